# Optimizing an MI355X kernel written in HIP

```python
import math
import jax, jax.numpy as jnp
from jax import lax
import numpy as np

D_MODEL = 1024
BATCH = 4
SEQ = 8192
DEPTH = 4

PLE_DIM = 256
N_A_LAYERS = DEPTH // 2
N_B_LAYERS = DEPTH - N_A_LAYERS
DIFF_HEAD_DIM = 64
DIFF_HEADS = D_MODEL // (2 * DIFF_HEAD_DIM)
FOX_HEAD_DIM = 64
FOX_HEADS = D_MODEL // FOX_HEAD_DIM
D_FF = 4 * D_MODEL
ROT_DIM = DIFF_HEAD_DIM // 4
ROPE_THETA = 500000.0
BLOCK_Q = 128
RMS_EPS = 1e-6

kernel_name = "yoco_diff_fox_hybrid"


def _rms_norm(x, gain):
    xf = x.astype(jnp.float32)
    y = xf * lax.rsqrt(jnp.mean(xf * xf, axis=-1, keepdims=True) + RMS_EPS)
    return (y * gain.astype(jnp.float32)).astype(x.dtype)


def _rope_tables(positions, dtype):
    inv_freq = 1.0 / (ROPE_THETA ** (jnp.arange(0, ROT_DIM, 2, dtype=jnp.float32) / ROT_DIM))
    ang = positions.astype(jnp.float32)[..., None] * inv_freq
    return jnp.cos(ang).astype(dtype), jnp.sin(ang).astype(dtype)


def _partial_rope(x, cos, sin):
    cos = cos[:, :, None, None, :]
    sin = sin[:, :, None, None, :]
    half = ROT_DIM // 2
    x1 = x[..., :half]
    x2 = x[..., half:ROT_DIM]
    return jnp.concatenate([x1 * cos - x2 * sin, x2 * cos + x1 * sin, x[..., ROT_DIM:]], axis=-1)


def _to_blocks(t):
    b, s = t.shape[:2]
    t = t.reshape((b, s // BLOCK_Q, BLOCK_Q) + t.shape[2:])
    return jnp.moveaxis(t, 1, 0)


def _from_blocks(t):
    t = jnp.moveaxis(t, 0, 1)
    return t.reshape((t.shape[0], t.shape[1] * t.shape[2]) + t.shape[3:])


def _causal_mask(blk, s):
    q_idx = blk * BLOCK_Q + jnp.arange(BLOCK_Q)
    return jnp.arange(s)[None, :] <= q_idx[:, None]


def _diff_attention(hn, w_qkv, lam_params, subln_gain, w_o, cos, sin, layer_idx):
    b, s, _ = hn.shape
    q, k, v = jnp.split(hn @ w_qkv, 3, axis=-1)
    q = _partial_rope(q.reshape(b, s, DIFF_HEADS, 2, DIFF_HEAD_DIM), cos, sin)
    k = _partial_rope(k.reshape(b, s, DIFF_HEADS, 2, DIFF_HEAD_DIM), cos, sin)
    v = v.reshape(b, s, DIFF_HEADS, 2 * DIFF_HEAD_DIM)
    lam_init = 0.8 - 0.6 * math.exp(-0.3 * layer_idx)
    lp = lam_params.astype(jnp.float32)
    lam = jnp.exp(jnp.sum(lp[0] * lp[1])) - jnp.exp(jnp.sum(lp[2] * lp[3])) + lam_init
    scale = DIFF_HEAD_DIM ** -0.5

    def block(args):
        qb, blk = args
        sc = jnp.einsum('bqhcd,bkhcd->bhcqk', qb, k).astype(jnp.float32) * scale
        sc = jnp.where(_causal_mask(blk, s), sc, -jnp.inf)
        pr = jax.nn.softmax(sc, axis=-1)
        a = pr[:, :, 0] - lam * pr[:, :, 1]
        return jnp.einsum('bhqk,bkhe->bqhe', a.astype(v.dtype), v)

    o = _from_blocks(lax.map(block, (_to_blocks(q), jnp.arange(s // BLOCK_Q))))
    o = _rms_norm(o, subln_gain) * (1.0 - lam_init)
    return o.reshape(b, s, -1) @ w_o


def _fox_shared_kv(h, kv_norm, kv_w, kv_b_f):
    b, s, _ = h.shape
    proj = _rms_norm(h, kv_norm) @ kv_w
    k = proj[..., :D_MODEL].reshape(b, s, FOX_HEADS, FOX_HEAD_DIM)
    v = proj[..., D_MODEL:2 * D_MODEL].reshape(b, s, FOX_HEADS, FOX_HEAD_DIM)
    f_logit = (proj[..., 2 * D_MODEL:] + kv_b_f).astype(jnp.float32)
    c = jnp.cumsum(jax.nn.log_sigmoid(f_logit), axis=1)
    return k, v, c


def _fox_attention(hn, w_q, w_o, k, v, c):
    b, s, _ = hn.shape
    q = (hn @ w_q).reshape(b, s, FOX_HEADS, FOX_HEAD_DIM)
    scale = FOX_HEAD_DIM ** -0.5
    c_k = jnp.moveaxis(c, 1, 2)

    def block(args):
        qb, cq, blk = args
        sc = jnp.einsum('bqhd,bkhd->bhqk', qb, k).astype(jnp.float32) * scale
        sc = sc + jnp.moveaxis(cq, 1, 2)[..., :, None] - c_k[:, :, None, :]
        sc = jnp.where(_causal_mask(blk, s), sc, -jnp.inf)
        pr = jax.nn.softmax(sc, axis=-1)
        return jnp.einsum('bhqk,bkhd->bqhd', pr.astype(v.dtype), v)

    o = _from_blocks(lax.map(block, (_to_blocks(q), _to_blocks(c), jnp.arange(s // BLOCK_Q))))
    return o.reshape(b, s, -1) @ w_o


def setup_inputs(seed: int = 0) -> dict:
    key = jax.random.key(seed)
    ks = jax.random.split(key, 24)

    def nrm(k, shape, scale):
        return jax.random.normal(k, shape, jnp.float32) * scale

    def gain(k, shape):
        return 1.0 + 0.01 * jax.random.normal(k, shape, jnp.float32)

    offsets = jax.random.randint(ks[2], (BATCH, 1), 0, 4096, dtype=jnp.int32)
    positions = (offsets + jnp.arange(SEQ, dtype=jnp.int32)[None, :]).astype(jnp.int32)
    return {
        "x": nrm(ks[0], (BATCH, SEQ, D_MODEL), 1.0),
        "p": nrm(ks[1], (DEPTH, BATCH, SEQ, PLE_DIM), 1.0),
        "positions": positions,
        "a_attn_norm": gain(ks[3], (N_A_LAYERS, D_MODEL)),
        "a_w_qkv": nrm(ks[4], (N_A_LAYERS, D_MODEL, 3 * D_MODEL), D_MODEL ** -0.5),
        "a_lambda": nrm(ks[5], (N_A_LAYERS, 4, DIFF_HEAD_DIM), 0.1),
        "a_subln": gain(ks[6], (N_A_LAYERS, 2 * DIFF_HEAD_DIM)),
        "a_w_o": nrm(ks[7], (N_A_LAYERS, D_MODEL, D_MODEL), D_MODEL ** -0.5),
        "kv_norm": gain(ks[8], (D_MODEL,)),
        "kv_w": nrm(ks[9], (D_MODEL, 2 * D_MODEL + FOX_HEADS), D_MODEL ** -0.5),
        "kv_b_f": jax.random.uniform(ks[10], (FOX_HEADS,), jnp.float32, 1.0, 5.0),
        "b_attn_norm": gain(ks[11], (N_B_LAYERS, D_MODEL)),
        "b_w_q": nrm(ks[12], (N_B_LAYERS, D_MODEL, D_MODEL), D_MODEL ** -0.5),
        "b_w_o": nrm(ks[13], (N_B_LAYERS, D_MODEL, D_MODEL), D_MODEL ** -0.5),
        "mlp_norm": gain(ks[14], (DEPTH, D_MODEL)),
        "mlp_w1": nrm(ks[15], (DEPTH, D_MODEL, D_FF), D_MODEL ** -0.5),
        "mlp_w2": nrm(ks[16], (DEPTH, D_FF, D_MODEL), D_FF ** -0.5),
        "ple_gate_norm": gain(ks[17], (DEPTH, D_MODEL)),
        "ple_gate_w": nrm(ks[18], (DEPTH, D_MODEL, D_MODEL), D_MODEL ** -0.5),
        "ple_w": nrm(ks[19], (DEPTH, PLE_DIM, D_MODEL), PLE_DIM ** -0.5),
        "final_norm": gain(ks[20], (D_MODEL,)),
    }


def reference(x, p, positions, a_attn_norm, a_w_qkv, a_lambda, a_subln, a_w_o, kv_norm, kv_w, kv_b_f,
              b_attn_norm, b_w_q, b_w_o, mlp_norm, mlp_w1, mlp_w2, ple_gate_norm, ple_gate_w, ple_w,
              final_norm):
    cos, sin = _rope_tables(positions, x.dtype)
    h = x
    for i in range(DEPTH):
        if i < N_A_LAYERS:
            h = h + _diff_attention(_rms_norm(h, a_attn_norm[i]), a_w_qkv[i], a_lambda[i], a_subln[i],
                                    a_w_o[i], cos, sin, i)
        else:
            j = i - N_A_LAYERS
            if j == 0:
                k_sh, v_sh, c_sh = _fox_shared_kv(h, kv_norm, kv_w, kv_b_f)
            h = h + _fox_attention(_rms_norm(h, b_attn_norm[j]), b_w_q[j], b_w_o[j], k_sh, v_sh, c_sh)
        hn = _rms_norm(h, mlp_norm[i])
        h = h + jnp.square(jax.nn.relu(hn @ mlp_w1[i])) @ mlp_w2[i]
        gate = jax.nn.sigmoid(_rms_norm(h, ple_gate_norm[i]) @ ple_gate_w[i])
        h = h + (p[i] @ ple_w[i]) * gate
    return _rms_norm(h, final_norm)
```

```cpp
#include <hip/hip_runtime.h>
#include <cstdio>
#include <cstdint>
namespace pg8 {
#define PG8_LAS __attribute__((address_space(3)))
typedef unsigned short bf16_t;
typedef short bf16x8 __attribute__((ext_vector_type(8)));
typedef float f32x4 __attribute__((ext_vector_type(4)));
typedef unsigned u32x4 __attribute__((ext_vector_type(4)));
constexpr int BM = 256, BK = 64, HALF = 128, HTB = HALF * BK * 2  , STAGE_BYTES = 8 * HTB, NXCD = 8, WGM = 8;

__host__ __device__ __forceinline__ int lds_byte(int r, int c) { const int st = (r >> 4) * 2 + (c >> 5), rr = r & 15, cc = c & 31, ob = rr * 64 + cc * 2; return st * 1024 + (ob ^ (((ob >> 9) & 1) << 5)); }
__host__ __device__ __forceinline__ void stage_rc(int b, int& R, int& C) { const int st = b / 1024, sb = b % 1024, swz = sb ^ (((sb >> 9) & 1) << 5); R = (st >> 1) * 16 + swz / 64; C = (st & 1) * 32 + (swz % 64) / 2; }
__host__ __device__ __forceinline__ int perm32(int rho) { const int n = rho >> 4, i = rho & 15; return 8 * (i >> 2) + 4 * n + (i & 3); }

struct Unit { int pm, pn; };
struct Gemm { const bf16_t* A; const bf16_t* Bt; int M, N, K; };

struct StaticOrder {
    int nM, nN, nwg, G, c;
    __host__ __device__ void init(int M, int N, int G_, int c_) { nM = M / BM; nN = N / BM; nwg = nM * nN; G = G_; c = c_; }
    __host__ __device__ bool next(int i, Unit& u) const {
        const long L = (long)i * G + c; if (L >= nwg) return false;
        int wgid = (int)L; { const int q = nwg / NXCD, r = nwg % NXCD, xcd = wgid % NXCD, off = wgid / NXCD; wgid = (xcd < r ? xcd * (q + 1) : r * (q + 1) + (xcd - r) * q) + off; }
        const int nig = WGM * nN, gid = wgid / nig, fm = gid * WGM, gsz = (nM - fm) < WGM ? (nM - fm) : WGM;
        u.pm = fm + ((wgid % nig) % gsz); u.pn = (wgid % nig) / gsz; return true;
    }
    __device__ __forceinline__ void a_ready(const Unit&) const {}
    __device__ __forceinline__ void done(const Unit&) const {}
};

__device__ __forceinline__ unsigned cvt_pk_bf16(float lo, float hi) { unsigned r; asm volatile("v_cvt_pk_bf16_f32 %0, %1, %2" : "=v"(r) : "v"(lo), "v"(hi)); return r; }
typedef float f32x2 __attribute__((ext_vector_type(2)));
template <int M> __device__ __forceinline__ float lane_xor(float v) { return __builtin_bit_cast(float, __builtin_amdgcn_ds_swizzle(__builtin_bit_cast(int, v), 0x1f | (M << 10))); }
__device__ __forceinline__ float half_sum(float v) { auto rr = __builtin_amdgcn_permlane32_swap(__float_as_uint(v), __float_as_uint(v), false, false); return __uint_as_float(rr[0]) + __uint_as_float(rr[1]); }
typedef float f32x2 __attribute__((ext_vector_type(2)));
typedef unsigned u32x2 __attribute__((ext_vector_type(2)));
constexpr float QK_C2 = 0.125f * 1.4426950408889634f;
__device__ __forceinline__ float rstd_of(const float* rowss, int row) { const f32x4* p = (const f32x4*)(rowss + (size_t)row * 16); const f32x4 a = p[0], b = p[1], c = p[2], d = p[3];
    const float s = (((a[0] + a[1]) + (a[2] + a[3])) + ((b[0] + b[1]) + (b[2] + b[3]))) + (((c[0] + c[1]) + (c[2] + c[3])) + ((d[0] + d[1]) + (d[2] + d[3]))); return __builtin_amdgcn_rsqf(s * (1.0f / 1024.0f) + 1e-6f); }
__device__ __forceinline__ float bf2f(unsigned short b) { return __builtin_bit_cast(float, (unsigned)b << 16); }

template <int ACT  > struct EpiBf {
    static constexpr bool PERM = true, AFTER_DRAIN = false;
    bf16_t* O; int ldc; const float* rowss; int row_off;
    __device__ __forceinline__ void operator()(const f32x4 (&acc)[2][2][4][2], const Unit& u, int wr, int wc, int fr, int fq) const {
        const int row0 = u.pm * BM + wr * 64 + fr, col0 = u.pn * BM + wc * 32 + 8 * fq;
#pragma unroll
        for (int ai = 0; ai < 2; ++ai)
#pragma unroll
            for (int m = 0; m < 4; ++m) { const int rl = row0 + ai * HALF + m * 16; const float rs = rowss ? rstd_of(rowss, row_off + rl) : 1.0f; bf16_t* rowp = O + (size_t)rl * ldc + col0;
#pragma unroll
                for (int bj = 0; bj < 2; ++bj) { f32x4 v0 = acc[ai][bj][m][0] * rs, v1 = acc[ai][bj][m][1] * rs;
                    if (ACT == 1) {
#pragma unroll
                        for (int i = 0; i < 4; ++i) { const float a = __builtin_fmaxf(v0[i], 0.f), b = __builtin_fmaxf(v1[i], 0.f); v0[i] = a * a; v1[i] = b * b; } }
                    u32x4 w; w.x = cvt_pk_bf16(v0[0], v0[1]); w.y = cvt_pk_bf16(v0[2], v0[3]); w.z = cvt_pk_bf16(v1[0], v1[1]); w.w = cvt_pk_bf16(v1[2], v1[3]);
                    *(u32x4*)(rowp + bj * HALF) = w; } }
    }
};

template <int MODE> struct EpiQKV {
    static constexpr bool PERM = true, AFTER_DRAIN = false;
    bf16_t* O; size_t offK, offV; const float* rowss; const float* cs; float* flog; const float* bfg;
    __device__ __forceinline__ void operator()(const f32x4 (&acc)[2][2][4][2], const Unit& u, int wr, int wc, int fr, int fq) const {
        const int colt = u.pn * BM, t = colt >> 10, cl = colt & 1023;
        const int row0 = u.pm * BM + wr * 64 + fr;
        if (MODE == 1 && t == 3) {
            if (wc == 0 && fq < 2) {
                const f32x4 b0 = *(const f32x4*)(bfg + 8 * fq), b1 = *(const f32x4*)(bfg + 8 * fq + 4);
#pragma unroll
                for (int ai = 0; ai < 2; ++ai)
#pragma unroll
                    for (int m = 0; m < 4; ++m) { const int row = row0 + ai * HALF + m * 16; const float rs = rstd_of(rowss, row);
                        f32x4 v0 = acc[ai][0][m][0] * rs + b0, v1 = acc[ai][0][m][1] * rs + b1;
#pragma unroll
                        for (int i = 0; i < 4; ++i) { v0[i] = __builtin_fminf(v0[i], 0.f) - log1pf(__expf(-__builtin_fabsf(v0[i]))); v1[i] = __builtin_fminf(v1[i], 0.f) - log1pf(__expf(-__builtin_fabsf(v1[i]))); }
                        *(f32x4*)(flog + (size_t)row * 16 + 8 * fq) = v0; *(f32x4*)(flog + (size_t)row * 16 + 8 * fq + 4) = v1; }
            }
            return;
        }
        bf16_t* base = O + ((t == 0) ? (size_t)0 : (t == 1) ? offK : offV); const float sc = (t == 0) ? QK_C2 : 1.0f;
        const bool rope = (MODE == 0) && (t < 2) && !(wc & 1);
        const float sgn = (fq == 0) ? -1.0f : 1.0f;
        const int col0 = cl + wc * 32 + 8 * fq;
#pragma unroll
        for (int ai = 0; ai < 2; ++ai)
#pragma unroll
            for (int m = 0; m < 4; ++m) { const int row = row0 + ai * HALF + m * 16; const float rs = rstd_of(rowss, row); bf16_t* rowp = base + (size_t)row * 1024 + col0;
                f32x4 c0, c1, s0, s1;
                if (rope) { const float* cp = cs + (size_t)row * 16; c0 = *(const f32x4*)(cp); c1 = *(const f32x4*)(cp + 4); s0 = *(const f32x4*)(cp + 8) * sgn; s1 = *(const f32x4*)(cp + 12) * sgn; }
#pragma unroll
                for (int bj = 0; bj < 2; ++bj) { f32x4 v0 = acc[ai][bj][m][0] * rs, v1 = acc[ai][bj][m][1] * rs;
                    if (rope) { f32x4 p0, p1;
#pragma unroll
                        for (int i = 0; i < 4; ++i) { p0[i] = lane_xor<16>(v0[i]); p1[i] = lane_xor<16>(v1[i]); }
                        const f32x4 r0 = v0 * c0 + p0 * s0, r1 = v1 * c1 + p1 * s1;
                        if (fq < 2) { v0 = r0; v1 = r1; } }
                    v0 = v0 * sc; v1 = v1 * sc;
                    u32x4 w; w.x = cvt_pk_bf16(v0[0], v0[1]); w.y = cvt_pk_bf16(v0[2], v0[3]); w.z = cvt_pk_bf16(v1[0], v1[1]); w.w = cvt_pk_bf16(v1[2], v1[3]);
                    *(u32x4*)(rowp + bj * HALF) = w; } }
    }
};

template <int MODE> struct EpiRes {
    static constexpr bool PERM = false, AFTER_DRAIN = false;
    const float* res; float* hout; bf16_t* hb; float* rowss_out; const float* rowss_in; const bf16_t* pl; int row_off;
    __device__ __forceinline__ void operator()(const f32x4 (&acc)[2][2][4][2], const Unit& u, int wr, int wc, int fr, int fq) const {
        const int col0 = u.pn * BM + wc * 32 + 4 * fq;
#pragma unroll
        for (int ai = 0; ai < 2; ++ai)
#pragma unroll
            for (int m = 0; m < 4; ++m) { const int row = row_off + u.pm * BM + ai * HALF + wr * 64 + m * 16 + fr; const size_t off = (size_t)row * 1024 + col0;
                float rs = 0.f; if (MODE == 1) rs = rstd_of(rowss_in, row);
                float ss = 0.f;
#pragma unroll
                for (int bj = 0; bj < 2; ++bj)
#pragma unroll
                    for (int n = 0; n < 2; ++n) { const size_t c = off + bj * HALF + n * 16; const f32x4 r = *(const f32x4*)(res + c); const f32x4 a = acc[ai][bj][m][n]; f32x4 o;
                        if (MODE == 1) { const u32x2 pw = *(const u32x2*)(pl + c);
                            const float p0 = __builtin_bit_cast(float, pw.x << 16), p1 = __builtin_bit_cast(float, pw.x & 0xffff0000u), p2 = __builtin_bit_cast(float, pw.y << 16), p3 = __builtin_bit_cast(float, pw.y & 0xffff0000u);
                            const f32x4 pv = (f32x4){p0, p1, p2, p3};
#pragma unroll
                            for (int i = 0; i < 4; ++i) { const float g = __builtin_amdgcn_rcpf(1.0f + __builtin_amdgcn_exp2f(-a[i] * rs * 1.4426950408889634f)); o[i] = r[i] + pv[i] * g; }
                        } else o = r + a;
                        *(f32x4*)(hout + c) = o; u32x2 w; w.x = cvt_pk_bf16(o[0], o[1]); w.y = cvt_pk_bf16(o[2], o[3]); *(u32x2*)(hb + c) = w;
                        ss += (o[0] * o[0] + o[1] * o[1]) + (o[2] * o[2] + o[3] * o[3]); }
                ss += lane_xor<16>(ss); ss = half_sum(ss);
                if (fq == 0) rowss_out[(size_t)row * 16 + u.pn * 4 + wc] = ss;
            }
    }
};
template <class Epi, class Sched, bool ALIGN_EPI = false, bool SP2 = false>
__device__ __forceinline__ void gemm_phase(PG8_LAS unsigned char* lds, const Gemm g, const Sched& S, const Epi& E) {
    int tid_ = threadIdx.x; asm volatile("" : "+v"(tid_));
    const int tid = tid_, wid = __builtin_amdgcn_readfirstlane(tid >> 6), lane = tid & 63, wr = wid >> 2, wc = wid & 3, fr = lane & 15, fq = lane >> 4;
    const int K = g.K, nt = K / BK;
    unsigned voffA[2], voffB[2];
#pragma unroll
    for (int i = 0; i < 2; ++i) { int R, C; stage_rc(tid * 16 + i * 8192, R, C); const int Rb = Epi::PERM ? ((R & ~31) + perm32(R & 31)) : R;
        voffA[i] = (unsigned)(R * K + C) * 2u; voffB[i] = (unsigned)(Rb * K + C) * 2u; }
    const size_t kstep = (size_t)(BK * 2);
    const size_t hstep = (size_t)HALF * K * 2;
    const size_t tstep = 2 * hstep;
    const unsigned ldsw = (unsigned)wid * 1024u;
    const int aoff = lds_byte(wr * 64 + fr, fq * 8), boff = lds_byte(wc * 32 + fr, fq * 8);
#define PG8_SA(b, h) (((b) * 2 + (h)) * HTB)
#define PG8_SB(b, h) ((4 + (b) * 2 + (h)) * HTB)
#define PG8_STAGE(bufoff, gbase, voff) do { _Pragma("unroll") for (int _i = 0; _i < 2; ++_i) \
        __builtin_amdgcn_global_load_lds((const unsigned*)((const char*)(gbase) + (voff)[_i]), (PG8_LAS unsigned*)(lds + (bufoff) + ldsw + _i * 8192), 16, 0, 0); } while (0)
#define PG8_LDA(dst, b, h) do { _Pragma("unroll") for (int m = 0; m < 4; ++m) _Pragma("unroll") for (int k = 0; k < 2; ++k) dst[m][k] = *(const PG8_LAS bf16x8*)(lds + PG8_SA(b, h) + aoff + m * 2048 + k * 1024); } while (0)
#define PG8_LDB(dst, b, h) do { _Pragma("unroll") for (int n = 0; n < 2; ++n) _Pragma("unroll") for (int k = 0; k < 2; ++k) dst[n][k] = *(const PG8_LAS bf16x8*)(lds + PG8_SB(b, h) + boff + n * 2048 + k * 1024); } while (0)
#define PG8_MMA(ai, bj, At, Bt) do { __builtin_amdgcn_s_setprio(1); _Pragma("unroll") for (int m = 0; m < 4; ++m) _Pragma("unroll") for (int n = 0; n < 2; ++n) _Pragma("unroll") for (int k = 0; k < 2; ++k) \
        acc[ai][bj][m][n] = __builtin_amdgcn_mfma_f32_16x16x32_bf16(Bt[n][k], At[m][k], acc[ai][bj][m][n], 0, 0, 0); __builtin_amdgcn_s_setprio(0); } while (0)
#define PG8_WAIT_V(n) asm volatile("s_waitcnt vmcnt(" #n ")" ::: "memory")
#define PG8_WAIT_L(n) asm volatile("s_waitcnt lgkmcnt(" #n ")" ::: "memory")
#define PG8_BAR __builtin_amdgcn_s_barrier()
#define PG8_SCHED __builtin_amdgcn_sched_barrier(0)
    Unit cur, nxt; int ui = 0;
    if (!S.next(0, cur)) return;
    f32x4 acc[2][2][4][2];
#pragma unroll
    for (int a = 0; a < 2; ++a)
#pragma unroll
        for (int b = 0; b < 2; ++b)
#pragma unroll
            for (int m = 0; m < 4; ++m)
#pragma unroll
                for (int n = 0; n < 2; ++n) acc[a][b][m][n] = (f32x4){0.f, 0.f, 0.f, 0.f};
    bf16x8 At[4][2], B0[2][2], B1[2][2];
    const char* cA = (const char*)g.A + (size_t)cur.pm * tstep; const char* cB = (const char*)g.Bt + (size_t)cur.pn * tstep;
    S.a_ready(cur);
    if constexpr (SP2) {
        PG8_STAGE(PG8_SB(0, 0), cB, voffB); PG8_STAGE(PG8_SB(0, 1), cB + hstep, voffB); PG8_STAGE(PG8_SA(0, 0), cA, voffA); PG8_STAGE(PG8_SA(0, 1), cA + hstep, voffA);
        if (wr == 1) PG8_BAR;
        PG8_WAIT_V(2); PG8_BAR;
        PG8_STAGE(PG8_SB(1, 0), cB + kstep, voffB); PG8_STAGE(PG8_SA(1, 0), cA + kstep, voffA); PG8_STAGE(PG8_SB(1, 1), cB + hstep + kstep, voffB);
        PG8_WAIT_V(6); PG8_BAR;
    } else {
        PG8_STAGE(PG8_SB(0, 0), cB, voffB); PG8_STAGE(PG8_SA(0, 0), cA, voffA); PG8_STAGE(PG8_SB(0, 1), cB + hstep, voffB); PG8_STAGE(PG8_SA(0, 1), cA + hstep, voffA);
        if (wr == 1) PG8_BAR;
        PG8_WAIT_V(4); PG8_BAR;
        PG8_STAGE(PG8_SB(1, 0), cB + kstep, voffB); PG8_STAGE(PG8_SA(1, 0), cA + kstep, voffA); PG8_STAGE(PG8_SB(1, 1), cB + hstep + kstep, voffB);
        PG8_WAIT_V(6); PG8_BAR;
    }
    for (;;) {
        const bool has_next = S.next(ui + 1, nxt);
        const char* nA = has_next ? (const char*)g.A + (size_t)nxt.pm * tstep : cA; const char* nB = has_next ? (const char*)g.Bt + (size_t)nxt.pn * tstep : cB;
        for (int t = 0; t < nt; t += 2) {
            const bool last = (t == nt - 2);
            const char* a1 = cA + (size_t)(t + 1) * kstep;
            const char* a2 = last ? nA : cA + (size_t)(t + 2) * kstep; const char* b2 = last ? nB : cB + (size_t)(t + 2) * kstep;
            const char* a3 = a2 + kstep; const char* b3 = b2 + kstep;
            if (last && has_next) S.a_ready(nxt);
            if constexpr (SP2) {
            PG8_LDB(B0, 0, 0); PG8_LDB(B1, 0, 1); PG8_SCHED; PG8_LDA(At, 0, 0); PG8_STAGE(PG8_SA(1, 1), a1 + hstep, voffA);
            PG8_WAIT_V(8); PG8_WAIT_L(0); PG8_BAR; PG8_MMA(0, 0, At, B0); PG8_MMA(0, 1, At, B1); PG8_BAR; PG8_SCHED;
            PG8_LDA(At, 0, 1); PG8_STAGE(PG8_SB(0, 0), b2, voffB); PG8_STAGE(PG8_SB(0, 1), b2 + hstep, voffB); PG8_STAGE(PG8_SA(0, 0), a2, voffA);
            PG8_WAIT_V(8); PG8_WAIT_L(0); PG8_BAR; PG8_MMA(1, 0, At, B0); PG8_MMA(1, 1, At, B1); PG8_BAR; PG8_SCHED;
            PG8_LDB(B0, 1, 0); PG8_LDB(B1, 1, 1); PG8_SCHED; PG8_LDA(At, 1, 0); PG8_STAGE(PG8_SA(0, 1), a2 + hstep, voffA);
            PG8_WAIT_V(8); PG8_WAIT_L(0); PG8_BAR; PG8_MMA(0, 0, At, B0); PG8_MMA(0, 1, At, B1); PG8_BAR; PG8_SCHED;
            PG8_LDA(At, 1, 1); PG8_STAGE(PG8_SB(1, 0), b3, voffB); PG8_STAGE(PG8_SB(1, 1), b3 + hstep, voffB); PG8_STAGE(PG8_SA(1, 0), a3, voffA);
            PG8_WAIT_V(8); PG8_WAIT_L(0); PG8_BAR; PG8_MMA(1, 0, At, B0); PG8_MMA(1, 1, At, B1); PG8_BAR; PG8_SCHED;
            } else {
            PG8_LDB(B0, 0, 0); PG8_SCHED; PG8_LDA(At, 0, 0); PG8_STAGE(PG8_SA(1, 1), a1 + hstep, voffA);
            PG8_WAIT_L(8); PG8_BAR; PG8_WAIT_L(0); PG8_MMA(0, 0, At, B0); PG8_BAR; PG8_SCHED;
            PG8_LDB(B1, 0, 1); PG8_STAGE(PG8_SB(0, 0), b2, voffB);
            PG8_BAR; PG8_WAIT_L(0); PG8_MMA(0, 1, At, B1); PG8_BAR;
            PG8_LDA(At, 0, 1); PG8_STAGE(PG8_SA(0, 0), a2, voffA);
            PG8_BAR; PG8_WAIT_L(0); PG8_MMA(1, 0, At, B0); PG8_BAR; PG8_SCHED;
            PG8_STAGE(PG8_SB(0, 1), b2 + hstep, voffB);
            PG8_WAIT_V(6); PG8_BAR; PG8_MMA(1, 1, At, B1); PG8_BAR;
            PG8_LDB(B0, 1, 0); PG8_SCHED; PG8_LDA(At, 1, 0); PG8_STAGE(PG8_SA(0, 1), a2 + hstep, voffA);
            PG8_WAIT_L(8); PG8_BAR; PG8_WAIT_L(0); PG8_MMA(0, 0, At, B0); PG8_BAR; PG8_SCHED;
            PG8_LDB(B1, 1, 1); PG8_STAGE(PG8_SB(1, 0), b3, voffB);
            PG8_BAR; PG8_WAIT_L(0); PG8_MMA(0, 1, At, B1); PG8_BAR;
            PG8_LDA(At, 1, 1); PG8_STAGE(PG8_SA(1, 0), a3, voffA);
            PG8_BAR; PG8_WAIT_L(0); PG8_MMA(1, 0, At, B0); PG8_BAR; PG8_SCHED;
            PG8_STAGE(PG8_SB(1, 1), b3 + hstep, voffB);
            PG8_WAIT_V(6); PG8_BAR; PG8_MMA(1, 1, At, B1); PG8_BAR;
            }
        }
        if constexpr (ALIGN_EPI) { if (wr == 0) PG8_BAR; }
        if constexpr (!Epi::AFTER_DRAIN) { E(acc, cur, wr, wc, fr, fq); S.done(cur); }
        if (!has_next) break;
#pragma unroll
        for (int a = 0; a < 2; ++a)
#pragma unroll
            for (int b = 0; b < 2; ++b)
#pragma unroll
                for (int m = 0; m < 4; ++m)
#pragma unroll
                    for (int n = 0; n < 2; ++n) acc[a][b][m][n] = (f32x4){0.f, 0.f, 0.f, 0.f};
        cur = nxt; cA = nA; cB = nB; ++ui;
        if constexpr (ALIGN_EPI) { if (wr == 1) PG8_BAR; }
    }
    PG8_WAIT_V(0);
    if constexpr (!ALIGN_EPI) { if (wr == 0) PG8_BAR; }
    PG8_BAR;
    if constexpr (Epi::AFTER_DRAIN) { E.fused(acc, cur, wr, wc, fr, fq, lds, wid, lane); S.done(cur); }
#undef PG8_SA
#undef PG8_SB
#undef PG8_STAGE
#undef PG8_LDA
#undef PG8_LDB
#undef PG8_MMA
#undef PG8_WAIT_V
#undef PG8_WAIT_L
#undef PG8_BAR
#undef PG8_SCHED
}
}

#ifndef PG8_SP2
#define PG8_SP2 true
#endif
#ifndef PG8_ALIGN
#define PG8_ALIGN true
#endif
#include <hip/hip_bf16.h>
#include <cmath>
namespace attn_body {
using bf16=__hip_bfloat16;
using bf16x8=__attribute__((ext_vector_type(8)))short;
using s16x4=__attribute__((ext_vector_type(4)))short;
using f32x16=__attribute__((ext_vector_type(16)))float;
using u32x4=__attribute__((ext_vector_type(4)))unsigned;
constexpr int BATCH=4,NHEAD=16,SEQ=8192,D=64,DM=NHEAD*D;
constexpr int NW=8,QBLK=32,QB=QBLK*NW,KVBLK=64,NQB=SEQ/QB;
constexpr int ATTN_PITCH=DM, ATTN_UNIT_ROWS=QB;
__device__ __forceinline__ int crow(int r,int hi){return (r&3)+8*(r>>2)+4*hi;}
#define SBAR() __builtin_amdgcn_sched_barrier(0)
__device__ __forceinline__ void cmask(f32x16&p0,f32x16&p1,int jb,int qrel,int hi){
  const float NEG=-INFINITY; int kb=64*jb+4*hi;
  #pragma unroll
  for(int r=0;r<16;++r){int kv=kb+(r&3)+8*(r>>2); if(kv>qrel)p0[r]=NEG; if(kv+32>qrel)p1[r]=NEG;}
}

constexpr int NSLOT=3, SLOTB=8192;
constexpr int LDS_K=0, LDS_V=NSLOT*SLOTB, LDS_WS=2*NSLOT*SLOTB, LDS_OST=LDS_WS+NW*64*4, LDS_BIAS=LDS_OST+NW*4096  , LDS_BYTES=LDS_BIAS+32768;
constexpr float C2=0.125f*1.4426950408889634f;
__device__ __forceinline__ void glds16(const void*gsrc,unsigned lds_dst){unsigned keep;
  asm volatile("s_mov_b32 %0, m0\n\ts_mov_b32 m0, %2\n\ts_nop 0\n\tglobal_load_lds_dwordx4 %1, off\n\ts_mov_b32 m0, %0":"=&s"(keep):"v"(gsrc),"s"(lds_dst):"memory");}
__device__ __forceinline__ float max3f(float a,float b,float c){float r;asm("v_max3_f32 %0, %1, %2, %3":"=v"(r):"v"(a),"v"(b),"v"(c));return r;}
__device__ __forceinline__ float max2f(float a,float b){float r;asm("v_max_f32_e32 %0, %1, %2":"=v"(r):"v"(a),"v"(b));return r;}
__device__ __forceinline__ float fadd_s(float a,float b){float r;asm("v_add_f32_e32 %0, %1, %2":"=v"(r):"v"(a),"v"(b));return r;}
__device__ __forceinline__ float fsub_s(float a,float b){float r;asm("v_sub_f32_e32 %0, %1, %2":"=v"(r):"v"(a),"v"(b));return r;}
typedef float f32x2_t __attribute__((ext_vector_type(2))); typedef __bf16 bf16x2_t __attribute__((ext_vector_type(2)));
__device__ __forceinline__ unsigned cvtpk_s(float lo,float hi){f32x2_t v={lo,hi};bf16x2_t b=__builtin_convertvector(v,bf16x2_t);return __builtin_bit_cast(unsigned,b);}
#define WAIT_BAR(N) asm volatile("s_waitcnt vmcnt(" #N ") lgkmcnt(0)\n\ts_barrier":::"memory")

template<bool ACCUM> __device__ __forceinline__ void qkt(f32x16&p0,f32x16&p1,const char*Kslot,const bf16x8*qr,const f32x16&negm,int r32,int hi){
  const char*kb=Kslot+hi*1024+r32*16;
  #pragma unroll
  for(int d0=0;d0<4;++d0){
    const bf16x8 b0=*reinterpret_cast<const bf16x8*>(kb+d0*2048);
    const bf16x8 b1=*reinterpret_cast<const bf16x8*>(kb+d0*2048+512);
    if(d0==0&&!ACCUM){p0=__builtin_amdgcn_mfma_f32_32x32x16_bf16(b0,qr[0],negm,0,0,0);p1=__builtin_amdgcn_mfma_f32_32x32x16_bf16(b1,qr[0],negm,0,0,0);}
    else{p0=__builtin_amdgcn_mfma_f32_32x32x16_bf16(b0,qr[d0],p0,0,0,0);p1=__builtin_amdgcn_mfma_f32_32x32x16_bf16(b1,qr[d0],p1,0,0,0);}}
}
typedef __attribute__((address_space(3))) const char* lds_cptr;
typedef short v4i16_t __attribute__((ext_vector_type(4)));
__device__ __forceinline__ void kload8(bf16x8*kf,lds_cptr kp){
  kf[0]=*(const __attribute__((address_space(3))) bf16x8*)(kp);      kf[1]=*(const __attribute__((address_space(3))) bf16x8*)(kp+512);
  kf[2]=*(const __attribute__((address_space(3))) bf16x8*)(kp+2048); kf[3]=*(const __attribute__((address_space(3))) bf16x8*)(kp+2560);
  kf[4]=*(const __attribute__((address_space(3))) bf16x8*)(kp+4096); kf[5]=*(const __attribute__((address_space(3))) bf16x8*)(kp+4608);
  kf[6]=*(const __attribute__((address_space(3))) bf16x8*)(kp+6144); kf[7]=*(const __attribute__((address_space(3))) bf16x8*)(kp+6656);
}
__device__ __forceinline__ void kload2(bf16x8*kf,lds_cptr kp,int j){ kf[2*j]=*(const __attribute__((address_space(3))) bf16x8*)(kp+j*2048); kf[2*j+1]=*(const __attribute__((address_space(3))) bf16x8*)(kp+j*2048+512); }
__device__ __forceinline__ s16x4 vtr(lds_cptr p){ return __builtin_bit_cast(s16x4,__builtin_amdgcn_ds_read_tr16_b64_v4i16((__attribute__((address_space(3))) v4i16_t*)p)); }
__device__ __forceinline__ float rowmax(const f32x16&p0,const f32x16&p1){
  float a=max3f(p0[0],p0[1],p1[0]),b=max3f(p0[2],p0[3],p1[1]);a=max3f(a,p1[2],p1[3]);
  #pragma unroll
  for(int r=4;r<16;r+=4){a=max3f(a,p0[r],p0[r+1]);b=max3f(b,p0[r+2],p0[r+3]);a=max3f(a,p1[r],p1[r+1]);b=max3f(b,p1[r+2],p1[r+3]);}
  const float m=max2f(a,b);
  auto rr=__builtin_amdgcn_permlane32_swap(__float_as_uint(m),__float_as_uint(m),false,false);
  return max2f(__uint_as_float(rr[0]),__uint_as_float(rr[1]));
}
__device__ __forceinline__ void pv(f32x16*o,int vb,bf16x8 pa0,bf16x8 pa1,bf16x8 pa2,bf16x8 pa3){
  #pragma unroll
  for(int d0=0;d0<2;++d0){s16x4 lo[4],hi[4];
    #pragma unroll
    for(int ks=0;ks<4;++ks){
      asm volatile("ds_read_b64_tr_b16 %0,%1 offset:%c2":"=&v"(lo[ks]):"v"(vb),"i"(d0*4096+ks*1024):"memory");
      asm volatile("ds_read_b64_tr_b16 %0,%1 offset:%c2":"=&v"(hi[ks]):"v"(vb),"i"(d0*4096+ks*1024+512):"memory");}
    asm volatile("s_waitcnt lgkmcnt(0)":::"memory");SBAR();
    #define PK(k) (bf16x8){lo[k][0],lo[k][1],lo[k][2],lo[k][3],hi[k][0],hi[k][1],hi[k][2],hi[k][3]}
    o[d0]=__builtin_amdgcn_mfma_f32_32x32x16_bf16(pa0,PK(0),o[d0],0,0,0);
    o[d0]=__builtin_amdgcn_mfma_f32_32x32x16_bf16(pa1,PK(1),o[d0],0,0,0);
    o[d0]=__builtin_amdgcn_mfma_f32_32x32x16_bf16(pa2,PK(2),o[d0],0,0,0);
    o[d0]=__builtin_amdgcn_mfma_f32_32x32x16_bf16(pa3,PK(3),o[d0],0,0,0);
    #undef PK
  }
}

#ifndef ATTN_STORE16
#define ATTN_STORE16(p,v) (*(u32x4*)(p)=(v))
#endif
typedef float f32x4b __attribute__((ext_vector_type(4)));
__device__ __forceinline__ void binit(f32x16&c0,f32x16&c1,lds_cptr bp,float nm){
  #pragma unroll
  for(int g=0;g<4;++g){ const f32x4b a=*(const __attribute__((address_space(3))) f32x4b*)(bp+g*32); const f32x4b bb=*(const __attribute__((address_space(3))) f32x4b*)(bp+128+g*32);
    #pragma unroll
    for(int i=0;i<4;++i){ c0[4*g+i]=nm-a[i]; c1[4*g+i]=nm-bb[i]; } }
}
template<int THRL,bool BIAS> __device__ __forceinline__ void attn_unit(int b,int cq,int ck,int cv,int co,int qb,const bf16*Q,const bf16*__restrict__ K,const bf16*__restrict__ V,bf16*O,const float*cb,char*shm){
  int tid_=threadIdx.x; asm volatile("":"+v"(tid_)); const int tid=tid_,lane=tid&63,r32=lane&31,hi=lane>>5; const int wid=__builtin_amdgcn_readfirstlane(tid>>6);
  const long rowbase=(long)b*SEQ; const int q0=qb*QB;
  const bf16*Qw=Q+(rowbase+q0+wid*QBLK)*DM+cq;
  const bf16*Kh=K+rowbase*DM+ck,*Vh=V+rowbase*DM+cv;
  const unsigned lds0=(unsigned)(uintptr_t)shm;
  float*wsf=(float*)(shm+LDS_WS)+wid*64;
  const bf16*ksrc=Kh+(long)lane*DM+wid*8;
  const bf16*vsrc=Vh+(long)(16*(wid&3)+(lane>>2))*DM+(wid>>2)*32+(lane&3)*8;
  const unsigned kdst=lds0+LDS_K+wid*1024, vdst=lds0+LDS_V+wid*1024;
  #define DMA_K(t,slot) glds16(ksrc+(long)(t)*KVBLK*DM,(unsigned)__builtin_amdgcn_readfirstlane(kdst+(slot)))
  #define DMA_V(t,slot) glds16(vsrc+(long)(t)*KVBLK*DM,(unsigned)__builtin_amdgcn_readfirstlane(vdst+(slot)))
  const int vb0=(int)(lds0+LDS_V)+((lane>>4)&1)*32+(lane&3)*8+(4*hi+((lane&15)>>2))*64;
  const char*Kbase=shm+LDS_K; bf16x8 kf[8];
  const lds_cptr shm3=(lds_cptr)shm; const lds_cptr kp0=shm3+LDS_K+hi*1024+r32*16; const lds_cptr vp0=shm3+LDS_V+((lane>>4)&1)*32+(lane&3)*8+(4*hi+((lane&15)>>2))*64;
  const int NT=(q0+QB)/KVBLK;
  float cqv=0.f,nm=0.f; const lds_cptr bp0=shm3+LDS_BIAS+hi*16;
  if constexpr(BIAS){ for(int p=wid;p<=qb;p+=NW) glds16(cb+p*256+lane*4,(unsigned)__builtin_amdgcn_readfirstlane(lds0+LDS_BIAS+p*1024));
    cqv=cb[q0+wid*QBLK+r32]; }
  DMA_K(0,0);DMA_V(0,0);DMA_K(1,SLOTB);
  bf16x8 qr[4];
  #pragma unroll
  for(int d0=0;d0<4;++d0)qr[d0]=*reinterpret_cast<const bf16x8*>(&Qw[(long)r32*DM+d0*16+hi*8]);
  float mhat=0.f,l_reg=0.f;f32x16 o[2];o[0]=f32x16{};o[1]=f32x16{};f32x16 negm=f32x16{};if constexpr(!BIAS)asm volatile("":"+v"(negm));
  const int qrel=wid*QBLK+r32;
  #define CMASK(P0,P1,t) do{int jb_=(t)-(NT-4); if(jb_>=0)cmask(P0,P1,jb_,qrel,hi);}while(0)
  bool resc=false;
  #define START(P0,P1) do{ const float rm=rowmax(P0,P1); resc=false; \
    { const float dl=BIAS?__builtin_fmaxf(rm,0.f):rm; mhat=fadd_s(mhat,dl); \
      _Pragma("unroll") for(int r=0;r<16;++r){P0[r]=fsub_s(P0[r],dl);P1[r]=fsub_s(P1[r],dl);} \
      if constexpr(BIAS){ nm=cqv-mhat; } else { _Pragma("unroll") for(int r=0;r<16;++r)negm[r]=-mhat; asm volatile("":"+v"(negm)); } } \
    _Pragma("unroll") for(int r=0;r<16;++r)P0[r]=__builtin_amdgcn_exp2f(P0[r]); }while(0)
  #define RESC() do{ if(resc){ asm volatile("s_waitcnt lgkmcnt(0)":::"memory"); \
      _Pragma("unroll") for(int d_=0;d_<2;++d_) _Pragma("unroll") for(int r=0;r<16;++r)o[d_][r]*=wsf[crow(r,hi)]; } }while(0)
  f32x16 pA0,pA1,pB0,pB1;
  int sl_prev=0,sl_cur=0,sl_next=SLOTB;
  #define ROT() do{sl_prev=sl_cur;sl_cur=sl_next;sl_next=(sl_next==(NSLOT-1)*SLOTB)?0:sl_next+SLOTB;}while(0)
  DMA_K(2,2*SLOTB);
  WAIT_BAR(3);
  if constexpr(BIAS){ nm=cqv; binit(pA0,pA1,bp0,nm); qkt<true>(pA0,pA1,Kbase,qr,negm,r32,hi); } else { qkt<false>(pA0,pA1,Kbase,qr,negm,r32,hi); } asm volatile("s_nop 15\n\ts_nop 7":"+v"(pA0),"+v"(pA1));CMASK(pA0,pA1,0);
  START(pA0,pA1);
  _Pragma("unroll") for(int r=0;r<16;++r)pA1[r]=__builtin_amdgcn_exp2f(pA1[r]);
  WAIT_BAR(0);
  DMA_K(3,0);DMA_V(1,SLOTB);
  ROT();
  kload8(kf,kp0+sl_cur);
  WAIT_BAR(2);
  s16x4 vlo[8],vhi[8]; u32x4 pw0,pw1,pw2,pw3;
  #define PKW(P,B) cvtpk_s(P[B],P[B+1])
  #define PAF(k) __builtin_bit_cast(bf16x8,pw##k)
  #define VFR(i) (bf16x8){vlo[i][0],vlo[i][1],vlo[i][2],vlo[i][3],vhi[i][0],vhi[i][1],vhi[i][2],vhi[i][3]}
  #define PIN(x) asm volatile("":"+v"(x))
  #define MX3(a,b,c) __builtin_fmaxf(__builtin_fmaxf((a),(b)),(c))
  #define GAPA(MF,A0,A1,A2,A3,W0,W1,PW) do{ MF; sacc+=A0; sacc+=A1; sacc+=A2; sacc+=A3; PIN(sacc); W0; W1; PIN(PW); SBAR(); }while(0)
  #define EX(v) __builtin_amdgcn_exp2f(v)
  #define GAPB(MF,X,B) do{ MF; X[B]=EX(X[B]); X[B+1]=EX(X[B+1]); X[B+2]=EX(X[B+2]); X[B+3]=EX(X[B+3]); PIN(X); SBAR(); }while(0)
  #define VRD(i) do{ vlo[i]=vtr(vp_+(((i)>>2)*4096+((i)&3)*1024)); vhi[i]=vtr(vp_+(((i)>>2)*4096+((i)&3)*1024+512)); }while(0)
  #define KRD(G,j) do{ if(G){ kload2(kf,kp0+sl_next,j); SBAR(); } }while(0)
  #define STEP(C0,C1,P0,P1,t,GK,GV,GL) do{ SBAR(); \
    const lds_cptr vp_=vp0+sl_prev; \
    if constexpr(BIAS){ binit(C0,C1,bp0+(t)*256,nm); SBAR(); } \
    VRD(0); SBAR(); float sacc=(P0[0]+P0[1]); \
    GAPA(C0=__builtin_amdgcn_mfma_f32_32x32x16_bf16(kf[0],qr[0],BIAS?C0:negm,0,0,0), P0[2],P0[3],P0[4],P0[5],     pw0[0]=PKW(P0,0), pw0[1]=PKW(P0,2), pw0); \
    VRD(4); SBAR(); GAPA(C1=__builtin_amdgcn_mfma_f32_32x32x16_bf16(kf[1],qr[0],BIAS?C1:negm,0,0,0), P0[6],P0[7],P0[8],P0[9],     pw0[2]=PKW(P0,4), pw0[3]=PKW(P0,6), pw0); \
    VRD(1); SBAR(); GAPA(C0=__builtin_amdgcn_mfma_f32_32x32x16_bf16(kf[2],qr[1],C0,0,0,0),   P0[10],P0[11],P0[12],P0[13], pw1[0]=PKW(P0,8), pw1[1]=PKW(P0,10), pw1); \
    VRD(5); SBAR(); GAPA(C1=__builtin_amdgcn_mfma_f32_32x32x16_bf16(kf[3],qr[1],C1,0,0,0),   P0[14],P0[15],P1[0],P1[1],   pw1[2]=PKW(P0,12),pw1[3]=PKW(P0,14), pw1); \
    VRD(2); SBAR(); GAPA(C0=__builtin_amdgcn_mfma_f32_32x32x16_bf16(kf[4],qr[2],C0,0,0,0),   P1[2],P1[3],P1[4],P1[5],     pw2[0]=PKW(P1,0), pw2[1]=PKW(P1,2), pw2); \
    VRD(6); SBAR(); GAPA(C1=__builtin_amdgcn_mfma_f32_32x32x16_bf16(kf[5],qr[2],C1,0,0,0),   P1[6],P1[7],P1[8],P1[9],     pw2[2]=PKW(P1,4), pw2[3]=PKW(P1,6), pw2); \
    VRD(3); SBAR(); GAPA(C0=__builtin_amdgcn_mfma_f32_32x32x16_bf16(kf[6],qr[3],C0,0,0,0),   P1[10],P1[11],P1[12],P1[13], pw3[0]=PKW(P1,8), pw3[1]=PKW(P1,10), pw3); \
    VRD(7); SBAR(); GAPA(C1=__builtin_amdgcn_mfma_f32_32x32x16_bf16(kf[7],qr[3],C1,0,0,0),   P1[14],P1[15],0.f,0.f,       pw3[2]=PKW(P1,12),pw3[3]=PKW(P1,14), pw3); \
    l_reg+=sacc; \
    if(GK){DMA_K((t)+3,sl_cur);} if(GV){DMA_V((t)+1,sl_next);} \
    CMASK(C0,C1,t); \
    { float a=MX3(C0[0],C0[1],C1[0]),b=MX3(C0[2],C0[3],C1[1]); a=MX3(a,C1[2],C1[3]); \
      _Pragma("unroll") for(int r=4;r<16;r+=4){a=MX3(a,C0[r],C0[r+1]);b=MX3(b,C0[r+2],C0[r+3]);a=MX3(a,C1[r],C1[r+1]);b=MX3(b,C1[r+2],C1[r+3]);} \
      float rm=__builtin_fmaxf(a,b); { auto rr=__builtin_amdgcn_permlane32_swap(__float_as_uint(rm),__float_as_uint(rm),false,false); rm=__builtin_fmaxf(__uint_as_float(rr[0]),__uint_as_float(rr[1])); } \
      resc=false; \
      if(__builtin_expect(__any(rm>(float)THRL),0)){ const float dl=__builtin_fmaxf(rm,0.f); mhat+=dl; \
        _Pragma("unroll") for(int r=0;r<16;++r){C0[r]-=dl;C1[r]-=dl;} \
        if constexpr(BIAS){ nm=cqv-mhat; } else { _Pragma("unroll") for(int r=0;r<16;++r)negm[r]=-mhat; asm volatile("":"+v"(negm)); } \
        const float f=__builtin_amdgcn_exp2f(-dl); l_reg*=f; if(hi==0)wsf[r32]=f; resc=true; } } \
    SBAR(); \
    GAPB(o[0]=__builtin_amdgcn_mfma_f32_32x32x16_bf16(PAF(0),VFR(0),o[0],0,0,0), C0,0); \
    GAPB(o[1]=__builtin_amdgcn_mfma_f32_32x32x16_bf16(PAF(0),VFR(4),o[1],0,0,0), C0,4); \
    KRD(GL,0); GAPB(o[0]=__builtin_amdgcn_mfma_f32_32x32x16_bf16(PAF(1),VFR(1),o[0],0,0,0), C0,8); \
    KRD(GL,1); GAPB(o[1]=__builtin_amdgcn_mfma_f32_32x32x16_bf16(PAF(1),VFR(5),o[1],0,0,0), C0,12); \
    KRD(GL,2); GAPB(o[0]=__builtin_amdgcn_mfma_f32_32x32x16_bf16(PAF(2),VFR(2),o[0],0,0,0), C1,0); \
    KRD(GL,3); GAPB(o[1]=__builtin_amdgcn_mfma_f32_32x32x16_bf16(PAF(2),VFR(6),o[1],0,0,0), C1,4); \
    GAPB(o[0]=__builtin_amdgcn_mfma_f32_32x32x16_bf16(PAF(3),VFR(3),o[0],0,0,0), C1,8); \
    GAPB(o[1]=__builtin_amdgcn_mfma_f32_32x32x16_bf16(PAF(3),VFR(7),o[1],0,0,0), C1,12); \
    }while(0)
  int t=1;
  #undef CMASK
  #define CMASK(P0,P1,t) do{}while(0)
  for(;t+5<NT;t+=2){
    STEP(pB0,pB1,pA0,pA1,t,true,true,true);     WAIT_BAR(2); RESC(); ROT();
    STEP(pA0,pA1,pB0,pB1,t+1,true,true,true);   WAIT_BAR(2); RESC(); ROT();
  }
  #undef CMASK
  #define CMASK(P0,P1,t) do{int jb_=(t)-(NT-4); if(jb_>=0)cmask(P0,P1,jb_,qrel,hi);}while(0)
  #define ENDW(tt) do{ if((tt)+3<NT){WAIT_BAR(2);} else if((tt)+2<NT){WAIT_BAR(1);} else {WAIT_BAR(0);} }while(0)
  for(;t+1<NT;t+=2){
    STEP(pB0,pB1,pA0,pA1,t,(t+3<NT),(t+1<NT),(t+1<NT));       ENDW(t);   RESC(); ROT();
    STEP(pA0,pA1,pB0,pB1,t+1,(t+4<NT),(t+2<NT),(t+2<NT));     ENDW(t+1); RESC(); ROT();
  }
  STEP(pB0,pB1,pA0,pA1,NT-1,false,false,false); RESC();
  { float sacc=pB0[0]+pB0[1]; _Pragma("unroll") for(int r=2;r<16;++r)sacc+=pB0[r]; _Pragma("unroll") for(int r=0;r<16;++r)sacc+=pB1[r]; l_reg+=sacc;
    pw0=(u32x4){PKW(pB0,0),PKW(pB0,2),PKW(pB0,4),PKW(pB0,6)};pw1=(u32x4){PKW(pB0,8),PKW(pB0,10),PKW(pB0,12),PKW(pB0,14)};pw2=(u32x4){PKW(pB1,0),PKW(pB1,2),PKW(pB1,4),PKW(pB1,6)};pw3=(u32x4){PKW(pB1,8),PKW(pB1,10),PKW(pB1,12),PKW(pB1,14)};
    SBAR(); pv(o,vb0+sl_cur,PAF(0),PAF(1),PAF(2),PAF(3)); }
  #undef PKW
  #undef PAF
  #undef VFR
  #undef PIN
  #undef MX3
  #undef GAPA
  #undef GAPB
  #undef EX
  #undef VRD
  #undef KRD
  #undef STEP
  #undef ENDW
  {auto rr=__builtin_amdgcn_permlane32_swap(__float_as_uint(l_reg),__float_as_uint(l_reg),false,false);l_reg=__uint_as_float(rr[0])+__uint_as_float(rr[1]);}
  if(hi==0)wsf[32+r32]=l_reg;asm volatile("s_waitcnt lgkmcnt(0)":::"memory");
  float rli[16];
  #pragma unroll
  for(int r=0;r<16;++r)rli[r]=__builtin_amdgcn_rcpf(wsf[32+crow(r,hi)]);
  bf16*Ow=O+(rowbase+q0+wid*QBLK)*DM+co;
  { bf16*stg=(bf16*)(shm+LDS_OST)+wid*2048;
    #pragma unroll
    for(int r=0;r<16;++r){const int orow=crow(r,hi);
      #pragma unroll
      for(int d0=0;d0<2;++d0)stg[orow*64+d0*32+r32]=__float2bfloat16(o[d0][r]*rli[r]);}
    asm volatile("s_waitcnt lgkmcnt(0)":::"memory");
    #pragma unroll
    for(int i=0;i<4;++i){const int row=i*8+(lane>>3),ch=lane&7; const u32x4 v=*(const u32x4*)(stg+row*64+ch*8); ATTN_STORE16(Ow+(long)row*DM+ch*8,v);} }
  asm volatile("s_waitcnt lgkmcnt(0)\n\ts_barrier":::"memory");
  #undef DMA_K
  #undef DMA_V
  #undef CMASK
  #undef START
  #undef RESC
  #undef ROT
}
constexpr int ATTN_LDS_BYTES=LDS_BYTES;
#undef SBAR
#undef WAIT_BAR
}
#include <hip/hip_cooperative_groups.h>
namespace cg = cooperative_groups;
#ifndef MK_SPLIT
#define MK_SPLIT 0
#endif
constexpr int NWAVES = 8;
constexpr int BATCH = 4, SEQ = 8192, T = BATCH * SEQ, D = 1024, FF = 4096, PLE = 256, DEPTH = 4, NFH = 16;
constexpr int TH = T / 2;
constexpr size_t MiB = 1u << 20;
constexpr size_t WS_ROWSS = 8 * MiB;
constexpr size_t WS_CS = 2 * MiB;
constexpr size_t WS_FLOG = 4 * MiB;
constexpr size_t WS_CK = 6 * MiB;
constexpr size_t W_QKV = 16 * MiB;
constexpr size_t W_O = 23 * MiB;
constexpr size_t W_1 = 25 * MiB;
constexpr size_t W_2 = 33 * MiB;
constexpr size_t W_PLE = 41 * MiB;
constexpr size_t W_G = 42 * MiB;
constexpr size_t WS_HBX = 48 * MiB, WS_HBY = 112 * MiB, WS_R1 = 176 * MiB, WS_PL = 432 * MiB, WS_END = 496 * MiB;
constexpr int RING_BYTES = 131072, LDS_BYTES = 147456;
static_assert(attn_body::ATTN_LDS_BYTES <= RING_BYTES, "attention LDS");

#define GAS __attribute__((address_space(1)))
#define LAS __attribute__((address_space(3)))
typedef unsigned short bf16;
typedef unsigned v4u __attribute__((ext_vector_type(4)));
typedef float f32x4 __attribute__((ext_vector_type(4)));
#define LDS_WAIT() asm volatile("s_waitcnt lgkmcnt(0)" ::: "memory")
__device__ __forceinline__ unsigned f2bf(float f) { unsigned u = __builtin_bit_cast(unsigned, f); return (u + 0x7fffu + ((u >> 16) & 1u)) >> 16; }
__device__ __forceinline__ unsigned pk2(float lo, float hi) { return f2bf(lo) | (f2bf(hi) << 16); }
__device__ __forceinline__ float wave_sum(float v) {
    v += pg8::lane_xor<1>(v); v += pg8::lane_xor<2>(v); v += pg8::lane_xor<4>(v); v += pg8::lane_xor<8>(v); v += pg8::lane_xor<16>(v);
    return pg8::half_sum(v);
}

constexpr int N_PHASES = 1 + 9 + 9 + 9 + 8 + 1;
enum { K_PRO = 0, K_QKVA, K_ATTA, K_COMB, K_QKVB, K_SCAN, K_ATTB, K_RES, K_W1, K_GATE, K_FIN };
struct Args { const float* in[21]; float* out; unsigned char* ws; float inv_freq[8]; int ph_lo, ph_hi; int prog[N_PHASES + 1]; };

#define CAS __attribute__((address_space(4)))
struct Frame { LAS unsigned char* lds; int tid, lane, wave, vcu, G; const CAS Args* a; };

__device__ __forceinline__ void transpose_item(const float* W, int ldw, int coff, int ncols, int K, const float* gain, bf16* WT, int row_off, LAS float* scr, int item, int nblk, int lane) {
    const int kb = item / nblk, nb = item % nblk, k0 = 64 * kb, n0 = 32 * nb;
#pragma unroll 8
    for (int i = 0; i < 32; ++i) { const int kk = 2 * i + (lane >> 5), n = n0 + (lane & 31);
        float v = (n < ncols) ? W[(size_t)(k0 + kk) * ldw + coff + n] : 0.f; if (gain) v *= gain[k0 + kk]; scr[kk * 33 + (lane & 31)] = v; }
    LDS_WAIT(); asm volatile("" ::: "memory");
    const int c = lane & 7;
#pragma unroll
    for (int j = 0; j < 4; ++j) { const int n = (lane >> 3) + 8 * j; const LAS float* s = scr + (8 * c) * 33 + n;
        v4u o; o.x = pk2(s[0 * 33], s[1 * 33]); o.y = pk2(s[2 * 33], s[3 * 33]); o.z = pk2(s[4 * 33], s[5 * 33]); o.w = pk2(s[6 * 33], s[7 * 33]);
        *(GAS v4u*)(WT + (size_t)(row_off + n0 + n) * K + k0 + 8 * c) = o; }
    LDS_WAIT(); asm volatile("" ::: "memory");
}

__device__ __forceinline__ void convert_layer(Frame& F, int L) {
    const CAS Args& A = *F.a; unsigned char* ws = A.ws;
    LAS float* scr = (LAS float*)(F.lds + F.wave * 16384);
    const int gw = F.vcu * NWAVES + F.wave, NGW = F.G * NWAVES;
    bf16* Wqkv = (bf16*)(ws + W_QKV); bf16* Wo = (bf16*)(ws + W_O); bf16* W1 = (bf16*)(ws + W_1); bf16* W2 = (bf16*)(ws + W_2); bf16* Wp = (bf16*)(ws + W_PLE); bf16* Wg = (bf16*)(ws + W_G + (size_t)(L & 1) * 2 * MiB);
    const bool isA = L < 2; const int j = L - 2;
    const int I_QKV = isA ? 16 * 96 : 16 * 32, I_KV = (!isA && j == 0) ? 16 * 64 : 0, I_F = (!isA && j == 0) ? 16 : 0, I_O = 16 * 32, I_1 = 16 * 128, I_2 = 64 * 32, I_G = 16 * 32, I_P = 4 * 32;
    const int NIT = I_QKV + I_KV + I_F + I_O + I_1 + I_2 + I_G + I_P;
    for (int it = gw; it < NIT; it += NGW) {
        int r = it;
        if (r < I_QKV) { if (isA) transpose_item(A.in[4] + (size_t)L * D * 3 * D, 3 * D, 0, 3 * D, D, A.in[3] + L * D, Wqkv, 0, scr, r, 96, F.lane);
                         else transpose_item(A.in[12] + (size_t)j * D * D, D, 0, D, D, A.in[11] + j * D, Wqkv, 0, scr, r, 32, F.lane); continue; } r -= I_QKV;
        if (r < I_KV) { transpose_item(A.in[9], 2 * D + NFH, 0, 2 * D, D, A.in[8], Wqkv, D, scr, r, 64, F.lane); continue; } r -= I_KV;
        if (r < I_F) { transpose_item(A.in[9], 2 * D + NFH, 2 * D, NFH, D, A.in[8], Wqkv, 3 * D, scr, r, 1, F.lane); continue; } r -= I_F;
        if (r < I_O) { transpose_item(isA ? A.in[7] + (size_t)L * D * D : A.in[13] + (size_t)j * D * D, D, 0, D, D, nullptr, Wo, 0, scr, r, 32, F.lane); continue; } r -= I_O;
        if (r < I_1) { transpose_item(A.in[15] + (size_t)L * D * FF, FF, 0, FF, D, A.in[14] + L * D, W1, 0, scr, r, 128, F.lane); continue; } r -= I_1;
        if (r < I_2) { transpose_item(A.in[16] + (size_t)L * FF * D, D, 0, D, FF, nullptr, W2, 0, scr, r, 32, F.lane); continue; } r -= I_2;
        if (r < I_G) { transpose_item(A.in[18] + (size_t)L * D * D, D, 0, D, D, A.in[17] + L * D, Wg, 0, scr, r, 32, F.lane); continue; } r -= I_G;
        transpose_item(A.in[19] + (size_t)L * PLE * D, D, 0, D, PLE, nullptr, Wp, 0, scr, r, 32, F.lane);
    }
}

__device__ __forceinline__ void sincos_red(double r, float& s, float& c) {
    const double r2 = r * r;
    double sp = -1.0 / 51090942171709440000.0;
    sp = sp * r2 + 1.0 / 121645100408832000.0;
    sp = sp * r2 - 1.0 / 355687428096000.0;
    sp = sp * r2 + 1.0 / 1307674368000.0;
    sp = sp * r2 - 1.0 / 6227020800.0;
    sp = sp * r2 + 1.0 / 39916800.0;
    sp = sp * r2 - 1.0 / 362880.0;
    sp = sp * r2 + 1.0 / 5040.0;
    sp = sp * r2 - 1.0 / 120.0;
    sp = sp * r2 + 1.0 / 6.0;
    sp = sp * r2 - 1.0;
    s = (float)(-(sp * r));
    double cp = 1.0 / 1124000727777607680000.0;
    cp = cp * r2 - 1.0 / 2432902008176640000.0;
    cp = cp * r2 + 1.0 / 6402373705728000.0;
    cp = cp * r2 - 1.0 / 20922789888000.0;
    cp = cp * r2 + 1.0 / 87178291200.0;
    cp = cp * r2 - 1.0 / 479001600.0;
    cp = cp * r2 + 1.0 / 3628800.0;
    cp = cp * r2 - 1.0 / 40320.0;
    cp = cp * r2 + 1.0 / 720.0;
    cp = cp * r2 - 1.0 / 24.0;
    cp = cp * r2 + 0.5;
    c = (float)(1.0 - cp * r2);
}

__device__ __forceinline__ void p0_prologue(Frame& F) {
    const CAS Args& A = *F.a; unsigned char* ws = A.ws;
    const int gw = F.vcu * NWAVES + F.wave, NGW = F.G * NWAVES, gt = gw * 64 + F.lane, NGT = NGW * 64;
    float* rowss = (float*)(ws + WS_ROWSS);
    bf16* hbx = (bf16*)(ws + WS_HBX);
    for (int m = gw; m < T; m += NGW) {
        const GAS f32x4* xr = (const GAS f32x4*)(A.in[0] + (size_t)m * D) + F.lane; f32x4 v[4]; float s = 0.f;
#pragma unroll
        for (int j = 0; j < 4; ++j) { v[j] = xr[64 * j]; s += (v[j].x * v[j].x + v[j].y * v[j].y) + (v[j].z * v[j].z + v[j].w * v[j].w); }
        s = wave_sum(s); if (F.lane < 16) rowss[(size_t)m * 16 + F.lane] = (F.lane == 0) ? s : 0.f;
        GAS unsigned long long* o8 = (GAS unsigned long long*)(hbx + (size_t)m * D) + F.lane;
#pragma unroll
        for (int j = 0; j < 4; ++j) o8[64 * j] = (unsigned long long)pk2(v[j].x, v[j].y) | ((unsigned long long)pk2(v[j].z, v[j].w) << 32);
    }
    float* cs = (float*)(ws + WS_CS); const int* pos = (const int*)A.in[2];
    for (int i = gt; i < T * 8; i += NGT) { const int row = i >> 3, jj = i & 7;
        const float ang = (float)pos[row] * A.inv_freq[jj]; const double a = (double)ang;
        const double n = __builtin_rint(a * 0.15915494309189535); const double r = __builtin_fma(-n, 6.283185307179586, a) - n * 2.4492935982947064e-16;
        float s, c; sincos_red(r, s, c); cs[row * 16 + jj] = c; cs[row * 16 + 8 + jj] = s; }
}

__device__ __forceinline__ void convert_p(Frame& F, int L, bf16* pb) {
    const CAS Args& A = *F.a; const int gt = (F.vcu * NWAVES + F.wave) * 64 + F.lane, NGT = F.G * NWAVES * 64;
    const GAS f32x4* src = (const GAS f32x4*)(A.in[1] + (size_t)L * T * PLE); GAS v4u* dst = (GAS v4u*)pb;
    for (int i = gt; i < T * PLE / 8; i += NGT) { const f32x4 a = src[2 * i], b = src[2 * i + 1]; v4u o; o.x = pk2(a.x, a.y); o.y = pk2(a.z, a.w); o.z = pk2(b.x, b.y); o.w = pk2(b.z, b.w); dst[i] = o; }
}

__device__ __forceinline__ void scan_phase(Frame& F) {
    unsigned char* ws = F.a->ws; const float* flog = (const float*)(ws + WS_FLOG); float* ck = (float*)(ws + WS_CK);
    LAS float* wtot = (LAS float*)F.lds;
    for (int bh = blockIdx.x; bh < BATCH * NFH; bh += F.G) { const int b = bh >> 4, h = bh & 15, t0 = F.tid * 16;
        float v0, v1, v2, v3, v4, v5, v6, v7, v8, v9, v10, v11, v12, v13, v14, v15;
        const float* src = flog + ((size_t)b * SEQ + t0) * 16 + h;
        v0 = src[0]; v1 = v0 + src[16]; v2 = v1 + src[32]; v3 = v2 + src[48]; v4 = v3 + src[64]; v5 = v4 + src[80]; v6 = v5 + src[96]; v7 = v6 + src[112];
        v8 = v7 + src[128]; v9 = v8 + src[144]; v10 = v9 + src[160]; v11 = v10 + src[176]; v12 = v11 + src[192]; v13 = v12 + src[208]; v14 = v13 + src[224]; v15 = v14 + src[240];
        float incl = v15, tot = v15;
#define BSTEP(M) { const float pt = pg8::lane_xor<M>(tot); if (F.lane & M) incl += pt; tot += pt; }
        BSTEP(1) BSTEP(2) BSTEP(4) BSTEP(8) BSTEP(16)
#undef BSTEP
        { const float lowtot = __builtin_bit_cast(float, __builtin_amdgcn_readlane(__builtin_bit_cast(int, tot), 0)); if (F.lane & 32) incl += lowtot; }
        if (F.lane == 63) wtot[F.wave] = incl;
        LDS_WAIT(); __syncthreads();
        float base = incl - v15;
        for (int w = 0; w < F.wave; ++w) base += wtot[w];
        const float L2E = 1.4426950408889634f;
        f32x4* dst = (f32x4*)(ck + (size_t)bh * SEQ + t0);
        dst[0] = (f32x4){(v0 + base) * L2E, (v1 + base) * L2E, (v2 + base) * L2E, (v3 + base) * L2E};
        dst[1] = (f32x4){(v4 + base) * L2E, (v5 + base) * L2E, (v6 + base) * L2E, (v7 + base) * L2E};
        dst[2] = (f32x4){(v8 + base) * L2E, (v9 + base) * L2E, (v10 + base) * L2E, (v11 + base) * L2E};
        dst[3] = (f32x4){(v12 + base) * L2E, (v13 + base) * L2E, (v14 + base) * L2E, (v15 + base) * L2E};
        __syncthreads();
    }
}

__device__ __forceinline__ void combine_phase(Frame& F, int L, const bf16* O1, const bf16* O2, bf16* On) {
    const CAS Args& A = *F.a; const int gw = F.vcu * NWAVES + F.wave, NGW = F.G * NWAVES;
    const float lam_init = (L == 0) ? 0.2f : 0.35550906759096924f;
    const float* lp = A.in[5] + L * 4 * 64;
    const float s1 = wave_sum(lp[F.lane] * lp[64 + F.lane]), s2 = wave_sum(lp[128 + F.lane] * lp[192 + F.lane]);
    const float lam = expf(s1) - expf(s2) + lam_init;
    const float* gp = A.in[6] + L * 128 + 16 * (F.lane & 7);
    const f32x4 g0 = *(const f32x4*)gp, g1 = *(const f32x4*)(gp + 4), g2 = *(const f32x4*)(gp + 8), g3 = *(const f32x4*)(gp + 12);
    const float post = 1.0f - lam_init;
    for (int row = gw; row < T; row += NGW) {
        const size_t off = (size_t)row * D + 16 * F.lane;
        const v4u a0 = *(const GAS v4u*)(O1 + off), a1 = *(const GAS v4u*)(O1 + off + 8), b0 = *(const GAS v4u*)(O2 + off), b1 = *(const GAS v4u*)(O2 + off + 8);
        float o[16];
#define CB(k, aw, bw) o[2 * (k)] = __builtin_bit_cast(float, (aw) << 16) - lam * __builtin_bit_cast(float, (bw) << 16); o[2 * (k) + 1] = __builtin_bit_cast(float, (aw) & 0xffff0000u) - lam * __builtin_bit_cast(float, (bw) & 0xffff0000u);
        CB(0, a0.x, b0.x) CB(1, a0.y, b0.y) CB(2, a0.z, b0.z) CB(3, a0.w, b0.w) CB(4, a1.x, b1.x) CB(5, a1.y, b1.y) CB(6, a1.z, b1.z) CB(7, a1.w, b1.w)
#undef CB
        float ss = 0.f;
#pragma unroll
        for (int k = 0; k < 16; ++k) ss += o[k] * o[k];
        ss += pg8::lane_xor<1>(ss); ss += pg8::lane_xor<2>(ss); ss += pg8::lane_xor<4>(ss);
        const float rs = __builtin_amdgcn_rsqf(ss * (1.0f / 128.0f) + 1e-6f) * post;
        v4u w0, w1;
        w0.x = pk2(o[0] * rs * g0.x, o[1] * rs * g0.y); w0.y = pk2(o[2] * rs * g0.z, o[3] * rs * g0.w); w0.z = pk2(o[4] * rs * g1.x, o[5] * rs * g1.y); w0.w = pk2(o[6] * rs * g1.z, o[7] * rs * g1.w);
        w1.x = pk2(o[8] * rs * g2.x, o[9] * rs * g2.y); w1.y = pk2(o[10] * rs * g2.z, o[11] * rs * g2.w); w1.z = pk2(o[12] * rs * g3.x, o[13] * rs * g3.y); w1.w = pk2(o[14] * rs * g3.z, o[15] * rs * g3.w);
        *(GAS v4u*)(On + off) = w0; *(GAS v4u*)(On + off + 8) = w1;
    }
}

__device__ __forceinline__ void final_phase(Frame& F, float* h) {
    const CAS Args& A = *F.a; const int gw = F.vcu * NWAVES + F.wave, NGW = F.G * NWAVES;
    const GAS f32x4* gp = (const GAS f32x4*)A.in[20] + F.lane;
    const f32x4 g0 = gp[0], g1 = gp[64], g2 = gp[128], g3 = gp[192];
    for (int m = gw; m < T; m += NGW) {
        GAS f32x4* xr = (GAS f32x4*)(h + (size_t)m * D) + F.lane;
        f32x4 v0 = xr[0], v1 = xr[64], v2 = xr[128], v3 = xr[192];
        float s = (v0.x * v0.x + v0.y * v0.y) + (v0.z * v0.z + v0.w * v0.w); s += (v1.x * v1.x + v1.y * v1.y) + (v1.z * v1.z + v1.w * v1.w);
        s += (v2.x * v2.x + v2.y * v2.y) + (v2.z * v2.z + v2.w * v2.w); s += (v3.x * v3.x + v3.y * v3.y) + (v3.z * v3.z + v3.w * v3.w);
        const float rs = 1.0f / sqrtf(wave_sum(s) * (1.0f / D) + 1e-6f);
        xr[0] = v0 * rs * g0; xr[64] = v1 * rs * g1; xr[128] = v2 * rs * g2; xr[192] = v3 * rs * g3;
    }
}

template <bool BIAS> __device__ __forceinline__ void attn_phase(Frame& F, const bf16* Q, const bf16* K, const bf16* V, bf16* O1, bf16* O2, const float* ck) {
    using abf = attn_body::bf16;
    const int nslot = (BIAS ? BATCH * 16 : BATCH * 32) * 8;
    for (int sl = F.vcu; sl < nslot; sl += F.G) { const int bhv = sl >> 3, s = sl & 7;
        for (int k = 0; k < 4; ++k) { const int qb = (k == 0) ? s : (k == 1) ? 15 - s : (k == 2) ? 16 + s : 31 - s;
            if constexpr (BIAS) { const int b = bhv >> 4, h = bhv & 15;
                attn_body::attn_unit<8, true>(b, h * 64, h * 64, h * 64, h * 64, qb, (const abf*)Q, (const abf*)K, (const abf*)V, (abf*)O1, ck + (size_t)bhv * SEQ, (char*)F.lds);
            } else { const int b = bhv >> 5, vh = bhv & 31, h = vh >> 2, c = (vh >> 1) & 1, half = vh & 1;
                attn_body::attn_unit<8, false>(b, (2 * h + c) * 64, (2 * h + c) * 64, h * 128 + half * 64, h * 128 + half * 64, qb, (const abf*)Q, (const abf*)K, (const abf*)V, (abf*)(c ? O2 : O1), nullptr, (char*)F.lds); }
        }
    }
}

__global__ void __launch_bounds__(NWAVES * 64, 2) yoco_fwd(Args args) {
    extern __shared__ __attribute__((aligned(16))) unsigned char lds[];
    cg::grid_group grid = cg::this_grid();
    using pg8::Gemm; using pg8::StaticOrder; using pg8::EpiQKV; using pg8::EpiRes; using pg8::EpiBf; using pg8::gemm_phase;
    const size_t E64 = 64 * MiB / 2;
    const int ph_lo = args.ph_lo, ph_hi = args.ph_hi;
    if (ph_lo == 0) {
        const CAS Args* ap = (const CAS Args*)__builtin_amdgcn_kernarg_segment_ptr(); asm volatile("" : "+s"(ap));
        Frame F; F.a = ap; F.lds = (LAS unsigned char*)lds;
        { int t_ = threadIdx.x; asm volatile("" : "+v"(t_)); F.tid = t_; F.lane = t_ & 63; F.wave = __builtin_amdgcn_readfirstlane(t_ >> 6); }
        int bx = blockIdx.x, G_ = gridDim.x; asm volatile("" : "+s"(bx), "+s"(G_)); F.G = G_; F.vcu = (G_ % 8 == 0) ? (bx % 8) * (G_ / 8) + bx / 8 : bx;
        p0_prologue(F);
    }
    for (int ph = ph_lo; ph < ph_hi; ++ph) {
        const CAS Args* ap = (const CAS Args*)__builtin_amdgcn_kernarg_segment_ptr(); asm volatile("" : "+s"(ap));
        Frame F; F.a = ap; F.lds = (LAS unsigned char*)lds;
#define FRESH_TID() do { int t_ = threadIdx.x; asm volatile("" : "+v"(t_)); F.tid = t_; F.lane = t_ & 63; F.wave = __builtin_amdgcn_readfirstlane(t_ >> 6); } while (0)
        int bx = blockIdx.x, G_ = gridDim.x; asm volatile("" : "+s"(bx), "+s"(G_)); F.G = G_; F.vcu = (G_ % 8 == 0) ? (bx % 8) * (G_ / 8) + bx / 8 : bx;
        const int code = ap->prog[ph], kind = code & 255, L = (code >> 8) & 255, hf = (code >> 16) & 1, w2 = (code >> 17) & 1;
        unsigned char* ws = ap->ws; LAS unsigned char* ring = F.lds;
        float* rowss = (float*)(ws + WS_ROWSS); float* h = ap->out;
        bf16* hbX = (bf16*)(ws + WS_HBX); bf16* hbY = (bf16*)(ws + WS_HBY); bf16* R1 = (bf16*)(ws + WS_R1);
        int conv = -1;
        switch (kind) {
        case K_PRO: conv = 0; break;
        case K_QKVA: { Gemm g{hbX, (bf16*)(ws + W_QKV), T, 3 * D, D}; StaticOrder S; S.init(T, 3 * D, F.G, bx);
            EpiQKV<0> E{R1, E64, 2 * E64, rowss + (size_t)((3 * L) & 3) * T * 16, (const float*)(ws + WS_CS), nullptr, nullptr};
            gemm_phase<EpiQKV<0>, StaticOrder, PG8_ALIGN, PG8_SP2>(ring, g, S, E); } break;
        case K_ATTA: attn_phase<false>(F, R1, R1 + E64, R1 + 2 * E64, hbX, hbY, nullptr); break;
        case K_COMB: FRESH_TID(); combine_phase(F, L, hbX, hbY, R1 + 3 * E64); break;
        case K_QKVB: { const int N = (L == 2) ? 3 * D + 256 : D; Gemm g{hbX, (bf16*)(ws + W_QKV), T, N, D}; StaticOrder S; S.init(T, N, F.G, bx);
            EpiQKV<1> E{R1, 2 * E64, 3 * E64, rowss + (size_t)((3 * L) & 3) * T * 16, nullptr, (float*)(ws + WS_FLOG), ap->in[10]};
            gemm_phase<EpiQKV<1>, StaticOrder, PG8_ALIGN, PG8_SP2>(ring, g, S, E); } break;
        case K_SCAN: FRESH_TID(); scan_phase(F); break;
        case K_ATTB: attn_phase<true>(F, R1, R1 + 2 * E64, R1 + 3 * E64, R1, nullptr, (const float*)(ws + WS_CK)); break;
        case K_RES: {
            Gemm g{w2 ? R1 : (L < 2 ? R1 + 3 * E64 : R1), (bf16*)(ws + (w2 ? W_2 : W_O)), w2 ? TH : T, D, w2 ? FF : D}; StaticOrder S; S.init(g.M, D, F.G, bx);
            EpiRes<0> E{(!w2 && L == 0) ? ap->in[0] : h, h, w2 ? hbY : hbX, rowss + (size_t)((3 * L + 1 + w2) & 3) * T * 16, nullptr, nullptr, w2 ? hf * TH : 0};
            gemm_phase<EpiRes<0>, StaticOrder, PG8_ALIGN, PG8_SP2>(ring, g, S, E);
            if (!w2) { FRESH_TID(); convert_p(F, L, hbY); } } break;
        case K_W1: { { Gemm g{hbX + (size_t)hf * TH * D, (bf16*)(ws + W_1), TH, FF, D}; StaticOrder S; S.init(TH, FF, F.G, bx);
                EpiBf<1> E{R1, FF, rowss + (size_t)((3 * L + 1) & 3) * T * 16, hf * TH};
                gemm_phase<EpiBf<1>, StaticOrder, PG8_ALIGN, PG8_SP2>(ring, g, S, E); }
            if (hf == 0) { Gemm g2{hbY, (bf16*)(ws + W_PLE), T, D, PLE}; StaticOrder S2; S2.init(T, D, F.G, bx);
                EpiBf<0> E2{(bf16*)(ws + WS_PL), D, nullptr, 0};
                gemm_phase<EpiBf<0>, StaticOrder, PG8_ALIGN, PG8_SP2>(ring, g2, S2, E2); } } break;
        case K_GATE: { Gemm g{hbY, (bf16*)(ws + W_G + (size_t)(L & 1) * 2 * MiB), T, D, D}; StaticOrder S; S.init(T, D, F.G, bx);
            EpiRes<1> E{h, h, hbX, rowss + (size_t)((3 * L + 3) & 3) * T * 16, rowss + (size_t)((3 * L + 2) & 3) * T * 16, (const bf16*)(ws + WS_PL), 0};
            gemm_phase<EpiRes<1>, StaticOrder, PG8_ALIGN, PG8_SP2>(ring, g, S, E);
            if (L + 1 < DEPTH) conv = L + 1; } break;
        default: FRESH_TID(); final_phase(F, h); break;
        }
        if (conv >= 0) { FRESH_TID(); convert_layer(F, conv); }
        if (ph + 1 < ph_hi) grid.sync();
    }
}

static void build_prog(int* prog) {
    int n = 0; prog[n++] = K_PRO;
    for (int L = 0; L < DEPTH; ++L) {
        if (L < 2) { prog[n++] = K_QKVA | L << 8; prog[n++] = K_ATTA | L << 8; prog[n++] = K_COMB | L << 8; }
        else { prog[n++] = K_QKVB | L << 8; if (L == 2) prog[n++] = K_SCAN | L << 8; prog[n++] = K_ATTB | L << 8; }
        prog[n++] = K_RES | L << 8;
        for (int hf = 0; hf < 2; ++hf) { prog[n++] = K_W1 | L << 8 | hf << 16; prog[n++] = K_RES | L << 8 | hf << 16 | 1 << 17; }
        prog[n++] = K_GATE | L << 8;
    }
    prog[n++] = K_FIN;
    if (n != N_PHASES) fprintf(stderr, "build_prog: %d phases, N_PHASES %d\n", n, N_PHASES);
    while (n < N_PHASES + 1) prog[n++] = K_FIN;
}

extern "C" void kernel_launch(void* const* d_in, const int* in_sizes, int n_in, void* d_out, int out_size, void* d_ws, size_t ws_size, hipStream_t stream) {
    static int grid = 0;
    if (grid == 0) {
        if (n_in != 21 || out_size != T * D || ws_size < WS_END) { fprintf(stderr, "kernel_launch: unexpected problem (n_in %d out %d ws %zu)\n", n_in, out_size, ws_size); grid = -1; return; }
        int dev = 0, cus = 0, per_cu = 0;
        if (hipGetDevice(&dev) != hipSuccess || hipDeviceGetAttribute(&cus, hipDeviceAttributeMultiprocessorCount, dev) != hipSuccess) { grid = -1; return; }
        if (hipFuncSetAttribute((const void*)yoco_fwd, hipFuncAttributeMaxDynamicSharedMemorySize, LDS_BYTES) != hipSuccess) { fprintf(stderr, "kernel_launch: hipFuncSetAttribute failed\n"); grid = -1; return; }
        if (hipOccupancyMaxActiveBlocksPerMultiprocessor(&per_cu, (const void*)yoco_fwd, NWAVES * 64, LDS_BYTES) != hipSuccess || per_cu < 1) { fprintf(stderr, "kernel_launch: occupancy query says %d\n", per_cu); per_cu = 1; }
        (void)hipGetLastError();
        grid = cus;
    }
    if (grid < 0) return;
    Args a{};
    for (int i = 0; i < 21; ++i) a.in[i] = (const float*)d_in[i];
    a.out = (float*)d_out; a.ws = (unsigned char*)d_ws;
    for (int j = 0; j < 8; ++j) { const float p = powf(500000.0f, (float)(2 * j) / 16.0f); a.inv_freq[j] = 1.0f / p; }
    build_prog(a.prog);
#if MK_SPLIT
    for (int p = 0; p < N_PHASES; ++p) { a.ph_lo = p; a.ph_hi = p + 1; hipLaunchKernelGGL(yoco_fwd, dim3(grid), dim3(NWAVES * 64), LDS_BYTES, stream, a); }
#else
    a.ph_lo = 0; a.ph_hi = N_PHASES;
    void* kargs[] = {&a};
    const hipError_t e = hipLaunchCooperativeKernel((const void*)yoco_fwd, dim3(grid), dim3(NWAVES * 64), kargs, LDS_BYTES, stream);
    if (e != hipSuccess) fprintf(stderr, "kernel_launch: cooperative launch failed: %s (grid %d)\n", hipGetErrorString(e), grid);
#endif
}
```

```cpp
#include <hip/hip_runtime.h>
#include <cstdio>
#include <cstdint>
namespace pg8 {
#define PG8_LAS __attribute__((address_space(3)))
typedef unsigned short bf16_t;
typedef short bf16x8 __attribute__((ext_vector_type(8)));
typedef float f32x4 __attribute__((ext_vector_type(4)));
typedef unsigned u32x4 __attribute__((ext_vector_type(4)));
constexpr int BM = 256, BK = 64, HALF = 128, HTB = HALF * BK * 2  , STAGE_BYTES = 8 * HTB, NXCD = 8, WGM = 8;

__host__ __device__ __forceinline__ int lds_byte(int r, int c) { const int st = (r >> 4) * 2 + (c >> 5), rr = r & 15, cc = c & 31, ob = rr * 64 + cc * 2; return st * 1024 + (ob ^ (((ob >> 9) & 1) << 5)); }
__host__ __device__ __forceinline__ void stage_rc(int b, int& R, int& C) { const int st = b / 1024, sb = b % 1024, swz = sb ^ (((sb >> 9) & 1) << 5); R = (st >> 1) * 16 + swz / 64; C = (st & 1) * 32 + (swz % 64) / 2; }
__host__ __device__ __forceinline__ int perm32(int rho) { const int n = rho >> 4, i = rho & 15; return 8 * (i >> 2) + 4 * n + (i & 3); }

struct Unit { int pm, pn; };
struct Gemm { const bf16_t* A; const bf16_t* Bt; int M, N, K; };

struct StaticOrder {
    int nM, nN, nwg, G, c;
    __host__ __device__ void init(int M, int N, int G_, int c_) { nM = M / BM; nN = N / BM; nwg = nM * nN; G = G_; c = c_; }
    __host__ __device__ bool next(int i, Unit& u) const {
        const long L = (long)i * G + c; if (L >= nwg) return false;
        int wgid = (int)L; { const int q = nwg / NXCD, r = nwg % NXCD, xcd = wgid % NXCD, off = wgid / NXCD; wgid = (xcd < r ? xcd * (q + 1) : r * (q + 1) + (xcd - r) * q) + off; }
        const int nig = WGM * nN, gid = wgid / nig, fm = gid * WGM, gsz = (nM - fm) < WGM ? (nM - fm) : WGM;
        u.pm = fm + ((wgid % nig) % gsz); u.pn = (wgid % nig) / gsz; return true;
    }
    __device__ __forceinline__ void a_ready(const Unit&) const {}
    __device__ __forceinline__ void done(const Unit&) const {}
};

__device__ __forceinline__ unsigned cvt_pk_bf16(float lo, float hi) { unsigned r; asm volatile("v_cvt_pk_bf16_f32 %0, %1, %2" : "=v"(r) : "v"(lo), "v"(hi)); return r; }
typedef float f32x2 __attribute__((ext_vector_type(2)));
template <int M> __device__ __forceinline__ float lane_xor(float v) { return __builtin_bit_cast(float, __builtin_amdgcn_ds_swizzle(__builtin_bit_cast(int, v), 0x1f | (M << 10))); }
__device__ __forceinline__ float half_sum(float v) { auto rr = __builtin_amdgcn_permlane32_swap(__float_as_uint(v), __float_as_uint(v), false, false); return __uint_as_float(rr[0]) + __uint_as_float(rr[1]); }
typedef float f32x2 __attribute__((ext_vector_type(2)));
typedef unsigned u32x2 __attribute__((ext_vector_type(2)));
constexpr float QK_C2 = 0.125f * 1.4426950408889634f;
__device__ __forceinline__ float rstd_of(const float* rowss, int row) { const f32x4* p = (const f32x4*)(rowss + (size_t)row * 16); const f32x4 a = p[0], b = p[1], c = p[2], d = p[3];
    const float s = (((a[0] + a[1]) + (a[2] + a[3])) + ((b[0] + b[1]) + (b[2] + b[3]))) + (((c[0] + c[1]) + (c[2] + c[3])) + ((d[0] + d[1]) + (d[2] + d[3]))); return __builtin_amdgcn_rsqf(s * (1.0f / 1024.0f) + 1e-6f); }
__device__ __forceinline__ float bf2f(unsigned short b) { return __builtin_bit_cast(float, (unsigned)b << 16); }

template <int ACT  > struct EpiBf {
    static constexpr bool PERM = true, AFTER_DRAIN = false;
    bf16_t* O; int ldc; const float* rowss; int row_off;
    __device__ __forceinline__ void operator()(const f32x4 (&acc)[2][2][4][2], const Unit& u, int wr, int wc, int fr, int fq) const {
        const int row0 = u.pm * BM + wr * 64 + fr, col0 = u.pn * BM + wc * 32 + 8 * fq;
#pragma unroll
        for (int ai = 0; ai < 2; ++ai)
#pragma unroll
            for (int m = 0; m < 4; ++m) { const int rl = row0 + ai * HALF + m * 16; const float rs = rowss ? rstd_of(rowss, row_off + rl) : 1.0f; bf16_t* rowp = O + (size_t)rl * ldc + col0;
#pragma unroll
                for (int bj = 0; bj < 2; ++bj) { f32x4 v0 = acc[ai][bj][m][0] * rs, v1 = acc[ai][bj][m][1] * rs;
                    if (ACT == 1) {
#pragma unroll
                        for (int i = 0; i < 4; ++i) { const float a = __builtin_fmaxf(v0[i], 0.f), b = __builtin_fmaxf(v1[i], 0.f); v0[i] = a * a; v1[i] = b * b; } }
                    u32x4 w; w.x = cvt_pk_bf16(v0[0], v0[1]); w.y = cvt_pk_bf16(v0[2], v0[3]); w.z = cvt_pk_bf16(v1[0], v1[1]); w.w = cvt_pk_bf16(v1[2], v1[3]);
                    *(u32x4*)(rowp + bj * HALF) = w; } }
    }
};

template <int MODE> struct EpiQKV {
    static constexpr bool PERM = true, AFTER_DRAIN = false;
    bf16_t* O; size_t offK, offV; const float* rowss; const float* cs; float* flog; const float* bfg;
    __device__ __forceinline__ void operator()(const f32x4 (&acc)[2][2][4][2], const Unit& u, int wr, int wc, int fr, int fq) const {
        const int colt = u.pn * BM, t = colt >> 10, cl = colt & 1023;
        const int row0 = u.pm * BM + wr * 64 + fr;
        if (MODE == 1 && t == 3) {
            if (wc == 0 && fq < 2) {
                const f32x4 b0 = *(const f32x4*)(bfg + 8 * fq), b1 = *(const f32x4*)(bfg + 8 * fq + 4);
#pragma unroll
                for (int ai = 0; ai < 2; ++ai)
#pragma unroll
                    for (int m = 0; m < 4; ++m) { const int row = row0 + ai * HALF + m * 16; const float rs = rstd_of(rowss, row);
                        f32x4 v0 = acc[ai][0][m][0] * rs + b0, v1 = acc[ai][0][m][1] * rs + b1;
#pragma unroll
                        for (int i = 0; i < 4; ++i) { v0[i] = __builtin_fminf(v0[i], 0.f) - log1pf(__expf(-__builtin_fabsf(v0[i]))); v1[i] = __builtin_fminf(v1[i], 0.f) - log1pf(__expf(-__builtin_fabsf(v1[i]))); }
                        *(f32x4*)(flog + (size_t)row * 16 + 8 * fq) = v0; *(f32x4*)(flog + (size_t)row * 16 + 8 * fq + 4) = v1; }
            }
            return;
        }
        bf16_t* base = O + ((t == 0) ? (size_t)0 : (t == 1) ? offK : offV); const float sc = (t == 0) ? QK_C2 : 1.0f;
        const bool rope = (MODE == 0) && (t < 2) && !(wc & 1);
        const float sgn = (fq == 0) ? -1.0f : 1.0f;
        const int col0 = cl + wc * 32 + 8 * fq;
#pragma unroll
        for (int ai = 0; ai < 2; ++ai)
#pragma unroll
            for (int m = 0; m < 4; ++m) { const int row = row0 + ai * HALF + m * 16; const float rs = rstd_of(rowss, row); bf16_t* rowp = base + (size_t)row * 1024 + col0;
                f32x4 c0, c1, s0, s1;
                if (rope) { const float* cp = cs + (size_t)row * 16; c0 = *(const f32x4*)(cp); c1 = *(const f32x4*)(cp + 4); s0 = *(const f32x4*)(cp + 8) * sgn; s1 = *(const f32x4*)(cp + 12) * sgn; }
#pragma unroll
                for (int bj = 0; bj < 2; ++bj) { f32x4 v0 = acc[ai][bj][m][0] * rs, v1 = acc[ai][bj][m][1] * rs;
                    if (rope) { f32x4 p0, p1;
#pragma unroll
                        for (int i = 0; i < 4; ++i) { p0[i] = lane_xor<16>(v0[i]); p1[i] = lane_xor<16>(v1[i]); }
                        const f32x4 r0 = v0 * c0 + p0 * s0, r1 = v1 * c1 + p1 * s1;
                        if (fq < 2) { v0 = r0; v1 = r1; } }
                    v0 = v0 * sc; v1 = v1 * sc;
                    u32x4 w; w.x = cvt_pk_bf16(v0[0], v0[1]); w.y = cvt_pk_bf16(v0[2], v0[3]); w.z = cvt_pk_bf16(v1[0], v1[1]); w.w = cvt_pk_bf16(v1[2], v1[3]);
                    *(u32x4*)(rowp + bj * HALF) = w; } }
    }
};

template <int MODE> struct EpiRes {
    static constexpr bool PERM = false, AFTER_DRAIN = false;
    const float* res; float* hout; bf16_t* hb; float* rowss_out; const float* rowss_in; const bf16_t* pl; int row_off;
    __device__ __forceinline__ void operator()(const f32x4 (&acc)[2][2][4][2], const Unit& u, int wr, int wc, int fr, int fq) const {
        const int col0 = u.pn * BM + wc * 32 + 4 * fq;
#pragma unroll
        for (int ai = 0; ai < 2; ++ai)
#pragma unroll
            for (int m = 0; m < 4; ++m) { const int row = row_off + u.pm * BM + ai * HALF + wr * 64 + m * 16 + fr; const size_t off = (size_t)row * 1024 + col0;
                float rs = 0.f; if (MODE == 1) rs = rstd_of(rowss_in, row);
                float ss = 0.f;
#pragma unroll
                for (int bj = 0; bj < 2; ++bj)
#pragma unroll
                    for (int n = 0; n < 2; ++n) { const size_t c = off + bj * HALF + n * 16; const f32x4 r = *(const f32x4*)(res + c); const f32x4 a = acc[ai][bj][m][n]; f32x4 o;
                        if (MODE == 1) { const u32x2 pw = *(const u32x2*)(pl + c);
                            const float p0 = __builtin_bit_cast(float, pw.x << 16), p1 = __builtin_bit_cast(float, pw.x & 0xffff0000u), p2 = __builtin_bit_cast(float, pw.y << 16), p3 = __builtin_bit_cast(float, pw.y & 0xffff0000u);
                            const f32x4 pv = (f32x4){p0, p1, p2, p3};
#pragma unroll
                            for (int i = 0; i < 4; ++i) { const float g = __builtin_amdgcn_rcpf(1.0f + __builtin_amdgcn_exp2f(-a[i] * rs * 1.4426950408889634f)); o[i] = r[i] + pv[i] * g; }
                        } else o = r + a;
                        *(f32x4*)(hout + c) = o; u32x2 w; w.x = cvt_pk_bf16(o[0], o[1]); w.y = cvt_pk_bf16(o[2], o[3]); *(u32x2*)(hb + c) = w;
                        ss += (o[0] * o[0] + o[1] * o[1]) + (o[2] * o[2] + o[3] * o[3]); }
                ss += lane_xor<16>(ss); ss = half_sum(ss);
                if (fq == 0) rowss_out[(size_t)row * 16 + u.pn * 4 + wc] = ss;
            }
    }
};
template <class Epi, class Sched, bool ALIGN_EPI = false, bool SP2 = false>
__device__ __forceinline__ void gemm_phase(PG8_LAS unsigned char* lds, const Gemm g, const Sched& S, const Epi& E) {
    int tid_ = threadIdx.x; asm volatile("" : "+v"(tid_));
    const int tid = tid_, wid = __builtin_amdgcn_readfirstlane(tid >> 6), lane = tid & 63, wr = wid >> 2, wc = wid & 3, fr = lane & 15, fq = lane >> 4;
    const int K = g.K, nt = K / BK;
    unsigned voffA[2], voffB[2];
#pragma unroll
    for (int i = 0; i < 2; ++i) { int R, C; stage_rc(tid * 16 + i * 8192, R, C); const int Rb = Epi::PERM ? ((R & ~31) + perm32(R & 31)) : R;
        voffA[i] = (unsigned)(R * K + C) * 2u; voffB[i] = (unsigned)(Rb * K + C) * 2u; }
    const size_t kstep = (size_t)(BK * 2);
    const size_t hstep = (size_t)HALF * K * 2;
    const size_t tstep = 2 * hstep;
    const unsigned ldsw = (unsigned)wid * 1024u;
    const int aoff = lds_byte(wr * 64 + fr, fq * 8), boff = lds_byte(wc * 32 + fr, fq * 8);
#define PG8_SA(b, h) (((b) * 2 + (h)) * HTB)
#define PG8_SB(b, h) ((4 + (b) * 2 + (h)) * HTB)
#define PG8_STAGE(bufoff, gbase, voff) do { _Pragma("unroll") for (int _i = 0; _i < 2; ++_i) \
        __builtin_amdgcn_global_load_lds((const unsigned*)((const char*)(gbase) + (voff)[_i]), (PG8_LAS unsigned*)(lds + (bufoff) + ldsw + _i * 8192), 16, 0, 0); } while (0)
#define PG8_LDA(dst, b, h) do { _Pragma("unroll") for (int m = 0; m < 4; ++m) _Pragma("unroll") for (int k = 0; k < 2; ++k) dst[m][k] = *(const PG8_LAS bf16x8*)(lds + PG8_SA(b, h) + aoff + m * 2048 + k * 1024); } while (0)
#define PG8_LDB(dst, b, h) do { _Pragma("unroll") for (int n = 0; n < 2; ++n) _Pragma("unroll") for (int k = 0; k < 2; ++k) dst[n][k] = *(const PG8_LAS bf16x8*)(lds + PG8_SB(b, h) + boff + n * 2048 + k * 1024); } while (0)
#define PG8_MMA(ai, bj, At, Bt) do { __builtin_amdgcn_s_setprio(1); _Pragma("unroll") for (int m = 0; m < 4; ++m) _Pragma("unroll") for (int n = 0; n < 2; ++n) _Pragma("unroll") for (int k = 0; k < 2; ++k) \
        acc[ai][bj][m][n] = __builtin_amdgcn_mfma_f32_16x16x32_bf16(Bt[n][k], At[m][k], acc[ai][bj][m][n], 0, 0, 0); __builtin_amdgcn_s_setprio(0); } while (0)
#define PG8_WAIT_V(n) asm volatile("s_waitcnt vmcnt(" #n ")" ::: "memory")
#define PG8_WAIT_L(n) asm volatile("s_waitcnt lgkmcnt(" #n ")" ::: "memory")
#define PG8_BAR __builtin_amdgcn_s_barrier()
#define PG8_SCHED __builtin_amdgcn_sched_barrier(0)
    Unit cur, nxt; int ui = 0;
    if (!S.next(0, cur)) return;
    f32x4 acc[2][2][4][2];
#pragma unroll
    for (int a = 0; a < 2; ++a)
#pragma unroll
        for (int b = 0; b < 2; ++b)
#pragma unroll
            for (int m = 0; m < 4; ++m)
#pragma unroll
                for (int n = 0; n < 2; ++n) acc[a][b][m][n] = (f32x4){0.f, 0.f, 0.f, 0.f};
    bf16x8 At[4][2], B0[2][2], B1[2][2];
    const char* cA = (const char*)g.A + (size_t)cur.pm * tstep; const char* cB = (const char*)g.Bt + (size_t)cur.pn * tstep;
    S.a_ready(cur);
    if constexpr (SP2) {
        PG8_STAGE(PG8_SB(0, 0), cB, voffB); PG8_STAGE(PG8_SB(0, 1), cB + hstep, voffB); PG8_STAGE(PG8_SA(0, 0), cA, voffA); PG8_STAGE(PG8_SA(0, 1), cA + hstep, voffA);
        if (wr == 1) PG8_BAR;
        PG8_WAIT_V(2); PG8_BAR;
        PG8_STAGE(PG8_SB(1, 0), cB + kstep, voffB); PG8_STAGE(PG8_SA(1, 0), cA + kstep, voffA); PG8_STAGE(PG8_SB(1, 1), cB + hstep + kstep, voffB);
        PG8_WAIT_V(6); PG8_BAR;
    } else {
        PG8_STAGE(PG8_SB(0, 0), cB, voffB); PG8_STAGE(PG8_SA(0, 0), cA, voffA); PG8_STAGE(PG8_SB(0, 1), cB + hstep, voffB); PG8_STAGE(PG8_SA(0, 1), cA + hstep, voffA);
        if (wr == 1) PG8_BAR;
        PG8_WAIT_V(4); PG8_BAR;
        PG8_STAGE(PG8_SB(1, 0), cB + kstep, voffB); PG8_STAGE(PG8_SA(1, 0), cA + kstep, voffA); PG8_STAGE(PG8_SB(1, 1), cB + hstep + kstep, voffB);
        PG8_WAIT_V(6); PG8_BAR;
    }
    for (;;) {
        const bool has_next = S.next(ui + 1, nxt);
        const char* nA = has_next ? (const char*)g.A + (size_t)nxt.pm * tstep : cA; const char* nB = has_next ? (const char*)g.Bt + (size_t)nxt.pn * tstep : cB;
        for (int t = 0; t < nt; t += 2) {
            const bool last = (t == nt - 2);
            const char* a1 = cA + (size_t)(t + 1) * kstep;
            const char* a2 = last ? nA : cA + (size_t)(t + 2) * kstep; const char* b2 = last ? nB : cB + (size_t)(t + 2) * kstep;
            const char* a3 = a2 + kstep; const char* b3 = b2 + kstep;
            if (last && has_next) S.a_ready(nxt);
            if constexpr (SP2) {
            PG8_LDB(B0, 0, 0); PG8_LDB(B1, 0, 1); PG8_SCHED; PG8_LDA(At, 0, 0); PG8_STAGE(PG8_SA(1, 1), a1 + hstep, voffA);
            PG8_WAIT_V(8); PG8_WAIT_L(0); PG8_BAR; PG8_MMA(0, 0, At, B0); PG8_MMA(0, 1, At, B1); PG8_BAR; PG8_SCHED;
            PG8_LDA(At, 0, 1); PG8_STAGE(PG8_SB(0, 0), b2, voffB); PG8_STAGE(PG8_SB(0, 1), b2 + hstep, voffB); PG8_STAGE(PG8_SA(0, 0), a2, voffA);
            PG8_WAIT_V(8); PG8_WAIT_L(0); PG8_BAR; PG8_MMA(1, 0, At, B0); PG8_MMA(1, 1, At, B1); PG8_BAR; PG8_SCHED;
            PG8_LDB(B0, 1, 0); PG8_LDB(B1, 1, 1); PG8_SCHED; PG8_LDA(At, 1, 0); PG8_STAGE(PG8_SA(0, 1), a2 + hstep, voffA);
            PG8_WAIT_V(8); PG8_WAIT_L(0); PG8_BAR; PG8_MMA(0, 0, At, B0); PG8_MMA(0, 1, At, B1); PG8_BAR; PG8_SCHED;
            PG8_LDA(At, 1, 1); PG8_STAGE(PG8_SB(1, 0), b3, voffB); PG8_STAGE(PG8_SB(1, 1), b3 + hstep, voffB); PG8_STAGE(PG8_SA(1, 0), a3, voffA);
            PG8_WAIT_V(8); PG8_WAIT_L(0); PG8_BAR; PG8_MMA(1, 0, At, B0); PG8_MMA(1, 1, At, B1); PG8_BAR; PG8_SCHED;
            } else {
            PG8_LDB(B0, 0, 0); PG8_SCHED; PG8_LDA(At, 0, 0); PG8_STAGE(PG8_SA(1, 1), a1 + hstep, voffA);
            PG8_WAIT_L(8); PG8_BAR; PG8_WAIT_L(0); PG8_MMA(0, 0, At, B0); PG8_BAR; PG8_SCHED;
            PG8_LDB(B1, 0, 1); PG8_STAGE(PG8_SB(0, 0), b2, voffB);
            PG8_BAR; PG8_WAIT_L(0); PG8_MMA(0, 1, At, B1); PG8_BAR;
            PG8_LDA(At, 0, 1); PG8_STAGE(PG8_SA(0, 0), a2, voffA);
            PG8_BAR; PG8_WAIT_L(0); PG8_MMA(1, 0, At, B0); PG8_BAR; PG8_SCHED;
            PG8_STAGE(PG8_SB(0, 1), b2 + hstep, voffB);
            PG8_WAIT_V(6); PG8_BAR; PG8_MMA(1, 1, At, B1); PG8_BAR;
            PG8_LDB(B0, 1, 0); PG8_SCHED; PG8_LDA(At, 1, 0); PG8_STAGE(PG8_SA(0, 1), a2 + hstep, voffA);
            PG8_WAIT_L(8); PG8_BAR; PG8_WAIT_L(0); PG8_MMA(0, 0, At, B0); PG8_BAR; PG8_SCHED;
            PG8_LDB(B1, 1, 1); PG8_STAGE(PG8_SB(1, 0), b3, voffB);
            PG8_BAR; PG8_WAIT_L(0); PG8_MMA(0, 1, At, B1); PG8_BAR;
            PG8_LDA(At, 1, 1); PG8_STAGE(PG8_SA(1, 0), a3, voffA);
            PG8_BAR; PG8_WAIT_L(0); PG8_MMA(1, 0, At, B0); PG8_BAR; PG8_SCHED;
            PG8_STAGE(PG8_SB(1, 1), b3 + hstep, voffB);
            PG8_WAIT_V(6); PG8_BAR; PG8_MMA(1, 1, At, B1); PG8_BAR;
            }
        }
        if constexpr (ALIGN_EPI) { if (wr == 0) PG8_BAR; }
        if constexpr (!Epi::AFTER_DRAIN) { E(acc, cur, wr, wc, fr, fq); S.done(cur); }
        if (!has_next) break;
#pragma unroll
        for (int a = 0; a < 2; ++a)
#pragma unroll
            for (int b = 0; b < 2; ++b)
#pragma unroll
                for (int m = 0; m < 4; ++m)
#pragma unroll
                    for (int n = 0; n < 2; ++n) acc[a][b][m][n] = (f32x4){0.f, 0.f, 0.f, 0.f};
        cur = nxt; cA = nA; cB = nB; ++ui;
        if constexpr (ALIGN_EPI) { if (wr == 1) PG8_BAR; }
    }
    PG8_WAIT_V(0);
    if constexpr (!ALIGN_EPI) { if (wr == 0) PG8_BAR; }
    PG8_BAR;
    if constexpr (Epi::AFTER_DRAIN) { E.fused(acc, cur, wr, wc, fr, fq, lds, wid, lane); S.done(cur); }
#undef PG8_SA
#undef PG8_SB
#undef PG8_STAGE
#undef PG8_LDA
#undef PG8_LDB
#undef PG8_MMA
#undef PG8_WAIT_V
#undef PG8_WAIT_L
#undef PG8_BAR
#undef PG8_SCHED
}
}

#ifndef PG8_SP2
#define PG8_SP2 true
#endif
#ifndef PG8_ALIGN
#define PG8_ALIGN true
#endif
#include <hip/hip_bf16.h>
#include <cmath>
namespace attn_body {
using bf16=__hip_bfloat16;
using bf16x8=__attribute__((ext_vector_type(8)))short;
using s16x4=__attribute__((ext_vector_type(4)))short;
using f32x16=__attribute__((ext_vector_type(16)))float;
using u32x4=__attribute__((ext_vector_type(4)))unsigned;
constexpr int BATCH=4,NHEAD=16,SEQ=8192,D=64,DM=NHEAD*D;
constexpr int NW=8,QBLK=32,QB=QBLK*NW,KVBLK=64,NQB=SEQ/QB;
constexpr int ATTN_PITCH=DM, ATTN_UNIT_ROWS=QB;
__device__ __forceinline__ int crow(int r,int hi){return (r&3)+8*(r>>2)+4*hi;}
#define SBAR() __builtin_amdgcn_sched_barrier(0)
__device__ __forceinline__ void cmask(f32x16&p0,f32x16&p1,int jb,int qrel,int hi){
  const float NEG=-INFINITY; int kb=64*jb+4*hi;
  #pragma unroll
  for(int r=0;r<16;++r){int kv=kb+(r&3)+8*(r>>2); if(kv>qrel)p0[r]=NEG; if(kv+32>qrel)p1[r]=NEG;}
}

constexpr int NSLOT=3, SLOTB=8192;
constexpr int LDS_K=0, LDS_V=NSLOT*SLOTB, LDS_WS=2*NSLOT*SLOTB, LDS_OST=LDS_WS+NW*64*4, LDS_BIAS=LDS_OST+NW*4096  , LDS_BYTES=LDS_BIAS+32768;
constexpr float C2=0.125f*1.4426950408889634f;
__device__ __forceinline__ void glds16(const void*gsrc,unsigned lds_dst){unsigned keep;
  asm volatile("s_mov_b32 %0, m0\n\ts_mov_b32 m0, %2\n\ts_nop 0\n\tglobal_load_lds_dwordx4 %1, off\n\ts_mov_b32 m0, %0":"=&s"(keep):"v"(gsrc),"s"(lds_dst):"memory");}
__device__ __forceinline__ float max3f(float a,float b,float c){float r;asm("v_max3_f32 %0, %1, %2, %3":"=v"(r):"v"(a),"v"(b),"v"(c));return r;}
__device__ __forceinline__ float max2f(float a,float b){float r;asm("v_max_f32_e32 %0, %1, %2":"=v"(r):"v"(a),"v"(b));return r;}
__device__ __forceinline__ float fadd_s(float a,float b){float r;asm("v_add_f32_e32 %0, %1, %2":"=v"(r):"v"(a),"v"(b));return r;}
__device__ __forceinline__ float fsub_s(float a,float b){float r;asm("v_sub_f32_e32 %0, %1, %2":"=v"(r):"v"(a),"v"(b));return r;}
typedef float f32x2_t __attribute__((ext_vector_type(2))); typedef __bf16 bf16x2_t __attribute__((ext_vector_type(2)));
__device__ __forceinline__ unsigned cvtpk_s(float lo,float hi){f32x2_t v={lo,hi};bf16x2_t b=__builtin_convertvector(v,bf16x2_t);return __builtin_bit_cast(unsigned,b);}
#define WAIT_BAR(N) asm volatile("s_waitcnt vmcnt(" #N ") lgkmcnt(0)\n\ts_barrier":::"memory")

template<bool ACCUM> __device__ __forceinline__ void qkt(f32x16&p0,f32x16&p1,const char*Kslot,const bf16x8*qr,const f32x16&negm,int r32,int hi){
  const char*kb=Kslot+hi*1024+r32*16;
  #pragma unroll
  for(int d0=0;d0<4;++d0){
    const bf16x8 b0=*reinterpret_cast<const bf16x8*>(kb+d0*2048);
    const bf16x8 b1=*reinterpret_cast<const bf16x8*>(kb+d0*2048+512);
    if(d0==0&&!ACCUM){p0=__builtin_amdgcn_mfma_f32_32x32x16_bf16(b0,qr[0],negm,0,0,0);p1=__builtin_amdgcn_mfma_f32_32x32x16_bf16(b1,qr[0],negm,0,0,0);}
    else{p0=__builtin_amdgcn_mfma_f32_32x32x16_bf16(b0,qr[d0],p0,0,0,0);p1=__builtin_amdgcn_mfma_f32_32x32x16_bf16(b1,qr[d0],p1,0,0,0);}}
}
typedef __attribute__((address_space(3))) const char* lds_cptr;
typedef short v4i16_t __attribute__((ext_vector_type(4)));
__device__ __forceinline__ void kload8(bf16x8*kf,lds_cptr kp){
  kf[0]=*(const __attribute__((address_space(3))) bf16x8*)(kp);      kf[1]=*(const __attribute__((address_space(3))) bf16x8*)(kp+512);
  kf[2]=*(const __attribute__((address_space(3))) bf16x8*)(kp+2048); kf[3]=*(const __attribute__((address_space(3))) bf16x8*)(kp+2560);
  kf[4]=*(const __attribute__((address_space(3))) bf16x8*)(kp+4096); kf[5]=*(const __attribute__((address_space(3))) bf16x8*)(kp+4608);
  kf[6]=*(const __attribute__((address_space(3))) bf16x8*)(kp+6144); kf[7]=*(const __attribute__((address_space(3))) bf16x8*)(kp+6656);
}
__device__ __forceinline__ void kload2(bf16x8*kf,lds_cptr kp,int j){ kf[2*j]=*(const __attribute__((address_space(3))) bf16x8*)(kp+j*2048); kf[2*j+1]=*(const __attribute__((address_space(3))) bf16x8*)(kp+j*2048+512); }
__device__ __forceinline__ s16x4 vtr(lds_cptr p){ return __builtin_bit_cast(s16x4,__builtin_amdgcn_ds_read_tr16_b64_v4i16((__attribute__((address_space(3))) v4i16_t*)p)); }
__device__ __forceinline__ float rowmax(const f32x16&p0,const f32x16&p1){
  float a=max3f(p0[0],p0[1],p1[0]),b=max3f(p0[2],p0[3],p1[1]);a=max3f(a,p1[2],p1[3]);
  #pragma unroll
  for(int r=4;r<16;r+=4){a=max3f(a,p0[r],p0[r+1]);b=max3f(b,p0[r+2],p0[r+3]);a=max3f(a,p1[r],p1[r+1]);b=max3f(b,p1[r+2],p1[r+3]);}
  const float m=max2f(a,b);
  auto rr=__builtin_amdgcn_permlane32_swap(__float_as_uint(m),__float_as_uint(m),false,false);
  return max2f(__uint_as_float(rr[0]),__uint_as_float(rr[1]));
}
__device__ __forceinline__ void pv(f32x16*o,int vb,bf16x8 pa0,bf16x8 pa1,bf16x8 pa2,bf16x8 pa3){
  #pragma unroll
  for(int d0=0;d0<2;++d0){s16x4 lo[4],hi[4];
    #pragma unroll
    for(int ks=0;ks<4;++ks){
      asm volatile("ds_read_b64_tr_b16 %0,%1 offset:%c2":"=&v"(lo[ks]):"v"(vb),"i"(d0*4096+ks*1024):"memory");
      asm volatile("ds_read_b64_tr_b16 %0,%1 offset:%c2":"=&v"(hi[ks]):"v"(vb),"i"(d0*4096+ks*1024+512):"memory");}
    asm volatile("s_waitcnt lgkmcnt(0)":::"memory");SBAR();
    #define PK(k) (bf16x8){lo[k][0],lo[k][1],lo[k][2],lo[k][3],hi[k][0],hi[k][1],hi[k][2],hi[k][3]}
    o[d0]=__builtin_amdgcn_mfma_f32_32x32x16_bf16(pa0,PK(0),o[d0],0,0,0);
    o[d0]=__builtin_amdgcn_mfma_f32_32x32x16_bf16(pa1,PK(1),o[d0],0,0,0);
    o[d0]=__builtin_amdgcn_mfma_f32_32x32x16_bf16(pa2,PK(2),o[d0],0,0,0);
    o[d0]=__builtin_amdgcn_mfma_f32_32x32x16_bf16(pa3,PK(3),o[d0],0,0,0);
    #undef PK
  }
}

#ifndef ATTN_STORE16
#define ATTN_STORE16(p,v) (*(u32x4*)(p)=(v))
#endif
typedef float f32x4b __attribute__((ext_vector_type(4)));
__device__ __forceinline__ void binit(f32x16&c0,f32x16&c1,lds_cptr bp,float nm){
  #pragma unroll
  for(int g=0;g<4;++g){ const f32x4b a=*(const __attribute__((address_space(3))) f32x4b*)(bp+g*32); const f32x4b bb=*(const __attribute__((address_space(3))) f32x4b*)(bp+128+g*32);
    #pragma unroll
    for(int i=0;i<4;++i){ c0[4*g+i]=nm-a[i]; c1[4*g+i]=nm-bb[i]; } }
}
template<int THRL,bool BIAS> __device__ __forceinline__ void attn_unit(int b,int cq,int ck,int cv,int co,int qb,const bf16*Q,const bf16*__restrict__ K,const bf16*__restrict__ V,bf16*O,const float*cb,char*shm){
  int tid_=threadIdx.x; asm volatile("":"+v"(tid_)); const int tid=tid_,lane=tid&63,r32=lane&31,hi=lane>>5; const int wid=__builtin_amdgcn_readfirstlane(tid>>6);
  const long rowbase=(long)b*SEQ; const int q0=qb*QB;
  const bf16*Qw=Q+(rowbase+q0+wid*QBLK)*DM+cq;
  const bf16*Kh=K+rowbase*DM+ck,*Vh=V+rowbase*DM+cv;
  const unsigned lds0=(unsigned)(uintptr_t)shm;
  float*wsf=(float*)(shm+LDS_WS)+wid*64;
  const bf16*ksrc=Kh+(long)lane*DM+wid*8;
  const bf16*vsrc=Vh+(long)(16*(wid&3)+(lane>>2))*DM+(wid>>2)*32+(lane&3)*8;
  const unsigned kdst=lds0+LDS_K+wid*1024, vdst=lds0+LDS_V+wid*1024;
  #define DMA_K(t,slot) glds16(ksrc+(long)(t)*KVBLK*DM,(unsigned)__builtin_amdgcn_readfirstlane(kdst+(slot)))
  #define DMA_V(t,slot) glds16(vsrc+(long)(t)*KVBLK*DM,(unsigned)__builtin_amdgcn_readfirstlane(vdst+(slot)))
  const int vb0=(int)(lds0+LDS_V)+((lane>>4)&1)*32+(lane&3)*8+(4*hi+((lane&15)>>2))*64;
  const char*Kbase=shm+LDS_K; bf16x8 kf[8];
  const lds_cptr shm3=(lds_cptr)shm; const lds_cptr kp0=shm3+LDS_K+hi*1024+r32*16; const lds_cptr vp0=shm3+LDS_V+((lane>>4)&1)*32+(lane&3)*8+(4*hi+((lane&15)>>2))*64;
  const int NT=(q0+QB)/KVBLK;
  float cqv=0.f,nm=0.f; const lds_cptr bp0=shm3+LDS_BIAS+hi*16;
  if constexpr(BIAS){ for(int p=wid;p<=qb;p+=NW) glds16(cb+p*256+lane*4,(unsigned)__builtin_amdgcn_readfirstlane(lds0+LDS_BIAS+p*1024));
    cqv=cb[q0+wid*QBLK+r32]; }
  DMA_K(0,0);DMA_V(0,0);DMA_K(1,SLOTB);
  bf16x8 qr[4];
  #pragma unroll
  for(int d0=0;d0<4;++d0)qr[d0]=*reinterpret_cast<const bf16x8*>(&Qw[(long)r32*DM+d0*16+hi*8]);
  float mhat=0.f,l_reg=0.f;f32x16 o[2];o[0]=f32x16{};o[1]=f32x16{};f32x16 negm=f32x16{};if constexpr(!BIAS)asm volatile("":"+v"(negm));
  const int qrel=wid*QBLK+r32;
  #define CMASK(P0,P1,t) do{int jb_=(t)-(NT-4); if(jb_>=0)cmask(P0,P1,jb_,qrel,hi);}while(0)
  bool resc=false;
  #define START(P0,P1) do{ const float rm=rowmax(P0,P1); resc=false; \
    { const float dl=BIAS?__builtin_fmaxf(rm,0.f):rm; mhat=fadd_s(mhat,dl); \
      _Pragma("unroll") for(int r=0;r<16;++r){P0[r]=fsub_s(P0[r],dl);P1[r]=fsub_s(P1[r],dl);} \
      if constexpr(BIAS){ nm=cqv-mhat; } else { _Pragma("unroll") for(int r=0;r<16;++r)negm[r]=-mhat; asm volatile("":"+v"(negm)); } } \
    _Pragma("unroll") for(int r=0;r<16;++r)P0[r]=__builtin_amdgcn_exp2f(P0[r]); }while(0)
  #define RESC() do{ if(resc){ asm volatile("s_waitcnt lgkmcnt(0)":::"memory"); \
      _Pragma("unroll") for(int d_=0;d_<2;++d_) _Pragma("unroll") for(int r=0;r<16;++r)o[d_][r]*=wsf[crow(r,hi)]; } }while(0)
  f32x16 pA0,pA1,pB0,pB1;
  int sl_prev=0,sl_cur=0,sl_next=SLOTB;
  #define ROT() do{sl_prev=sl_cur;sl_cur=sl_next;sl_next=(sl_next==(NSLOT-1)*SLOTB)?0:sl_next+SLOTB;}while(0)
  DMA_K(2,2*SLOTB);
  WAIT_BAR(3);
  if constexpr(BIAS){ nm=cqv; binit(pA0,pA1,bp0,nm); qkt<true>(pA0,pA1,Kbase,qr,negm,r32,hi); } else { qkt<false>(pA0,pA1,Kbase,qr,negm,r32,hi); } asm volatile("s_nop 15\n\ts_nop 7":"+v"(pA0),"+v"(pA1));CMASK(pA0,pA1,0);
  START(pA0,pA1);
  _Pragma("unroll") for(int r=0;r<16;++r)pA1[r]=__builtin_amdgcn_exp2f(pA1[r]);
  WAIT_BAR(0);
  DMA_K(3,0);DMA_V(1,SLOTB);
  ROT();
  kload8(kf,kp0+sl_cur);
  WAIT_BAR(2);
  s16x4 vlo[8],vhi[8]; u32x4 pw0,pw1,pw2,pw3;
  #define PKW(P,B) cvtpk_s(P[B],P[B+1])
  #define PAF(k) __builtin_bit_cast(bf16x8,pw##k)
  #define VFR(i) (bf16x8){vlo[i][0],vlo[i][1],vlo[i][2],vlo[i][3],vhi[i][0],vhi[i][1],vhi[i][2],vhi[i][3]}
  #define PIN(x) asm volatile("":"+v"(x))
  #define MX3(a,b,c) __builtin_fmaxf(__builtin_fmaxf((a),(b)),(c))
  #define GAPA(MF,A0,A1,A2,A3,W0,W1,PW) do{ MF; sacc+=A0; sacc+=A1; sacc+=A2; sacc+=A3; PIN(sacc); W0; W1; PIN(PW); SBAR(); }while(0)
  #define EX(v) __builtin_amdgcn_exp2f(v)
  #define GAPB(MF,X,B) do{ MF; X[B]=EX(X[B]); X[B+1]=EX(X[B+1]); X[B+2]=EX(X[B+2]); X[B+3]=EX(X[B+3]); PIN(X); SBAR(); }while(0)
  #define VRD(i) do{ vlo[i]=vtr(vp_+(((i)>>2)*4096+((i)&3)*1024)); vhi[i]=vtr(vp_+(((i)>>2)*4096+((i)&3)*1024+512)); }while(0)
  #define KRD(G,j) do{ if(G){ kload2(kf,kp0+sl_next,j); SBAR(); } }while(0)
  #define STEP(C0,C1,P0,P1,t,GK,GV,GL) do{ SBAR(); \
    const lds_cptr vp_=vp0+sl_prev; \
    if constexpr(BIAS){ binit(C0,C1,bp0+(t)*256,nm); SBAR(); } \
    VRD(0); SBAR(); float sacc=(P0[0]+P0[1]); \
    GAPA(C0=__builtin_amdgcn_mfma_f32_32x32x16_bf16(kf[0],qr[0],BIAS?C0:negm,0,0,0), P0[2],P0[3],P0[4],P0[5],     pw0[0]=PKW(P0,0), pw0[1]=PKW(P0,2), pw0); \
    VRD(4); SBAR(); GAPA(C1=__builtin_amdgcn_mfma_f32_32x32x16_bf16(kf[1],qr[0],BIAS?C1:negm,0,0,0), P0[6],P0[7],P0[8],P0[9],     pw0[2]=PKW(P0,4), pw0[3]=PKW(P0,6), pw0); \
    VRD(1); SBAR(); GAPA(C0=__builtin_amdgcn_mfma_f32_32x32x16_bf16(kf[2],qr[1],C0,0,0,0),   P0[10],P0[11],P0[12],P0[13], pw1[0]=PKW(P0,8), pw1[1]=PKW(P0,10), pw1); \
    VRD(5); SBAR(); GAPA(C1=__builtin_amdgcn_mfma_f32_32x32x16_bf16(kf[3],qr[1],C1,0,0,0),   P0[14],P0[15],P1[0],P1[1],   pw1[2]=PKW(P0,12),pw1[3]=PKW(P0,14), pw1); \
    VRD(2); SBAR(); GAPA(C0=__builtin_amdgcn_mfma_f32_32x32x16_bf16(kf[4],qr[2],C0,0,0,0),   P1[2],P1[3],P1[4],P1[5],     pw2[0]=PKW(P1,0), pw2[1]=PKW(P1,2), pw2); \
    VRD(6); SBAR(); GAPA(C1=__builtin_amdgcn_mfma_f32_32x32x16_bf16(kf[5],qr[2],C1,0,0,0),   P1[6],P1[7],P1[8],P1[9],     pw2[2]=PKW(P1,4), pw2[3]=PKW(P1,6), pw2); \
    VRD(3); SBAR(); GAPA(C0=__builtin_amdgcn_mfma_f32_32x32x16_bf16(kf[6],qr[3],C0,0,0,0),   P1[10],P1[11],P1[12],P1[13], pw3[0]=PKW(P1,8), pw3[1]=PKW(P1,10), pw3); \
    VRD(7); SBAR(); GAPA(C1=__builtin_amdgcn_mfma_f32_32x32x16_bf16(kf[7],qr[3],C1,0,0,0),   P1[14],P1[15],0.f,0.f,       pw3[2]=PKW(P1,12),pw3[3]=PKW(P1,14), pw3); \
    l_reg+=sacc; \
    if(GK){DMA_K((t)+3,sl_cur);} if(GV){DMA_V((t)+1,sl_next);} \
    CMASK(C0,C1,t); \
    { float a=MX3(C0[0],C0[1],C1[0]),b=MX3(C0[2],C0[3],C1[1]); a=MX3(a,C1[2],C1[3]); \
      _Pragma("unroll") for(int r=4;r<16;r+=4){a=MX3(a,C0[r],C0[r+1]);b=MX3(b,C0[r+2],C0[r+3]);a=MX3(a,C1[r],C1[r+1]);b=MX3(b,C1[r+2],C1[r+3]);} \
      float rm=__builtin_fmaxf(a,b); { auto rr=__builtin_amdgcn_permlane32_swap(__float_as_uint(rm),__float_as_uint(rm),false,false); rm=__builtin_fmaxf(__uint_as_float(rr[0]),__uint_as_float(rr[1])); } \
      resc=false; \
      if(__builtin_expect(__any(rm>(float)THRL),0)){ const float dl=__builtin_fmaxf(rm,0.f); mhat+=dl; \
        _Pragma("unroll") for(int r=0;r<16;++r){C0[r]-=dl;C1[r]-=dl;} \
        if constexpr(BIAS){ nm=cqv-mhat; } else { _Pragma("unroll") for(int r=0;r<16;++r)negm[r]=-mhat; asm volatile("":"+v"(negm)); } \
        const float f=__builtin_amdgcn_exp2f(-dl); l_reg*=f; if(hi==0)wsf[r32]=f; resc=true; } } \
    SBAR(); \
    GAPB(o[0]=__builtin_amdgcn_mfma_f32_32x32x16_bf16(PAF(0),VFR(0),o[0],0,0,0), C0,0); \
    GAPB(o[1]=__builtin_amdgcn_mfma_f32_32x32x16_bf16(PAF(0),VFR(4),o[1],0,0,0), C0,4); \
    KRD(GL,0); GAPB(o[0]=__builtin_amdgcn_mfma_f32_32x32x16_bf16(PAF(1),VFR(1),o[0],0,0,0), C0,8); \
    KRD(GL,1); GAPB(o[1]=__builtin_amdgcn_mfma_f32_32x32x16_bf16(PAF(1),VFR(5),o[1],0,0,0), C0,12); \
    KRD(GL,2); GAPB(o[0]=__builtin_amdgcn_mfma_f32_32x32x16_bf16(PAF(2),VFR(2),o[0],0,0,0), C1,0); \
    KRD(GL,3); GAPB(o[1]=__builtin_amdgcn_mfma_f32_32x32x16_bf16(PAF(2),VFR(6),o[1],0,0,0), C1,4); \
    GAPB(o[0]=__builtin_amdgcn_mfma_f32_32x32x16_bf16(PAF(3),VFR(3),o[0],0,0,0), C1,8); \
    GAPB(o[1]=__builtin_amdgcn_mfma_f32_32x32x16_bf16(PAF(3),VFR(7),o[1],0,0,0), C1,12); \
    }while(0)
  int t=1;
  #undef CMASK
  #define CMASK(P0,P1,t) do{}while(0)
  for(;t+5<NT;t+=2){
    STEP(pB0,pB1,pA0,pA1,t,true,true,true);     WAIT_BAR(2); RESC(); ROT();
    STEP(pA0,pA1,pB0,pB1,t+1,true,true,true);   WAIT_BAR(2); RESC(); ROT();
  }
  #undef CMASK
  #define CMASK(P0,P1,t) do{int jb_=(t)-(NT-4); if(jb_>=0)cmask(P0,P1,jb_,qrel,hi);}while(0)
  #define ENDW(tt) do{ if((tt)+3<NT){WAIT_BAR(2);} else if((tt)+2<NT){WAIT_BAR(1);} else {WAIT_BAR(0);} }while(0)
  for(;t+1<NT;t+=2){
    STEP(pB0,pB1,pA0,pA1,t,(t+3<NT),(t+1<NT),(t+1<NT));       ENDW(t);   RESC(); ROT();
    STEP(pA0,pA1,pB0,pB1,t+1,(t+4<NT),(t+2<NT),(t+2<NT));     ENDW(t+1); RESC(); ROT();
  }
  STEP(pB0,pB1,pA0,pA1,NT-1,false,false,false); RESC();
  { float sacc=pB0[0]+pB0[1]; _Pragma("unroll") for(int r=2;r<16;++r)sacc+=pB0[r]; _Pragma("unroll") for(int r=0;r<16;++r)sacc+=pB1[r]; l_reg+=sacc;
    pw0=(u32x4){PKW(pB0,0),PKW(pB0,2),PKW(pB0,4),PKW(pB0,6)};pw1=(u32x4){PKW(pB0,8),PKW(pB0,10),PKW(pB0,12),PKW(pB0,14)};pw2=(u32x4){PKW(pB1,0),PKW(pB1,2),PKW(pB1,4),PKW(pB1,6)};pw3=(u32x4){PKW(pB1,8),PKW(pB1,10),PKW(pB1,12),PKW(pB1,14)};
    SBAR(); pv(o,vb0+sl_cur,PAF(0),PAF(1),PAF(2),PAF(3)); }
  #undef PKW
  #undef PAF
  #undef VFR
  #undef PIN
  #undef MX3
  #undef GAPA
  #undef GAPB
  #undef EX
  #undef VRD
  #undef KRD
  #undef STEP
  #undef ENDW
  {auto rr=__builtin_amdgcn_permlane32_swap(__float_as_uint(l_reg),__float_as_uint(l_reg),false,false);l_reg=__uint_as_float(rr[0])+__uint_as_float(rr[1]);}
  if(hi==0)wsf[32+r32]=l_reg;asm volatile("s_waitcnt lgkmcnt(0)":::"memory");
  float rli[16];
  #pragma unroll
  for(int r=0;r<16;++r)rli[r]=__builtin_amdgcn_rcpf(wsf[32+crow(r,hi)]);
  bf16*Ow=O+(rowbase+q0+wid*QBLK)*DM+co;
  { bf16*stg=(bf16*)(shm+LDS_OST)+wid*2048;
    #pragma unroll
    for(int r=0;r<16;++r){const int orow=crow(r,hi);
      #pragma unroll
      for(int d0=0;d0<2;++d0)stg[orow*64+d0*32+r32]=__float2bfloat16(o[d0][r]*rli[r]);}
    asm volatile("s_waitcnt lgkmcnt(0)":::"memory");
    #pragma unroll
    for(int i=0;i<4;++i){const int row=i*8+(lane>>3),ch=lane&7; const u32x4 v=*(const u32x4*)(stg+row*64+ch*8); ATTN_STORE16(Ow+(long)row*DM+ch*8,v);} }
  asm volatile("s_waitcnt lgkmcnt(0)\n\ts_barrier":::"memory");
  #undef DMA_K
  #undef DMA_V
  #undef CMASK
  #undef START
  #undef RESC
  #undef ROT
}
constexpr int ATTN_LDS_BYTES=LDS_BYTES;
#undef SBAR
#undef WAIT_BAR
}
#include <hip/hip_cooperative_groups.h>
namespace cg = cooperative_groups;
#ifndef MK_SPLIT
#define MK_SPLIT 0
#endif
constexpr int NWAVES = 8;
constexpr int BATCH = 4, SEQ = 8192, T = BATCH * SEQ, D = 1024, FF = 4096, PLE = 256, DEPTH = 4, NFH = 16;
constexpr int TH = T / 2;
constexpr size_t MiB = 1u << 20;
constexpr size_t WS_ROWSS = 8 * MiB;
constexpr size_t WS_CS = 2 * MiB;
constexpr size_t WS_FLOG = 4 * MiB;
constexpr size_t WS_CK = 6 * MiB;
constexpr size_t W_QKV = 16 * MiB;
constexpr size_t W_O = 23 * MiB;
constexpr size_t W_1 = 25 * MiB;
constexpr size_t W_2 = 33 * MiB;
constexpr size_t W_PLE = 41 * MiB;
constexpr size_t W_G = 42 * MiB;
constexpr size_t WS_HBX = 48 * MiB, WS_HBY = 112 * MiB, WS_R1 = 176 * MiB, WS_PL = 432 * MiB, WS_END = 496 * MiB;
constexpr int RING_BYTES = 131072, LDS_BYTES = 147456;
static_assert(attn_body::ATTN_LDS_BYTES <= RING_BYTES, "attention LDS");

#define GAS __attribute__((address_space(1)))
#define LAS __attribute__((address_space(3)))
typedef unsigned short bf16;
typedef unsigned v4u __attribute__((ext_vector_type(4)));
typedef float f32x4 __attribute__((ext_vector_type(4)));
#define LDS_WAIT() asm volatile("s_waitcnt lgkmcnt(0)" ::: "memory")
__device__ __forceinline__ unsigned f2bf(float f) { unsigned u = __builtin_bit_cast(unsigned, f); return (u + 0x7fffu + ((u >> 16) & 1u)) >> 16; }
__device__ __forceinline__ unsigned pk2(float lo, float hi) { return f2bf(lo) | (f2bf(hi) << 16); }
__device__ __forceinline__ float wave_sum(float v) {
    v += pg8::lane_xor<1>(v); v += pg8::lane_xor<2>(v); v += pg8::lane_xor<4>(v); v += pg8::lane_xor<8>(v); v += pg8::lane_xor<16>(v);
    return pg8::half_sum(v);
}

constexpr int N_PHASES = 1 + 9 + 9 + 9 + 8 + 1;
enum { K_PRO = 0, K_QKVA, K_ATTA, K_COMB, K_QKVB, K_SCAN, K_ATTB, K_RES, K_W1, K_GATE, K_FIN };
struct Args { const float* in[21]; float* out; unsigned char* ws; float inv_freq[8]; int ph_lo, ph_hi; int prog[N_PHASES + 1]; };

#define CAS __attribute__((address_space(4)))
struct Frame { LAS unsigned char* lds; int tid, lane, wave, vcu, G; const CAS Args* a; };

__device__ __forceinline__ void transpose_item(const float* W, int ldw, int coff, int ncols, int K, const float* gain, bf16* WT, int row_off, LAS float* scr, int item, int nblk, int lane) {
    const int kb = item / nblk, nb = item % nblk, k0 = 64 * kb, n0 = 32 * nb;
#pragma unroll 8
    for (int i = 0; i < 32; ++i) { const int kk = 2 * i + (lane >> 5), n = n0 + (lane & 31);
        float v = (n < ncols) ? W[(size_t)(k0 + kk) * ldw + coff + n] : 0.f; if (gain) v *= gain[k0 + kk]; scr[kk * 33 + (lane & 31)] = v; }
    LDS_WAIT(); asm volatile("" ::: "memory");
    const int c = lane & 7;
#pragma unroll
    for (int j = 0; j < 4; ++j) { const int n = (lane >> 3) + 8 * j; const LAS float* s = scr + (8 * c) * 33 + n;
        v4u o; o.x = pk2(s[0 * 33], s[1 * 33]); o.y = pk2(s[2 * 33], s[3 * 33]); o.z = pk2(s[4 * 33], s[5 * 33]); o.w = pk2(s[6 * 33], s[7 * 33]);
        *(GAS v4u*)(WT + (size_t)(row_off + n0 + n) * K + k0 + 8 * c) = o; }
    LDS_WAIT(); asm volatile("" ::: "memory");
}

__device__ __forceinline__ void convert_layer(Frame& F, int L) {
    const CAS Args& A = *F.a; unsigned char* ws = A.ws;
    LAS float* scr = (LAS float*)(F.lds + F.wave * 16384);
    const int gw = F.vcu * NWAVES + F.wave, NGW = F.G * NWAVES;
    bf16* Wqkv = (bf16*)(ws + W_QKV); bf16* Wo = (bf16*)(ws + W_O); bf16* W1 = (bf16*)(ws + W_1); bf16* W2 = (bf16*)(ws + W_2); bf16* Wp = (bf16*)(ws + W_PLE); bf16* Wg = (bf16*)(ws + W_G + (size_t)(L & 1) * 2 * MiB);
    const bool isA = L < 2; const int j = L - 2;
    const int I_QKV = isA ? 16 * 96 : 16 * 32, I_KV = (!isA && j == 0) ? 16 * 64 : 0, I_F = (!isA && j == 0) ? 16 : 0, I_O = 16 * 32, I_1 = 16 * 128, I_2 = 64 * 32, I_G = 16 * 32, I_P = 4 * 32;
    const int NIT = I_QKV + I_KV + I_F + I_O + I_1 + I_2 + I_G + I_P;
    for (int it = gw; it < NIT; it += NGW) {
        int r = it;
        if (r < I_QKV) { if (isA) transpose_item(A.in[4] + (size_t)L * D * 3 * D, 3 * D, 0, 3 * D, D, A.in[3] + L * D, Wqkv, 0, scr, r, 96, F.lane);
                         else transpose_item(A.in[12] + (size_t)j * D * D, D, 0, D, D, A.in[11] + j * D, Wqkv, 0, scr, r, 32, F.lane); continue; } r -= I_QKV;
        if (r < I_KV) { transpose_item(A.in[9], 2 * D + NFH, 0, 2 * D, D, A.in[8], Wqkv, D, scr, r, 64, F.lane); continue; } r -= I_KV;
        if (r < I_F) { transpose_item(A.in[9], 2 * D + NFH, 2 * D, NFH, D, A.in[8], Wqkv, 3 * D, scr, r, 1, F.lane); continue; } r -= I_F;
        if (r < I_O) { transpose_item(isA ? A.in[7] + (size_t)L * D * D : A.in[13] + (size_t)j * D * D, D, 0, D, D, nullptr, Wo, 0, scr, r, 32, F.lane); continue; } r -= I_O;
        if (r < I_1) { transpose_item(A.in[15] + (size_t)L * D * FF, FF, 0, FF, D, A.in[14] + L * D, W1, 0, scr, r, 128, F.lane); continue; } r -= I_1;
        if (r < I_2) { transpose_item(A.in[16] + (size_t)L * FF * D, D, 0, D, FF, nullptr, W2, 0, scr, r, 32, F.lane); continue; } r -= I_2;
        if (r < I_G) { transpose_item(A.in[18] + (size_t)L * D * D, D, 0, D, D, A.in[17] + L * D, Wg, 0, scr, r, 32, F.lane); continue; } r -= I_G;
        transpose_item(A.in[19] + (size_t)L * PLE * D, D, 0, D, PLE, nullptr, Wp, 0, scr, r, 32, F.lane);
    }
}

__device__ __forceinline__ void sincos_red(double r, float& s, float& c) {
    const double r2 = r * r;
    double sp = -1.0 / 51090942171709440000.0;
    sp = sp * r2 + 1.0 / 121645100408832000.0;
    sp = sp * r2 - 1.0 / 355687428096000.0;
    sp = sp * r2 + 1.0 / 1307674368000.0;
    sp = sp * r2 - 1.0 / 6227020800.0;
    sp = sp * r2 + 1.0 / 39916800.0;
    sp = sp * r2 - 1.0 / 362880.0;
    sp = sp * r2 + 1.0 / 5040.0;
    sp = sp * r2 - 1.0 / 120.0;
    sp = sp * r2 + 1.0 / 6.0;
    sp = sp * r2 - 1.0;
    s = (float)(-(sp * r));
    double cp = 1.0 / 1124000727777607680000.0;
    cp = cp * r2 - 1.0 / 2432902008176640000.0;
    cp = cp * r2 + 1.0 / 6402373705728000.0;
    cp = cp * r2 - 1.0 / 20922789888000.0;
    cp = cp * r2 + 1.0 / 87178291200.0;
    cp = cp * r2 - 1.0 / 479001600.0;
    cp = cp * r2 + 1.0 / 3628800.0;
    cp = cp * r2 - 1.0 / 40320.0;
    cp = cp * r2 + 1.0 / 720.0;
    cp = cp * r2 - 1.0 / 24.0;
    cp = cp * r2 + 0.5;
    c = (float)(1.0 - cp * r2);
}

__device__ __forceinline__ void p0_prologue(Frame& F) {
    const CAS Args& A = *F.a; unsigned char* ws = A.ws;
    const int gw = F.vcu * NWAVES + F.wave, NGW = F.G * NWAVES, gt = gw * 64 + F.lane, NGT = NGW * 64;
    float* rowss = (float*)(ws + WS_ROWSS);
    bf16* hbx = (bf16*)(ws + WS_HBX);
    for (int m = gw; m < T; m += NGW) {
        const GAS f32x4* xr = (const GAS f32x4*)(A.in[0] + (size_t)m * D) + F.lane; f32x4 v[4]; float s = 0.f;
#pragma unroll
        for (int j = 0; j < 4; ++j) { v[j] = xr[64 * j]; s += (v[j].x * v[j].x + v[j].y * v[j].y) + (v[j].z * v[j].z + v[j].w * v[j].w); }
        s = wave_sum(s); if (F.lane < 16) rowss[(size_t)m * 16 + F.lane] = (F.lane == 0) ? s : 0.f;
        GAS unsigned long long* o8 = (GAS unsigned long long*)(hbx + (size_t)m * D) + F.lane;
#pragma unroll
        for (int j = 0; j < 4; ++j) o8[64 * j] = (unsigned long long)pk2(v[j].x, v[j].y) | ((unsigned long long)pk2(v[j].z, v[j].w) << 32);
    }
    float* cs = (float*)(ws + WS_CS); const int* pos = (const int*)A.in[2];
    for (int i = gt; i < T * 8; i += NGT) { const int row = i >> 3, jj = i & 7;
        const float ang = (float)pos[row] * A.inv_freq[jj]; const double a = (double)ang;
        const double n = __builtin_rint(a * 0.15915494309189535); const double r = __builtin_fma(-n, 6.283185307179586, a) - n * 2.4492935982947064e-16;
        float s, c; sincos_red(r, s, c); cs[row * 16 + jj] = c; cs[row * 16 + 8 + jj] = s; }
}

__device__ __forceinline__ void convert_p(Frame& F, int L, bf16* pb) {
    const CAS Args& A = *F.a; const int gt = (F.vcu * NWAVES + F.wave) * 64 + F.lane, NGT = F.G * NWAVES * 64;
    const GAS f32x4* src = (const GAS f32x4*)(A.in[1] + (size_t)L * T * PLE); GAS v4u* dst = (GAS v4u*)pb;
    for (int i = gt; i < T * PLE / 8; i += NGT) { const f32x4 a = src[2 * i], b = src[2 * i + 1]; v4u o; o.x = pk2(a.x, a.y); o.y = pk2(a.z, a.w); o.z = pk2(b.x, b.y); o.w = pk2(b.z, b.w); dst[i] = o; }
}

__device__ __forceinline__ void scan_phase(Frame& F) {
    unsigned char* ws = F.a->ws; const float* flog = (const float*)(ws + WS_FLOG); float* ck = (float*)(ws + WS_CK);
    LAS float* wtot = (LAS float*)F.lds;
    for (int bh = blockIdx.x; bh < BATCH * NFH; bh += F.G) { const int b = bh >> 4, h = bh & 15, t0 = F.tid * 16;
        float v0, v1, v2, v3, v4, v5, v6, v7, v8, v9, v10, v11, v12, v13, v14, v15;
        const float* src = flog + ((size_t)b * SEQ + t0) * 16 + h;
        v0 = src[0]; v1 = v0 + src[16]; v2 = v1 + src[32]; v3 = v2 + src[48]; v4 = v3 + src[64]; v5 = v4 + src[80]; v6 = v5 + src[96]; v7 = v6 + src[112];
        v8 = v7 + src[128]; v9 = v8 + src[144]; v10 = v9 + src[160]; v11 = v10 + src[176]; v12 = v11 + src[192]; v13 = v12 + src[208]; v14 = v13 + src[224]; v15 = v14 + src[240];
        float incl = v15, tot = v15;
#define BSTEP(M) { const float pt = pg8::lane_xor<M>(tot); if (F.lane & M) incl += pt; tot += pt; }
        BSTEP(1) BSTEP(2) BSTEP(4) BSTEP(8) BSTEP(16)
#undef BSTEP
        { const float lowtot = __builtin_bit_cast(float, __builtin_amdgcn_readlane(__builtin_bit_cast(int, tot), 0)); if (F.lane & 32) incl += lowtot; }
        if (F.lane == 63) wtot[F.wave] = incl;
        LDS_WAIT(); __syncthreads();
        float base = incl - v15;
        for (int w = 0; w < F.wave; ++w) base += wtot[w];
        const float L2E = 1.4426950408889634f;
        f32x4* dst = (f32x4*)(ck + (size_t)bh * SEQ + t0);
        dst[0] = (f32x4){(v0 + base) * L2E, (v1 + base) * L2E, (v2 + base) * L2E, (v3 + base) * L2E};
        dst[1] = (f32x4){(v4 + base) * L2E, (v5 + base) * L2E, (v6 + base) * L2E, (v7 + base) * L2E};
        dst[2] = (f32x4){(v8 + base) * L2E, (v9 + base) * L2E, (v10 + base) * L2E, (v11 + base) * L2E};
        dst[3] = (f32x4){(v12 + base) * L2E, (v13 + base) * L2E, (v14 + base) * L2E, (v15 + base) * L2E};
        __syncthreads();
    }
}

__device__ __forceinline__ void combine_phase(Frame& F, int L, const bf16* O1, const bf16* O2, bf16* On) {
    const CAS Args& A = *F.a; const int gw = F.vcu * NWAVES + F.wave, NGW = F.G * NWAVES;
    const float lam_init = (L == 0) ? 0.2f : 0.35550906759096924f;
    const float* lp = A.in[5] + L * 4 * 64;
    const float s1 = wave_sum(lp[F.lane] * lp[64 + F.lane]), s2 = wave_sum(lp[128 + F.lane] * lp[192 + F.lane]);
    const float lam = expf(s1) - expf(s2) + lam_init;
    const float* gp = A.in[6] + L * 128 + 16 * (F.lane & 7);
    const f32x4 g0 = *(const f32x4*)gp, g1 = *(const f32x4*)(gp + 4), g2 = *(const f32x4*)(gp + 8), g3 = *(const f32x4*)(gp + 12);
    const float post = 1.0f - lam_init;
    for (int row = gw; row < T; row += NGW) {
        const size_t off = (size_t)row * D + 16 * F.lane;
        const v4u a0 = *(const GAS v4u*)(O1 + off), a1 = *(const GAS v4u*)(O1 + off + 8), b0 = *(const GAS v4u*)(O2 + off), b1 = *(const GAS v4u*)(O2 + off + 8);
        float o[16];
#define CB(k, aw, bw) o[2 * (k)] = __builtin_bit_cast(float, (aw) << 16) - lam * __builtin_bit_cast(float, (bw) << 16); o[2 * (k) + 1] = __builtin_bit_cast(float, (aw) & 0xffff0000u) - lam * __builtin_bit_cast(float, (bw) & 0xffff0000u);
        CB(0, a0.x, b0.x) CB(1, a0.y, b0.y) CB(2, a0.z, b0.z) CB(3, a0.w, b0.w) CB(4, a1.x, b1.x) CB(5, a1.y, b1.y) CB(6, a1.z, b1.z) CB(7, a1.w, b1.w)
#undef CB
        float ss = 0.f;
#pragma unroll
        for (int k = 0; k < 16; ++k) ss += o[k] * o[k];
        ss += pg8::lane_xor<1>(ss); ss += pg8::lane_xor<2>(ss); ss += pg8::lane_xor<4>(ss);
        const float rs = __builtin_amdgcn_rsqf(ss * (1.0f / 128.0f) + 1e-6f) * post;
        v4u w0, w1;
        w0.x = pk2(o[0] * rs * g0.x, o[1] * rs * g0.y); w0.y = pk2(o[2] * rs * g0.z, o[3] * rs * g0.w); w0.z = pk2(o[4] * rs * g1.x, o[5] * rs * g1.y); w0.w = pk2(o[6] * rs * g1.z, o[7] * rs * g1.w);
        w1.x = pk2(o[8] * rs * g2.x, o[9] * rs * g2.y); w1.y = pk2(o[10] * rs * g2.z, o[11] * rs * g2.w); w1.z = pk2(o[12] * rs * g3.x, o[13] * rs * g3.y); w1.w = pk2(o[14] * rs * g3.z, o[15] * rs * g3.w);
        *(GAS v4u*)(On + off) = w0; *(GAS v4u*)(On + off + 8) = w1;
    }
}

__device__ __forceinline__ void final_phase(Frame& F, float* h) {
    const CAS Args& A = *F.a; const int gw = F.vcu * NWAVES + F.wave, NGW = F.G * NWAVES;
    const GAS f32x4* gp = (const GAS f32x4*)A.in[20] + F.lane;
    const f32x4 g0 = gp[0], g1 = gp[64], g2 = gp[128], g3 = gp[192];
    for (int m = gw; m < T; m += NGW) {
        GAS f32x4* xr = (GAS f32x4*)(h + (size_t)m * D) + F.lane;
        f32x4 v0 = xr[0], v1 = xr[64], v2 = xr[128], v3 = xr[192];
        float s = (v0.x * v0.x + v0.y * v0.y) + (v0.z * v0.z + v0.w * v0.w); s += (v1.x * v1.x + v1.y * v1.y) + (v1.z * v1.z + v1.w * v1.w);
        s += (v2.x * v2.x + v2.y * v2.y) + (v2.z * v2.z + v2.w * v2.w); s += (v3.x * v3.x + v3.y * v3.y) + (v3.z * v3.z + v3.w * v3.w);
        const float rs = 1.0f / sqrtf(wave_sum(s) * (1.0f / D) + 1e-6f);
        xr[0] = v0 * rs * g0; xr[64] = v1 * rs * g1; xr[128] = v2 * rs * g2; xr[192] = v3 * rs * g3;
    }
}

template <bool BIAS> __device__ __forceinline__ void attn_phase(Frame& F, const bf16* Q, const bf16* K, const bf16* V, bf16* O1, bf16* O2, const float* ck) {
    using abf = attn_body::bf16;
    const int nslot = (BIAS ? BATCH * 16 : BATCH * 32) * 8;
    for (int sl = F.vcu; sl < nslot; sl += F.G) { const int bhv = sl >> 3, s = sl & 7;
        for (int k = 0; k < 4; ++k) { const int qb = (k == 0) ? s : (k == 1) ? 15 - s : (k == 2) ? 16 + s : 31 - s;
            if constexpr (BIAS) { const int b = bhv >> 4, h = bhv & 15;
                attn_body::attn_unit<8, true>(b, h * 64, h * 64, h * 64, h * 64, qb, (const abf*)Q, (const abf*)K, (const abf*)V, (abf*)O1, ck + (size_t)bhv * SEQ, (char*)F.lds);
            } else { const int b = bhv >> 5, vh = bhv & 31, h = vh >> 2, c = (vh >> 1) & 1, half = vh & 1;
                attn_body::attn_unit<8, false>(b, (2 * h + c) * 64, (2 * h + c) * 64, h * 128 + half * 64, h * 128 + half * 64, qb, (const abf*)Q, (const abf*)K, (const abf*)V, (abf*)(c ? O2 : O1), nullptr, (char*)F.lds); }
        }
    }
}

#define XB_TMO      128
#define XB_XCNT(j)  (256  + 64 * (j))
#define XB_XSUB(j)  (1280 + 64 * (j))
#define XB_XGEN(j)  (2304 + 64 * (j))
#define XB_TOP      3328
#define XB_TOPGEN   3392
#define XCD_BAR_WORDS 3456
#define XB_SPIN_CAP (1u << 18)

__device__ __forceinline__ unsigned xb_ld(unsigned* p)              { return __hip_atomic_load(p, __ATOMIC_RELAXED, __HIP_MEMORY_SCOPE_AGENT); }
__device__ __forceinline__ unsigned xb_add(unsigned* p, unsigned v) { return __hip_atomic_fetch_add(p, v, __ATOMIC_RELAXED, __HIP_MEMORY_SCOPE_AGENT); }
__device__ __forceinline__ unsigned xb_xcc_id() { return (unsigned)__builtin_amdgcn_s_getreg((3 << 11) | 20) & 0xFu; }
#define XB_SPIN(cond, bar) do { unsigned _sp = 0; while (cond) { __builtin_amdgcn_s_sleep(1); \
    if ((++_sp & 255u) == 0u) { if (xb_ld(&(bar)[XB_TMO])) break; if (_sp > XB_SPIN_CAP) { atomicAdd(&(bar)[XB_TMO], 1u); break; } } } } while (0)

struct XcdBarrier {
    unsigned* bar; unsigned x;
    volatile LAS unsigned* st;
};

__device__ __forceinline__ XcdBarrier xcd_barrier_post(unsigned* bar, volatile LAS unsigned* st) {
    XcdBarrier b; b.bar = bar; b.x = xb_xcc_id(); b.st = st;
    if (threadIdx.x == 0) (void)xb_add(&bar[XB_XCNT(b.x)], 1u);
    return b;
}
__device__ __forceinline__ void xcd_barrier_complete(unsigned* bar, unsigned x, unsigned& nloc, unsigned& nx) {
    const unsigned G = gridDim.x * gridDim.y * gridDim.z;
    unsigned sum, cnt, mine, sp = 0u;
    for (;;) {
        sum = 0u; cnt = 0u; mine = 0u;
#pragma unroll
        for (unsigned j = 0; j < 16; ++j) { const unsigned c = xb_ld(&bar[XB_XCNT(j)]); sum += c; cnt += (c > 0u) ? 1u : 0u; mine = (j == x) ? c : mine; }
        if (sum == G) break;
        __builtin_amdgcn_s_sleep(1);
        if ((++sp & 255u) == 0u) { if (xb_ld(&bar[XB_TMO])) break; if (sp > XB_SPIN_CAP) { atomicAdd(&bar[XB_TMO], 1u); break; } }
    }
    nloc = mine > 0u ? mine : 1u; nx = cnt > 0u ? cnt : 1u;
}

__device__ __forceinline__ void xcd_barrier(const XcdBarrier& b) {
    asm volatile("s_waitcnt vmcnt(0)" ::: "memory");
    __syncthreads();
    if (threadIdx.x == 0) {
        unsigned* bar = b.bar;
        __builtin_amdgcn_s_waitcnt(0);
        unsigned nloc = b.st[0], nx = b.st[1];
        if (nloc == 0u) { xcd_barrier_complete(bar, b.x, nloc, nx); b.st[0] = nloc; b.st[1] = nx; }
        const unsigned old = xb_add(&bar[XB_XSUB(b.x)], 1u);
        const unsigned gen = old / nloc;
        if (old + 1u == (gen + 1u) * nloc) {
            __builtin_amdgcn_fence(__ATOMIC_RELEASE, "agent");
            asm volatile("s_waitcnt vmcnt(0)" ::: "memory");
            const unsigned og = xb_add(&bar[XB_TOP], 1u);
            const unsigned tg = og / nx;
            if (og + 1u == (tg + 1u) * nx) xb_add(&bar[XB_TOPGEN], 1u);
            else XB_SPIN(xb_ld(&bar[XB_TOPGEN]) == tg, bar);
            __builtin_amdgcn_fence(__ATOMIC_ACQUIRE, "agent");
            xb_add(&bar[XB_XGEN(b.x)], 1u);
            asm volatile("s_waitcnt vmcnt(0)" ::: "memory");
        } else {
            XB_SPIN(xb_ld(&bar[XB_XGEN(b.x)]) == gen, bar);
            __builtin_amdgcn_fence(__ATOMIC_ACQUIRE, "agent");
            asm volatile("s_waitcnt vmcnt(0)" ::: "memory");
        }
    }
    __syncthreads();
}

constexpr size_t WS_CTL = 0, CTL_ZERO_BYTES = 16384;
constexpr int LDSCTL_OFF = RING_BYTES;
__global__ void __launch_bounds__(NWAVES * 64, 2) yoco_fwd(Args args) {
    extern __shared__ __attribute__((aligned(16))) unsigned char lds[];
    cg::grid_group grid = cg::this_grid();
    using pg8::Gemm; using pg8::StaticOrder; using pg8::EpiQKV; using pg8::EpiRes; using pg8::EpiBf; using pg8::gemm_phase;
    const size_t E64 = 64 * MiB / 2;
    const int ph_lo = args.ph_lo, ph_hi = args.ph_hi;
    if (threadIdx.x < 64) ((LAS unsigned*)((LAS unsigned char*)lds + LDSCTL_OFF))[threadIdx.x] = 0u;
    __syncthreads();
    if (ph_hi - ph_lo > 1 && threadIdx.x == 0) (void)xb_add((unsigned*)(args.ws + WS_CTL) + XB_XCNT(xb_xcc_id()), 1u);
    if (ph_lo == 0) {
        const CAS Args* ap = (const CAS Args*)__builtin_amdgcn_kernarg_segment_ptr(); asm volatile("" : "+s"(ap));
        Frame F; F.a = ap; F.lds = (LAS unsigned char*)lds;
        { int t_ = threadIdx.x; asm volatile("" : "+v"(t_)); F.tid = t_; F.lane = t_ & 63; F.wave = __builtin_amdgcn_readfirstlane(t_ >> 6); }
        int bx = blockIdx.x, G_ = gridDim.x; asm volatile("" : "+s"(bx), "+s"(G_)); F.G = G_; F.vcu = (G_ % 8 == 0) ? (bx % 8) * (G_ / 8) + bx / 8 : bx;
        p0_prologue(F);
    }
    for (int ph = ph_lo; ph < ph_hi; ++ph) {
        const CAS Args* ap = (const CAS Args*)__builtin_amdgcn_kernarg_segment_ptr(); asm volatile("" : "+s"(ap));
        Frame F; F.a = ap; F.lds = (LAS unsigned char*)lds;
#define FRESH_TID() do { int t_ = threadIdx.x; asm volatile("" : "+v"(t_)); F.tid = t_; F.lane = t_ & 63; F.wave = __builtin_amdgcn_readfirstlane(t_ >> 6); } while (0)
        int bx = blockIdx.x, G_ = gridDim.x; asm volatile("" : "+s"(bx), "+s"(G_)); F.G = G_; F.vcu = (G_ % 8 == 0) ? (bx % 8) * (G_ / 8) + bx / 8 : bx;
        const int code = ap->prog[ph], kind = code & 255, L = (code >> 8) & 255, hf = (code >> 16) & 1, w2 = (code >> 17) & 1;
        unsigned char* ws = ap->ws; LAS unsigned char* ring = F.lds;
        float* rowss = (float*)(ws + WS_ROWSS); float* h = ap->out;
        bf16* hbX = (bf16*)(ws + WS_HBX); bf16* hbY = (bf16*)(ws + WS_HBY); bf16* R1 = (bf16*)(ws + WS_R1);
        int conv = -1;
        switch (kind) {
        case K_PRO: conv = 0; break;
        case K_QKVA: { Gemm g{hbX, (bf16*)(ws + W_QKV), T, 3 * D, D}; StaticOrder S; S.init(T, 3 * D, F.G, bx);
            EpiQKV<0> E{R1, E64, 2 * E64, rowss + (size_t)((3 * L) & 3) * T * 16, (const float*)(ws + WS_CS), nullptr, nullptr};
            gemm_phase<EpiQKV<0>, StaticOrder, PG8_ALIGN, PG8_SP2>(ring, g, S, E); } break;
        case K_ATTA: attn_phase<false>(F, R1, R1 + E64, R1 + 2 * E64, hbX, hbY, nullptr); break;
        case K_COMB: FRESH_TID(); combine_phase(F, L, hbX, hbY, R1 + 3 * E64); break;
        case K_QKVB: { const int N = (L == 2) ? 3 * D + 256 : D; Gemm g{hbX, (bf16*)(ws + W_QKV), T, N, D}; StaticOrder S; S.init(T, N, F.G, bx);
            EpiQKV<1> E{R1, 2 * E64, 3 * E64, rowss + (size_t)((3 * L) & 3) * T * 16, nullptr, (float*)(ws + WS_FLOG), ap->in[10]};
            gemm_phase<EpiQKV<1>, StaticOrder, PG8_ALIGN, PG8_SP2>(ring, g, S, E); } break;
        case K_SCAN: FRESH_TID(); scan_phase(F); break;
        case K_ATTB: attn_phase<true>(F, R1, R1 + 2 * E64, R1 + 3 * E64, R1, nullptr, (const float*)(ws + WS_CK)); break;
        case K_RES: {
            Gemm g{w2 ? R1 : (L < 2 ? R1 + 3 * E64 : R1), (bf16*)(ws + (w2 ? W_2 : W_O)), w2 ? TH : T, D, w2 ? FF : D}; StaticOrder S; S.init(g.M, D, F.G, bx);
            EpiRes<0> E{(!w2 && L == 0) ? ap->in[0] : h, h, w2 ? hbY : hbX, rowss + (size_t)((3 * L + 1 + w2) & 3) * T * 16, nullptr, nullptr, w2 ? hf * TH : 0};
            gemm_phase<EpiRes<0>, StaticOrder, PG8_ALIGN, PG8_SP2>(ring, g, S, E);
            if (!w2) { FRESH_TID(); convert_p(F, L, hbY); } } break;
        case K_W1: { { Gemm g{hbX + (size_t)hf * TH * D, (bf16*)(ws + W_1), TH, FF, D}; StaticOrder S; S.init(TH, FF, F.G, bx);
                EpiBf<1> E{R1, FF, rowss + (size_t)((3 * L + 1) & 3) * T * 16, hf * TH};
                gemm_phase<EpiBf<1>, StaticOrder, PG8_ALIGN, PG8_SP2>(ring, g, S, E); }
            if (hf == 0) { Gemm g2{hbY, (bf16*)(ws + W_PLE), T, D, PLE}; StaticOrder S2; S2.init(T, D, F.G, bx);
                EpiBf<0> E2{(bf16*)(ws + WS_PL), D, nullptr, 0};
                gemm_phase<EpiBf<0>, StaticOrder, PG8_ALIGN, PG8_SP2>(ring, g2, S2, E2); } } break;
        case K_GATE: { Gemm g{hbY, (bf16*)(ws + W_G + (size_t)(L & 1) * 2 * MiB), T, D, D}; StaticOrder S; S.init(T, D, F.G, bx);
            EpiRes<1> E{h, h, hbX, rowss + (size_t)((3 * L + 3) & 3) * T * 16, rowss + (size_t)((3 * L + 2) & 3) * T * 16, (const bf16*)(ws + WS_PL), 0};
            gemm_phase<EpiRes<1>, StaticOrder, PG8_ALIGN, PG8_SP2>(ring, g, S, E);
            if (L + 1 < DEPTH) conv = L + 1; } break;
        default: FRESH_TID(); final_phase(F, h); break;
        }
        if (conv >= 0) { FRESH_TID(); convert_layer(F, conv); }
        if (ph + 1 < ph_hi) {
            if (ph == ph_lo) grid.sync();
            else { XcdBarrier xb; xb.bar = (unsigned*)(ap->ws + WS_CTL); xb.x = xb_xcc_id(); xb.st = (volatile LAS unsigned*)((LAS unsigned char*)lds + LDSCTL_OFF + 32); xcd_barrier(xb); }
        }
    }
}

static void build_prog(int* prog) {
    int n = 0; prog[n++] = K_PRO;
    for (int L = 0; L < DEPTH; ++L) {
        if (L < 2) { prog[n++] = K_QKVA | L << 8; prog[n++] = K_ATTA | L << 8; prog[n++] = K_COMB | L << 8; }
        else { prog[n++] = K_QKVB | L << 8; if (L == 2) prog[n++] = K_SCAN | L << 8; prog[n++] = K_ATTB | L << 8; }
        prog[n++] = K_RES | L << 8;
        for (int hf = 0; hf < 2; ++hf) { prog[n++] = K_W1 | L << 8 | hf << 16; prog[n++] = K_RES | L << 8 | hf << 16 | 1 << 17; }
        prog[n++] = K_GATE | L << 8;
    }
    prog[n++] = K_FIN;
    if (n != N_PHASES) fprintf(stderr, "build_prog: %d phases, N_PHASES %d\n", n, N_PHASES);
    while (n < N_PHASES + 1) prog[n++] = K_FIN;
}

extern "C" void kernel_launch(void* const* d_in, const int* in_sizes, int n_in, void* d_out, int out_size, void* d_ws, size_t ws_size, hipStream_t stream) {
    static int grid = 0;
    if (grid == 0) {
        if (n_in != 21 || out_size != T * D || ws_size < WS_END) { fprintf(stderr, "kernel_launch: unexpected problem (n_in %d out %d ws %zu)\n", n_in, out_size, ws_size); grid = -1; return; }
        int dev = 0, cus = 0, per_cu = 0;
        if (hipGetDevice(&dev) != hipSuccess || hipDeviceGetAttribute(&cus, hipDeviceAttributeMultiprocessorCount, dev) != hipSuccess) { grid = -1; return; }
        if (hipFuncSetAttribute((const void*)yoco_fwd, hipFuncAttributeMaxDynamicSharedMemorySize, LDS_BYTES) != hipSuccess) { fprintf(stderr, "kernel_launch: hipFuncSetAttribute failed\n"); grid = -1; return; }
        if (hipOccupancyMaxActiveBlocksPerMultiprocessor(&per_cu, (const void*)yoco_fwd, NWAVES * 64, LDS_BYTES) != hipSuccess || per_cu < 1) { fprintf(stderr, "kernel_launch: occupancy query says %d\n", per_cu); per_cu = 1; }
        (void)hipGetLastError();
        grid = cus;
    }
    if (grid < 0) return;
    Args a{};
    for (int i = 0; i < 21; ++i) a.in[i] = (const float*)d_in[i];
    a.out = (float*)d_out; a.ws = (unsigned char*)d_ws;
    for (int j = 0; j < 8; ++j) { const float p = powf(500000.0f, (float)(2 * j) / 16.0f); a.inv_freq[j] = 1.0f / p; }
    build_prog(a.prog);
#if MK_SPLIT
    for (int p = 0; p < N_PHASES; ++p) { a.ph_lo = p; a.ph_hi = p + 1; hipLaunchKernelGGL(yoco_fwd, dim3(grid), dim3(NWAVES * 64), LDS_BYTES, stream, a); }
#else
    a.ph_lo = 0; a.ph_hi = N_PHASES;
    (void)hipMemsetAsync((char*)d_ws + WS_CTL, 0, CTL_ZERO_BYTES, stream);
    void* kargs[] = {&a};
    const hipError_t e = hipLaunchCooperativeKernel((const void*)yoco_fwd, dim3(grid), dim3(NWAVES * 64), kargs, LDS_BYTES, stream);
    if (e != hipSuccess) fprintf(stderr, "kernel_launch: cooperative launch failed: %s (grid %d)\n", hipGetErrorString(e), grid);
#endif
}
```

```cpp
#include <hip/hip_runtime.h>
#include <cstdio>
#include <cstdint>
namespace pg8 {
#define PG8_LAS __attribute__((address_space(3)))
typedef unsigned short bf16_t;
typedef short bf16x8 __attribute__((ext_vector_type(8)));
typedef float f32x4 __attribute__((ext_vector_type(4)));
typedef unsigned u32x4 __attribute__((ext_vector_type(4)));
constexpr int BM = 256, BK = 64, HALF = 128, HTB = HALF * BK * 2  , STAGE_BYTES = 8 * HTB, NXCD = 8, WGM = 8;

__host__ __device__ __forceinline__ int lds_byte(int r, int c) { const int st = (r >> 4) * 2 + (c >> 5), rr = r & 15, cc = c & 31, ob = rr * 64 + cc * 2; return st * 1024 + (ob ^ (((ob >> 9) & 1) << 5)); }
__host__ __device__ __forceinline__ void stage_rc(int b, int& R, int& C) { const int st = b / 1024, sb = b % 1024, swz = sb ^ (((sb >> 9) & 1) << 5); R = (st >> 1) * 16 + swz / 64; C = (st & 1) * 32 + (swz % 64) / 2; }
__host__ __device__ __forceinline__ int perm32(int rho) { const int n = rho >> 4, i = rho & 15; return 8 * (i >> 2) + 4 * n + (i & 3); }

struct Unit { int pm, pn; };
struct Gemm { const bf16_t* A; const bf16_t* Bt; int M, N, K; };

struct StaticOrder {
    int nM, nN, nwg, G, c;
    __host__ __device__ void init(int M, int N, int G_, int c_) { nM = M / BM; nN = N / BM; nwg = nM * nN; G = G_; c = c_; }
    __host__ __device__ bool next(int i, Unit& u) const {
        const long L = (long)i * G + c; if (L >= nwg) return false;
        int wgid = (int)L; { const int q = nwg / NXCD, r = nwg % NXCD, xcd = wgid % NXCD, off = wgid / NXCD; wgid = (xcd < r ? xcd * (q + 1) : r * (q + 1) + (xcd - r) * q) + off; }
        const int nig = WGM * nN, gid = wgid / nig, fm = gid * WGM, gsz = (nM - fm) < WGM ? (nM - fm) : WGM;
        u.pm = fm + ((wgid % nig) % gsz); u.pn = (wgid % nig) / gsz; return true;
    }
    __device__ __forceinline__ void a_ready(const Unit&) const {}
    __device__ __forceinline__ void done(const Unit&) const {}
};

__device__ __forceinline__ unsigned cvt_pk_bf16(float lo, float hi) { unsigned r; asm volatile("v_cvt_pk_bf16_f32 %0, %1, %2" : "=v"(r) : "v"(lo), "v"(hi)); return r; }
typedef float f32x2 __attribute__((ext_vector_type(2)));
template <int M> __device__ __forceinline__ float lane_xor(float v) { return __builtin_bit_cast(float, __builtin_amdgcn_ds_swizzle(__builtin_bit_cast(int, v), 0x1f | (M << 10))); }
__device__ __forceinline__ float half_sum(float v) { auto rr = __builtin_amdgcn_permlane32_swap(__float_as_uint(v), __float_as_uint(v), false, false); return __uint_as_float(rr[0]) + __uint_as_float(rr[1]); }
typedef float f32x2 __attribute__((ext_vector_type(2)));
typedef unsigned u32x2 __attribute__((ext_vector_type(2)));
constexpr float QK_C2 = 0.125f * 1.4426950408889634f;
__device__ __forceinline__ float rstd_of(const float* rowss, int row) { const f32x4* p = (const f32x4*)(rowss + (size_t)row * 16); const f32x4 a = p[0], b = p[1], c = p[2], d = p[3];
    const float s = (((a[0] + a[1]) + (a[2] + a[3])) + ((b[0] + b[1]) + (b[2] + b[3]))) + (((c[0] + c[1]) + (c[2] + c[3])) + ((d[0] + d[1]) + (d[2] + d[3]))); return __builtin_amdgcn_rsqf(s * (1.0f / 1024.0f) + 1e-6f); }
__device__ __forceinline__ f32x4 rstd_pre(const float* rowss, int row, int fq) { return *(const f32x4*)(rowss + (size_t)row * 16 + 4 * fq); }
__device__ __forceinline__ float rstd_fin(const f32x4 p) { float s = (p[0] + p[1]) + (p[2] + p[3]); s += lane_xor<16>(s); s = half_sum(s); return __builtin_amdgcn_rsqf(s * (1.0f / 1024.0f) + 1e-6f); }
__device__ __forceinline__ float bf2f(unsigned short b) { return __builtin_bit_cast(float, (unsigned)b << 16); }

template <int ACT  > struct EpiBf {
    static constexpr bool PERM = true, AFTER_DRAIN = false;
    bf16_t* O; int ldc; const float* rowss; int row_off;
    __device__ __forceinline__ void operator()(const f32x4 (&acc)[2][2][4][2], const Unit& u, int wr, int wc, int fr, int fq) const {
        const int row0 = u.pm * BM + wr * 64 + fr, col0 = u.pn * BM + wc * 32 + 8 * fq;
        f32x4 rp[2][4];
        if (rowss) {
#pragma unroll
            for (int ai = 0; ai < 2; ++ai)
#pragma unroll
                for (int m = 0; m < 4; ++m) rp[ai][m] = rstd_pre(rowss, row_off + row0 + ai * HALF + m * 16, fq); }
#pragma unroll
        for (int ai = 0; ai < 2; ++ai)
#pragma unroll
            for (int m = 0; m < 4; ++m) { const int rl = row0 + ai * HALF + m * 16; const float rs = rowss ? rstd_fin(rp[ai][m]) : 1.0f; bf16_t* rowp = O + (size_t)rl * ldc + col0;
#pragma unroll
                for (int bj = 0; bj < 2; ++bj) { f32x4 v0 = acc[ai][bj][m][0] * rs, v1 = acc[ai][bj][m][1] * rs;
                    if (ACT == 1) {
#pragma unroll
                        for (int i = 0; i < 4; ++i) { const float a = __builtin_fmaxf(v0[i], 0.f), b = __builtin_fmaxf(v1[i], 0.f); v0[i] = a * a; v1[i] = b * b; } }
                    u32x4 w; w.x = cvt_pk_bf16(v0[0], v0[1]); w.y = cvt_pk_bf16(v0[2], v0[3]); w.z = cvt_pk_bf16(v1[0], v1[1]); w.w = cvt_pk_bf16(v1[2], v1[3]);
                    if (ACT == 1) __builtin_nontemporal_store(w, (u32x4*)(rowp + bj * HALF));
                    else *(u32x4*)(rowp + bj * HALF) = w; } }
    }
};

template <int MODE> struct EpiQKV {
    static constexpr bool PERM = true, AFTER_DRAIN = false;
    bf16_t* O; long long offK, offV; const float* rowss; const float* cs; float* flog; const float* bfg;
    __device__ __forceinline__ void operator()(const f32x4 (&acc)[2][2][4][2], const Unit& u, int wr, int wc, int fr, int fq) const {
        const int colt = u.pn * BM, t = colt >> 10, cl = colt & 1023;
        const int row0 = u.pm * BM + wr * 64 + fr;
        f32x4 rp[2][4];
#pragma unroll
        for (int ai = 0; ai < 2; ++ai)
#pragma unroll
            for (int m = 0; m < 4; ++m) rp[ai][m] = rstd_pre(rowss, row0 + ai * HALF + m * 16, fq);
        float rsv[2][4];
#pragma unroll
        for (int ai = 0; ai < 2; ++ai)
#pragma unroll
            for (int m = 0; m < 4; ++m) rsv[ai][m] = rstd_fin(rp[ai][m]);
        if (MODE == 1 && t == 3) {
            if (wc == 0 && fq < 2) {
                const f32x4 b0 = *(const f32x4*)(bfg + 8 * fq), b1 = *(const f32x4*)(bfg + 8 * fq + 4);
#pragma unroll
                for (int ai = 0; ai < 2; ++ai)
#pragma unroll
                    for (int m = 0; m < 4; ++m) { const int row = row0 + ai * HALF + m * 16; const float rs = rsv[ai][m];
                        f32x4 v0 = acc[ai][0][m][0] * rs + b0, v1 = acc[ai][0][m][1] * rs + b1;
#pragma unroll
                        for (int i = 0; i < 4; ++i) { v0[i] = __builtin_fminf(v0[i], 0.f) - __logf(1.0f + __expf(-__builtin_fabsf(v0[i]))); v1[i] = __builtin_fminf(v1[i], 0.f) - __logf(1.0f + __expf(-__builtin_fabsf(v1[i])));     }
                        *(f32x4*)(flog + (size_t)row * 16 + 8 * fq) = v0; *(f32x4*)(flog + (size_t)row * 16 + 8 * fq + 4) = v1; }
            }
            return;
        }
        bf16_t* base = (bf16_t*)((char*)O + ((t == 0) ? 0ll : (t == 1) ? offK : offV)); const float sc = (t == 0) ? QK_C2 : 1.0f;
        const bool rope = (MODE == 0) && (t < 2) && !(wc & 1);
        const float sgn = (fq == 0) ? -1.0f : 1.0f;
        const int col0 = cl + wc * 32 + 8 * fq;
#pragma unroll
        for (int ai = 0; ai < 2; ++ai)
#pragma unroll
            for (int m = 0; m < 4; ++m) { const int row = row0 + ai * HALF + m * 16; const float rs = rsv[ai][m]; bf16_t* rowp = base + (size_t)row * 1024 + col0;
                f32x4 c0, c1, s0, s1;
                if (rope) { const float* cp = cs + (size_t)row * 16; c0 = *(const f32x4*)(cp); c1 = *(const f32x4*)(cp + 4); s0 = *(const f32x4*)(cp + 8) * sgn; s1 = *(const f32x4*)(cp + 12) * sgn; }
#pragma unroll
                for (int bj = 0; bj < 2; ++bj) { f32x4 v0 = acc[ai][bj][m][0] * rs, v1 = acc[ai][bj][m][1] * rs;
                    if (rope) { f32x4 p0, p1;
#pragma unroll
                        for (int i = 0; i < 4; ++i) { p0[i] = lane_xor<16>(v0[i]); p1[i] = lane_xor<16>(v1[i]); }
                        const f32x4 r0 = v0 * c0 + p0 * s0, r1 = v1 * c1 + p1 * s1;
                        if (fq < 2) { v0 = r0; v1 = r1; } }
                    v0 = v0 * sc; v1 = v1 * sc;
                    u32x4 w; w.x = cvt_pk_bf16(v0[0], v0[1]); w.y = cvt_pk_bf16(v0[2], v0[3]); w.z = cvt_pk_bf16(v1[0], v1[1]); w.w = cvt_pk_bf16(v1[2], v1[3]);
                    *(u32x4*)(rowp + bj * HALF) = w; } }
    }
};

template <int MODE> struct EpiRes {
    static constexpr bool PERM = true, AFTER_DRAIN = false;
    const bf16_t* res; bf16_t* hb; float* rowss_out; const float* rowss_in; const bf16_t* pl; int row_off;
    static __device__ __forceinline__ void unpack8(const u32x4 w, float (&f)[8]) {
        f[0] = __builtin_bit_cast(float, w.x << 16); f[1] = __builtin_bit_cast(float, w.x & 0xffff0000u); f[2] = __builtin_bit_cast(float, w.y << 16); f[3] = __builtin_bit_cast(float, w.y & 0xffff0000u);
        f[4] = __builtin_bit_cast(float, w.z << 16); f[5] = __builtin_bit_cast(float, w.z & 0xffff0000u); f[6] = __builtin_bit_cast(float, w.w << 16); f[7] = __builtin_bit_cast(float, w.w & 0xffff0000u); }
    __device__ __forceinline__ void operator()(const f32x4 (&acc)[2][2][4][2], const Unit& u, int wr, int wc, int fr, int fq) const {
        const int col0 = u.pn * BM + wc * 32 + 8 * fq, rowb = row_off + u.pm * BM + wr * 64 + fr;
#pragma unroll
        for (int am = 0; am < 4; ++am) { const int ai = am >> 1, mh = (am & 1) * 2;
            u32x4 rw[2][2], pw[2][2]; f32x4 rp[2];
#pragma unroll
            for (int mm = 0; mm < 2; ++mm) { const int rowq = rowb + ai * HALF + (mh + mm) * 16; if (MODE == 1) rp[mm] = rstd_pre(rowss_in, rowq, fq);
#pragma unroll
                for (int bj = 0; bj < 2; ++bj) { const size_t c = (size_t)rowq * 1024 + col0 + bj * HALF; rw[mm][bj] = *(const u32x4*)(res + c); if (MODE == 1) pw[mm][bj] = *(const u32x4*)(pl + c); } }
#pragma unroll
            for (int mm = 0; mm < 2; ++mm) { const int m = mh + mm; const int row = rowb + ai * HALF + m * 16; const size_t off = (size_t)row * 1024 + col0;
                float rs = 0.f; if (MODE == 1) rs = rstd_fin(rp[mm]);
                float ss = 0.f;
#pragma unroll
                for (int bj = 0; bj < 2; ++bj) { float r[8], o[8]; unpack8(rw[mm][bj], r);
                    const f32x4 a0 = acc[ai][bj][m][0], a1 = acc[ai][bj][m][1];
                    if (MODE == 1) { float p[8]; unpack8(pw[mm][bj], p);
#pragma unroll
                        for (int i = 0; i < 4; ++i) { const float g0 = __builtin_amdgcn_rcpf(1.0f + __builtin_amdgcn_exp2f(-a0[i] * rs * 1.4426950408889634f)), g1 = __builtin_amdgcn_rcpf(1.0f + __builtin_amdgcn_exp2f(-a1[i] * rs * 1.4426950408889634f));
                            o[i] = r[i] + p[i] * g0; o[4 + i] = r[4 + i] + p[4 + i] * g1; }
                    } else {
#pragma unroll
                        for (int i = 0; i < 4; ++i) { o[i] = r[i] + a0[i]; o[4 + i] = r[4 + i] + a1[i]; } }
                    u32x4 w; w.x = cvt_pk_bf16(o[0], o[1]); w.y = cvt_pk_bf16(o[2], o[3]); w.z = cvt_pk_bf16(o[4], o[5]); w.w = cvt_pk_bf16(o[6], o[7]);
                    *(u32x4*)(hb + off + bj * HALF) = w;
                    float q[8]; unpack8(w, q);
                    ss += ((q[0] * q[0] + q[1] * q[1]) + (q[2] * q[2] + q[3] * q[3])) + ((q[4] * q[4] + q[5] * q[5]) + (q[6] * q[6] + q[7] * q[7])); }
                ss += lane_xor<16>(ss); ss = half_sum(ss);
                if (fq == 0) rowss_out[(size_t)row * 16 + u.pn * 4 + wc] = ss;
            }
        }
    }
};

template <class Epi, class Sched, bool ALIGN_EPI = false, bool SP2 = false>
__device__ __forceinline__ void gemm_phase(PG8_LAS unsigned char* lds, const Gemm g, const Sched& S, const Epi& E) {
    int tid_ = threadIdx.x; asm volatile("" : "+v"(tid_));
    const int tid = tid_, wid = __builtin_amdgcn_readfirstlane(tid >> 6), lane = tid & 63, wr = wid >> 2, wc = wid & 3, fr = lane & 15, fq = lane >> 4;
    const int K = g.K, nt = K / BK;
    unsigned voffA[2], voffB[2];
#pragma unroll
    for (int i = 0; i < 2; ++i) { int R, C; stage_rc(tid * 16 + i * 8192, R, C); const int Rb = Epi::PERM ? ((R & ~31) + perm32(R & 31)) : R;
        voffA[i] = (unsigned)(R * K + C) * 2u; voffB[i] = (unsigned)(Rb * K + C) * 2u; }
    const size_t kstep = (size_t)(BK * 2);
    const size_t hstep = (size_t)HALF * K * 2;
    const size_t tstep = 2 * hstep;
    const unsigned ldsw = (unsigned)wid * 1024u;
    const int aoff = lds_byte(wr * 64 + fr, fq * 8), boff = lds_byte(wc * 32 + fr, fq * 8);
#define PG8_SA(b, h) (((b) * 2 + (h)) * HTB)
#define PG8_SB(b, h) ((4 + (b) * 2 + (h)) * HTB)
#define PG8_STAGE(bufoff, gbase, voff) do { _Pragma("unroll") for (int _i = 0; _i < 2; ++_i) \
        __builtin_amdgcn_global_load_lds((const unsigned*)((const char*)(gbase) + (voff)[_i]), (PG8_LAS unsigned*)(lds + (bufoff) + ldsw + _i * 8192), 16, 0, 0); } while (0)
#define PG8_LDA(dst, b, h) do { _Pragma("unroll") for (int m = 0; m < 4; ++m) _Pragma("unroll") for (int k = 0; k < 2; ++k) dst[m][k] = *(const PG8_LAS bf16x8*)(lds + PG8_SA(b, h) + aoff + m * 2048 + k * 1024); } while (0)
#define PG8_LDB(dst, b, h) do { _Pragma("unroll") for (int n = 0; n < 2; ++n) _Pragma("unroll") for (int k = 0; k < 2; ++k) dst[n][k] = *(const PG8_LAS bf16x8*)(lds + PG8_SB(b, h) + boff + n * 2048 + k * 1024); } while (0)
#define PG8_MMA(ai, bj, At, Bt) do { __builtin_amdgcn_s_setprio(1); _Pragma("unroll") for (int m = 0; m < 4; ++m) _Pragma("unroll") for (int n = 0; n < 2; ++n) _Pragma("unroll") for (int k = 0; k < 2; ++k) \
        acc[ai][bj][m][n] = __builtin_amdgcn_mfma_f32_16x16x32_bf16(Bt[n][k], At[m][k], acc[ai][bj][m][n], 0, 0, 0); __builtin_amdgcn_s_setprio(0); } while (0)
#define PG8_WAIT_V(n) asm volatile("s_waitcnt vmcnt(" #n ")" ::: "memory")
#define PG8_WAIT_L(n) asm volatile("s_waitcnt lgkmcnt(" #n ")" ::: "memory")
#define PG8_BAR __builtin_amdgcn_s_barrier()
#define PG8_SCHED __builtin_amdgcn_sched_barrier(0)
    Unit cur, nxt; int ui = 0;
    if (!S.next(0, cur)) return;
    f32x4 acc[2][2][4][2];
#pragma unroll
    for (int a = 0; a < 2; ++a)
#pragma unroll
        for (int b = 0; b < 2; ++b)
#pragma unroll
            for (int m = 0; m < 4; ++m)
#pragma unroll
                for (int n = 0; n < 2; ++n) acc[a][b][m][n] = (f32x4){0.f, 0.f, 0.f, 0.f};
    bf16x8 At[4][2], B0[2][2], B1[2][2];
    const char* cA = (const char*)g.A + (size_t)cur.pm * tstep; const char* cB = (const char*)g.Bt + (size_t)cur.pn * tstep;
    S.a_ready(cur);
    if constexpr (SP2) {
        PG8_STAGE(PG8_SB(0, 0), cB, voffB); PG8_STAGE(PG8_SB(0, 1), cB + hstep, voffB); PG8_STAGE(PG8_SA(0, 0), cA, voffA); PG8_STAGE(PG8_SA(0, 1), cA + hstep, voffA);
        if (wr == 1) PG8_BAR;
        PG8_WAIT_V(2); PG8_BAR;
        PG8_STAGE(PG8_SB(1, 0), cB + kstep, voffB); PG8_STAGE(PG8_SA(1, 0), cA + kstep, voffA); PG8_STAGE(PG8_SB(1, 1), cB + hstep + kstep, voffB);
        PG8_WAIT_V(6); PG8_BAR;
    } else {
        PG8_STAGE(PG8_SB(0, 0), cB, voffB); PG8_STAGE(PG8_SA(0, 0), cA, voffA); PG8_STAGE(PG8_SB(0, 1), cB + hstep, voffB); PG8_STAGE(PG8_SA(0, 1), cA + hstep, voffA);
        if (wr == 1) PG8_BAR;
        PG8_WAIT_V(4); PG8_BAR;
        PG8_STAGE(PG8_SB(1, 0), cB + kstep, voffB); PG8_STAGE(PG8_SA(1, 0), cA + kstep, voffA); PG8_STAGE(PG8_SB(1, 1), cB + hstep + kstep, voffB);
        PG8_WAIT_V(6); PG8_BAR;
    }
    for (;;) {
        const bool has_next = S.next(ui + 1, nxt);
        const char* nA = has_next ? (const char*)g.A + (size_t)nxt.pm * tstep : cA; const char* nB = has_next ? (const char*)g.Bt + (size_t)nxt.pn * tstep : cB;
        for (int t = 0; t < nt; t += 2) {
            const bool last = (t == nt - 2);
            const char* a1 = cA + (size_t)(t + 1) * kstep;
            const char* a2 = last ? nA : cA + (size_t)(t + 2) * kstep; const char* b2 = last ? nB : cB + (size_t)(t + 2) * kstep;
            const char* a3 = a2 + kstep; const char* b3 = b2 + kstep;
            if (last && has_next) S.a_ready(nxt);
            if constexpr (SP2) {
            PG8_LDB(B0, 0, 0); PG8_LDB(B1, 0, 1); PG8_SCHED; PG8_LDA(At, 0, 0); PG8_STAGE(PG8_SA(1, 1), a1 + hstep, voffA);
            PG8_WAIT_V(8); PG8_WAIT_L(0); PG8_BAR; PG8_MMA(0, 0, At, B0); PG8_MMA(0, 1, At, B1); PG8_BAR; PG8_SCHED;
            PG8_LDA(At, 0, 1); PG8_STAGE(PG8_SB(0, 0), b2, voffB); PG8_STAGE(PG8_SB(0, 1), b2 + hstep, voffB); PG8_STAGE(PG8_SA(0, 0), a2, voffA);
            PG8_WAIT_V(8); PG8_WAIT_L(0); PG8_BAR; PG8_MMA(1, 0, At, B0); PG8_MMA(1, 1, At, B1); PG8_BAR; PG8_SCHED;
            PG8_LDB(B0, 1, 0); PG8_LDB(B1, 1, 1); PG8_SCHED; PG8_LDA(At, 1, 0); PG8_STAGE(PG8_SA(0, 1), a2 + hstep, voffA);
            PG8_WAIT_V(8); PG8_WAIT_L(0); PG8_BAR; PG8_MMA(0, 0, At, B0); PG8_MMA(0, 1, At, B1); PG8_BAR; PG8_SCHED;
            PG8_LDA(At, 1, 1); PG8_STAGE(PG8_SB(1, 0), b3, voffB); PG8_STAGE(PG8_SB(1, 1), b3 + hstep, voffB); PG8_STAGE(PG8_SA(1, 0), a3, voffA);
            PG8_WAIT_V(8); PG8_WAIT_L(0); PG8_BAR; PG8_MMA(1, 0, At, B0); PG8_MMA(1, 1, At, B1); PG8_BAR; PG8_SCHED;
            } else {
            PG8_LDB(B0, 0, 0); PG8_SCHED; PG8_LDA(At, 0, 0); PG8_STAGE(PG8_SA(1, 1), a1 + hstep, voffA);
            PG8_WAIT_L(8); PG8_BAR; PG8_WAIT_L(0); PG8_MMA(0, 0, At, B0); PG8_BAR; PG8_SCHED;
            PG8_LDB(B1, 0, 1); PG8_STAGE(PG8_SB(0, 0), b2, voffB);
            PG8_BAR; PG8_WAIT_L(0); PG8_MMA(0, 1, At, B1); PG8_BAR;
            PG8_LDA(At, 0, 1); PG8_STAGE(PG8_SA(0, 0), a2, voffA);
            PG8_BAR; PG8_WAIT_L(0); PG8_MMA(1, 0, At, B0); PG8_BAR; PG8_SCHED;
            PG8_STAGE(PG8_SB(0, 1), b2 + hstep, voffB);
            PG8_WAIT_V(6); PG8_BAR; PG8_MMA(1, 1, At, B1); PG8_BAR;
            PG8_LDB(B0, 1, 0); PG8_SCHED; PG8_LDA(At, 1, 0); PG8_STAGE(PG8_SA(0, 1), a2 + hstep, voffA);
            PG8_WAIT_L(8); PG8_BAR; PG8_WAIT_L(0); PG8_MMA(0, 0, At, B0); PG8_BAR; PG8_SCHED;
            PG8_LDB(B1, 1, 1); PG8_STAGE(PG8_SB(1, 0), b3, voffB);
            PG8_BAR; PG8_WAIT_L(0); PG8_MMA(0, 1, At, B1); PG8_BAR;
            PG8_LDA(At, 1, 1); PG8_STAGE(PG8_SA(1, 0), a3, voffA);
            PG8_BAR; PG8_WAIT_L(0); PG8_MMA(1, 0, At, B0); PG8_BAR; PG8_SCHED;
            PG8_STAGE(PG8_SB(1, 1), b3 + hstep, voffB);
            PG8_WAIT_V(6); PG8_BAR; PG8_MMA(1, 1, At, B1); PG8_BAR;
            }
        }
        if constexpr (ALIGN_EPI) { if (wr == 0) PG8_BAR; }
        if constexpr (!Epi::AFTER_DRAIN) { int te_ = threadIdx.x; asm volatile("" : "+v"(te_)); const int le_ = te_ & 63, we_ = __builtin_amdgcn_readfirstlane(te_ >> 6);
            E(acc, cur, we_ >> 2, we_ & 3, le_ & 15, le_ >> 4); S.done(cur); }
        if (!has_next) break;
#pragma unroll
        for (int a = 0; a < 2; ++a)
#pragma unroll
            for (int b = 0; b < 2; ++b)
#pragma unroll
                for (int m = 0; m < 4; ++m)
#pragma unroll
                    for (int n = 0; n < 2; ++n) acc[a][b][m][n] = (f32x4){0.f, 0.f, 0.f, 0.f};
        cur = nxt; cA = nA; cB = nB; ++ui;
        if constexpr (ALIGN_EPI) { if (wr == 1) PG8_BAR; }
    }
    PG8_WAIT_V(0);
    if constexpr (!ALIGN_EPI) { if (wr == 0) PG8_BAR; }
    PG8_BAR;
    if constexpr (Epi::AFTER_DRAIN) { E.fused(acc, cur, wr, wc, fr, fq, lds, wid, lane); S.done(cur); }
#undef PG8_SA
#undef PG8_SB
#undef PG8_STAGE
#undef PG8_LDA
#undef PG8_LDB
#undef PG8_MMA
#undef PG8_WAIT_V
#undef PG8_WAIT_L
#undef PG8_BAR
#undef PG8_SCHED
}
}

#ifndef PG8_SP2
#define PG8_SP2 true
#endif
#ifndef PG8_ALIGN
#define PG8_ALIGN true
#endif
#include <hip/hip_bf16.h>
#include <cmath>
namespace attn_body {
using bf16=__hip_bfloat16;
using bf16x8=__attribute__((ext_vector_type(8)))short;
using s16x4=__attribute__((ext_vector_type(4)))short;
using f32x16=__attribute__((ext_vector_type(16)))float;
using u32x4=__attribute__((ext_vector_type(4)))unsigned;
constexpr int BATCH=4,NHEAD=16,SEQ=8192,D=64,DM=NHEAD*D;
constexpr int NW=8,QBLK=32,QB=QBLK*NW,KVBLK=64,NQB=SEQ/QB;
constexpr int ATTN_PITCH=DM, ATTN_UNIT_ROWS=QB;
__device__ __forceinline__ int crow(int r,int hi){return (r&3)+8*(r>>2)+4*hi;}
#define SBAR() __builtin_amdgcn_sched_barrier(0)
__device__ __forceinline__ void cmask(f32x16&p0,f32x16&p1,int jb,int qrel,int hi){
  const float NEG=-INFINITY; int kb=64*jb+4*hi;
  #pragma unroll
  for(int r=0;r<16;++r){int kv=kb+(r&3)+8*(r>>2); if(kv>qrel)p0[r]=NEG; if(kv+32>qrel)p1[r]=NEG;}
}

constexpr int NSLOT=3, SLOTB=8192;
constexpr int LDS_K=0, LDS_V=NSLOT*SLOTB, LDS_WS=2*NSLOT*SLOTB, LDS_OST=LDS_WS+NW*64*4, LDS_BIAS=LDS_OST+NW*4096  , LDS_BYTES=LDS_BIAS+32768;
constexpr float C2=0.125f*1.4426950408889634f;
__device__ __forceinline__ void glds16(const void*gsrc,unsigned lds_dst){unsigned keep;
  asm volatile("s_mov_b32 %0, m0\n\ts_mov_b32 m0, %2\n\ts_nop 0\n\tglobal_load_lds_dwordx4 %1, off\n\ts_mov_b32 m0, %0":"=&s"(keep):"v"(gsrc),"s"(lds_dst):"memory");}
__device__ __forceinline__ float max3f(float a,float b,float c){float r;asm("v_max3_f32 %0, %1, %2, %3":"=v"(r):"v"(a),"v"(b),"v"(c));return r;}
__device__ __forceinline__ float max2f(float a,float b){float r;asm("v_max_f32_e32 %0, %1, %2":"=v"(r):"v"(a),"v"(b));return r;}
__device__ __forceinline__ float fadd_s(float a,float b){float r;asm("v_add_f32_e32 %0, %1, %2":"=v"(r):"v"(a),"v"(b));return r;}
__device__ __forceinline__ float fsub_s(float a,float b){float r;asm("v_sub_f32_e32 %0, %1, %2":"=v"(r):"v"(a),"v"(b));return r;}
typedef float f32x2_t __attribute__((ext_vector_type(2))); typedef __bf16 bf16x2_t __attribute__((ext_vector_type(2)));
__device__ __forceinline__ unsigned cvtpk_s(float lo,float hi){f32x2_t v={lo,hi};bf16x2_t b=__builtin_convertvector(v,bf16x2_t);return __builtin_bit_cast(unsigned,b);}
#define WAIT_BAR(N) asm volatile("s_waitcnt vmcnt(" #N ") lgkmcnt(0)\n\ts_barrier":::"memory")

template<bool ACCUM> __device__ __forceinline__ void qkt(f32x16&p0,f32x16&p1,const char*Kslot,const bf16x8*qr,const f32x16&negm,int r32,int hi){
  const char*kb=Kslot+hi*1024+r32*16;
  #pragma unroll
  for(int d0=0;d0<4;++d0){
    const bf16x8 b0=*reinterpret_cast<const bf16x8*>(kb+d0*2048);
    const bf16x8 b1=*reinterpret_cast<const bf16x8*>(kb+d0*2048+512);
    if(d0==0&&!ACCUM){p0=__builtin_amdgcn_mfma_f32_32x32x16_bf16(b0,qr[0],negm,0,0,0);p1=__builtin_amdgcn_mfma_f32_32x32x16_bf16(b1,qr[0],negm,0,0,0);}
    else{p0=__builtin_amdgcn_mfma_f32_32x32x16_bf16(b0,qr[d0],p0,0,0,0);p1=__builtin_amdgcn_mfma_f32_32x32x16_bf16(b1,qr[d0],p1,0,0,0);}}
}
typedef __attribute__((address_space(3))) const char* lds_cptr;
typedef short v4i16_t __attribute__((ext_vector_type(4)));
__device__ __forceinline__ void kload8(bf16x8*kf,lds_cptr kp){
  kf[0]=*(const __attribute__((address_space(3))) bf16x8*)(kp);      kf[1]=*(const __attribute__((address_space(3))) bf16x8*)(kp+512);
  kf[2]=*(const __attribute__((address_space(3))) bf16x8*)(kp+2048); kf[3]=*(const __attribute__((address_space(3))) bf16x8*)(kp+2560);
  kf[4]=*(const __attribute__((address_space(3))) bf16x8*)(kp+4096); kf[5]=*(const __attribute__((address_space(3))) bf16x8*)(kp+4608);
  kf[6]=*(const __attribute__((address_space(3))) bf16x8*)(kp+6144); kf[7]=*(const __attribute__((address_space(3))) bf16x8*)(kp+6656);
}
__device__ __forceinline__ void kload2(bf16x8*kf,lds_cptr kp,int j){ kf[2*j]=*(const __attribute__((address_space(3))) bf16x8*)(kp+j*2048); kf[2*j+1]=*(const __attribute__((address_space(3))) bf16x8*)(kp+j*2048+512); }
__device__ __forceinline__ s16x4 vtr(lds_cptr p){ return __builtin_bit_cast(s16x4,__builtin_amdgcn_ds_read_tr16_b64_v4i16((__attribute__((address_space(3))) v4i16_t*)p)); }
__device__ __forceinline__ float rowmax(const f32x16&p0,const f32x16&p1){
  float a=max3f(p0[0],p0[1],p1[0]),b=max3f(p0[2],p0[3],p1[1]);a=max3f(a,p1[2],p1[3]);
  #pragma unroll
  for(int r=4;r<16;r+=4){a=max3f(a,p0[r],p0[r+1]);b=max3f(b,p0[r+2],p0[r+3]);a=max3f(a,p1[r],p1[r+1]);b=max3f(b,p1[r+2],p1[r+3]);}
  const float m=max2f(a,b);
  auto rr=__builtin_amdgcn_permlane32_swap(__float_as_uint(m),__float_as_uint(m),false,false);
  return max2f(__uint_as_float(rr[0]),__uint_as_float(rr[1]));
}
__device__ __forceinline__ void pv(f32x16*o,int vb,bf16x8 pa0,bf16x8 pa1,bf16x8 pa2,bf16x8 pa3){
  #pragma unroll
  for(int d0=0;d0<2;++d0){s16x4 lo[4],hi[4];
    #pragma unroll
    for(int ks=0;ks<4;++ks){
      asm volatile("ds_read_b64_tr_b16 %0,%1 offset:%c2":"=&v"(lo[ks]):"v"(vb),"i"(d0*4096+ks*1024):"memory");
      asm volatile("ds_read_b64_tr_b16 %0,%1 offset:%c2":"=&v"(hi[ks]):"v"(vb),"i"(d0*4096+ks*1024+512):"memory");}
    asm volatile("s_waitcnt lgkmcnt(0)":::"memory");SBAR();
    #define PK(k) (bf16x8){lo[k][0],lo[k][1],lo[k][2],lo[k][3],hi[k][0],hi[k][1],hi[k][2],hi[k][3]}
    o[d0]=__builtin_amdgcn_mfma_f32_32x32x16_bf16(pa0,PK(0),o[d0],0,0,0);
    o[d0]=__builtin_amdgcn_mfma_f32_32x32x16_bf16(pa1,PK(1),o[d0],0,0,0);
    o[d0]=__builtin_amdgcn_mfma_f32_32x32x16_bf16(pa2,PK(2),o[d0],0,0,0);
    o[d0]=__builtin_amdgcn_mfma_f32_32x32x16_bf16(pa3,PK(3),o[d0],0,0,0);
    #undef PK
  }
}

#ifndef ATTN_STORE16
#define ATTN_STORE16(p,v) (*(u32x4*)(p)=(v))
#endif
typedef float f32x4b __attribute__((ext_vector_type(4)));
__device__ __forceinline__ void binit(f32x16&c0,f32x16&c1,lds_cptr bp,float nm){
  #pragma unroll
  for(int g=0;g<4;++g){ const f32x4b a=*(const __attribute__((address_space(3))) f32x4b*)(bp+g*32); const f32x4b bb=*(const __attribute__((address_space(3))) f32x4b*)(bp+128+g*32);
    #pragma unroll
    for(int i=0;i<4;++i){ c0[4*g+i]=nm-a[i]; c1[4*g+i]=nm-bb[i]; } }
}
template<int THRL,bool BIAS> __device__ __forceinline__ void attn_unit(int b,int cq,int ck,int cv,int co,int qb,const bf16*Q,const bf16*__restrict__ K,const bf16*__restrict__ V,bf16*O,const float*cb,char*shm,int t0){
  int tid_=threadIdx.x; asm volatile("":"+v"(tid_)); const int tid=tid_,lane=tid&63,r32=lane&31,hi=lane>>5; const int wid=__builtin_amdgcn_readfirstlane(tid>>6);
  const long rowbase=(long)b*SEQ; const int q0=qb*QB;
  const bf16*Qw=Q+(rowbase+q0+wid*QBLK)*DM+cq;
  const bf16*Kh=K+(rowbase+(long)t0*KVBLK)*DM+ck,*Vh=V+(rowbase+(long)t0*KVBLK)*DM+cv;
  const unsigned lds0=(unsigned)(uintptr_t)shm;
  float*wsf=(float*)(shm+LDS_WS)+wid*64;
  const bf16*ksrc=Kh+(long)lane*DM+wid*8;
  const bf16*vsrc=Vh+(long)(16*(wid&3)+(lane>>2))*DM+(wid>>2)*32+(lane&3)*8;
  const unsigned kdst=lds0+LDS_K+wid*1024, vdst=lds0+LDS_V+wid*1024;
  #define DMA_K(t,slot) glds16(ksrc+(long)(t)*KVBLK*DM,(unsigned)__builtin_amdgcn_readfirstlane(kdst+(slot)))
  #define DMA_V(t,slot) glds16(vsrc+(long)(t)*KVBLK*DM,(unsigned)__builtin_amdgcn_readfirstlane(vdst+(slot)))
  const int vb0=(int)(lds0+LDS_V)+((lane>>4)&1)*32+(lane&3)*8+(4*hi+((lane&15)>>2))*64;
  const char*Kbase=shm+LDS_K; bf16x8 kf[8];
  const lds_cptr shm3=(lds_cptr)shm; const lds_cptr kp0=shm3+LDS_K+hi*1024+r32*16; const lds_cptr vp0=shm3+LDS_V+((lane>>4)&1)*32+(lane&3)*8+(4*hi+((lane&15)>>2))*64;
  const int NT=(q0+QB)/KVBLK-t0;
  float cqv=0.f,nm=0.f; const lds_cptr bp0=shm3+LDS_BIAS+hi*16+t0*256;
  if constexpr(BIAS){ for(int p=(t0>>2)+wid;p<=qb;p+=NW) glds16(cb+p*256+lane*4,(unsigned)__builtin_amdgcn_readfirstlane(lds0+LDS_BIAS+p*1024));
    cqv=cb[q0+wid*QBLK+r32]; }
  DMA_K(0,0);DMA_V(0,0);DMA_K(1,SLOTB);
  bf16x8 qr[4];
  #pragma unroll
  for(int d0=0;d0<4;++d0)qr[d0]=*reinterpret_cast<const bf16x8*>(&Qw[(long)r32*DM+d0*16+hi*8]);
  float mhat=0.f,l_reg=0.f;f32x16 o[2];o[0]=f32x16{};o[1]=f32x16{};f32x16 negm=f32x16{};if constexpr(!BIAS)asm volatile("":"+v"(negm));
  const int qrel=wid*QBLK+r32;
  #define CMASK(P0,P1,t) do{int jb_=(t)-(NT-4); if(jb_>=0)cmask(P0,P1,jb_,qrel,hi);}while(0)
  bool resc=false;
  #define START(P0,P1) do{ const float rm=rowmax(P0,P1); resc=false; \
    { const float dl=BIAS?__builtin_fmaxf(rm,0.f):rm; mhat=fadd_s(mhat,dl); \
      _Pragma("unroll") for(int r=0;r<16;++r){P0[r]=fsub_s(P0[r],dl);P1[r]=fsub_s(P1[r],dl);} \
      if constexpr(BIAS){ nm=cqv-mhat; } else { _Pragma("unroll") for(int r=0;r<16;++r)negm[r]=-mhat; asm volatile("":"+v"(negm)); } } \
    _Pragma("unroll") for(int r=0;r<16;++r)P0[r]=__builtin_amdgcn_exp2f(P0[r]); }while(0)
  #define RESC() do{ if(resc){ asm volatile("s_waitcnt lgkmcnt(0)":::"memory"); \
      _Pragma("unroll") for(int d_=0;d_<2;++d_) _Pragma("unroll") for(int r=0;r<16;++r)o[d_][r]*=wsf[crow(r,hi)]; } }while(0)
  f32x16 pA0,pA1,pB0,pB1;
  int sl_prev=0,sl_cur=0,sl_next=SLOTB;
  #define ROT() do{sl_prev=sl_cur;sl_cur=sl_next;sl_next=(sl_next==(NSLOT-1)*SLOTB)?0:sl_next+SLOTB;}while(0)
  DMA_K(2,2*SLOTB);
  WAIT_BAR(3);
  if constexpr(BIAS){ nm=cqv; binit(pA0,pA1,bp0,nm); qkt<true>(pA0,pA1,Kbase,qr,negm,r32,hi); } else { qkt<false>(pA0,pA1,Kbase,qr,negm,r32,hi); } asm volatile("s_nop 15\n\ts_nop 7":"+v"(pA0),"+v"(pA1));CMASK(pA0,pA1,0);
  START(pA0,pA1);
  _Pragma("unroll") for(int r=0;r<16;++r)pA1[r]=__builtin_amdgcn_exp2f(pA1[r]);
  WAIT_BAR(0);
  DMA_K(3,0);DMA_V(1,SLOTB);
  ROT();
  kload8(kf,kp0+sl_cur);
  WAIT_BAR(2);
  s16x4 vlo[8],vhi[8]; u32x4 pw0,pw1,pw2,pw3;
  #define PKW(P,B) cvtpk_s(P[B],P[B+1])
  #define PAF(k) __builtin_bit_cast(bf16x8,pw##k)
  #define VFR(i) (bf16x8){vlo[i][0],vlo[i][1],vlo[i][2],vlo[i][3],vhi[i][0],vhi[i][1],vhi[i][2],vhi[i][3]}
  #define PIN(x) asm volatile("":"+v"(x))
  #define MX3(a,b,c) __builtin_fmaxf(__builtin_fmaxf((a),(b)),(c))
  #define GAPA(MF,A0,A1,A2,A3,W0,W1,PW) do{ MF; sacc+=A0; sacc+=A1; sacc+=A2; sacc+=A3; PIN(sacc); W0; W1; PIN(PW); SBAR(); }while(0)
  #define EX(v) __builtin_amdgcn_exp2f(v)
  #define GAPB(MF,X,B) do{ MF; X[B]=EX(X[B]); X[B+1]=EX(X[B+1]); X[B+2]=EX(X[B+2]); X[B+3]=EX(X[B+3]); PIN(X); SBAR(); }while(0)
  #define VRD(i) do{ vlo[i]=vtr(vp_+(((i)>>2)*4096+((i)&3)*1024)); vhi[i]=vtr(vp_+(((i)>>2)*4096+((i)&3)*1024+512)); }while(0)
  #define KRD(G,j) do{ if(G){ kload2(kf,kp0+sl_next,j); SBAR(); } }while(0)
  #define STEP(C0,C1,P0,P1,t,GK,GV,GL) do{ SBAR(); \
    const lds_cptr vp_=vp0+sl_prev; \
    if constexpr(BIAS){ binit(C0,C1,bp0+(t)*256,nm); SBAR(); } \
    VRD(0); SBAR(); float sacc=(P0[0]+P0[1]); \
    GAPA(C0=__builtin_amdgcn_mfma_f32_32x32x16_bf16(kf[0],qr[0],BIAS?C0:negm,0,0,0), P0[2],P0[3],P0[4],P0[5],     pw0[0]=PKW(P0,0), pw0[1]=PKW(P0,2), pw0); \
    VRD(4); SBAR(); GAPA(C1=__builtin_amdgcn_mfma_f32_32x32x16_bf16(kf[1],qr[0],BIAS?C1:negm,0,0,0), P0[6],P0[7],P0[8],P0[9],     pw0[2]=PKW(P0,4), pw0[3]=PKW(P0,6), pw0); \
    VRD(1); SBAR(); GAPA(C0=__builtin_amdgcn_mfma_f32_32x32x16_bf16(kf[2],qr[1],C0,0,0,0),   P0[10],P0[11],P0[12],P0[13], pw1[0]=PKW(P0,8), pw1[1]=PKW(P0,10), pw1); \
    VRD(5); SBAR(); GAPA(C1=__builtin_amdgcn_mfma_f32_32x32x16_bf16(kf[3],qr[1],C1,0,0,0),   P0[14],P0[15],P1[0],P1[1],   pw1[2]=PKW(P0,12),pw1[3]=PKW(P0,14), pw1); \
    VRD(2); SBAR(); GAPA(C0=__builtin_amdgcn_mfma_f32_32x32x16_bf16(kf[4],qr[2],C0,0,0,0),   P1[2],P1[3],P1[4],P1[5],     pw2[0]=PKW(P1,0), pw2[1]=PKW(P1,2), pw2); \
    VRD(6); SBAR(); GAPA(C1=__builtin_amdgcn_mfma_f32_32x32x16_bf16(kf[5],qr[2],C1,0,0,0),   P1[6],P1[7],P1[8],P1[9],     pw2[2]=PKW(P1,4), pw2[3]=PKW(P1,6), pw2); \
    VRD(3); SBAR(); GAPA(C0=__builtin_amdgcn_mfma_f32_32x32x16_bf16(kf[6],qr[3],C0,0,0,0),   P1[10],P1[11],P1[12],P1[13], pw3[0]=PKW(P1,8), pw3[1]=PKW(P1,10), pw3); \
    VRD(7); SBAR(); GAPA(C1=__builtin_amdgcn_mfma_f32_32x32x16_bf16(kf[7],qr[3],C1,0,0,0),   P1[14],P1[15],0.f,0.f,       pw3[2]=PKW(P1,12),pw3[3]=PKW(P1,14), pw3); \
    l_reg+=sacc; \
    if(GK){DMA_K((t)+3,sl_cur);} if(GV){DMA_V((t)+1,sl_next);} \
    CMASK(C0,C1,t); \
    { float a=MX3(C0[0],C0[1],C1[0]),b=MX3(C0[2],C0[3],C1[1]); a=MX3(a,C1[2],C1[3]); \
      _Pragma("unroll") for(int r=4;r<16;r+=4){a=MX3(a,C0[r],C0[r+1]);b=MX3(b,C0[r+2],C0[r+3]);a=MX3(a,C1[r],C1[r+1]);b=MX3(b,C1[r+2],C1[r+3]);} \
      float rm=__builtin_fmaxf(a,b); { auto rr=__builtin_amdgcn_permlane32_swap(__float_as_uint(rm),__float_as_uint(rm),false,false); rm=__builtin_fmaxf(__uint_as_float(rr[0]),__uint_as_float(rr[1])); } \
      resc=false; \
      if(__builtin_expect(__any(rm>(float)THRL),0)){ const float dl=__builtin_fmaxf(rm,0.f); mhat+=dl; \
        _Pragma("unroll") for(int r=0;r<16;++r){C0[r]-=dl;C1[r]-=dl;} \
        if constexpr(BIAS){ nm=cqv-mhat; } else { _Pragma("unroll") for(int r=0;r<16;++r)negm[r]=-mhat; asm volatile("":"+v"(negm)); } \
        const float f=__builtin_amdgcn_exp2f(-dl); l_reg*=f; if(hi==0)wsf[r32]=f; resc=true; } } \
    SBAR(); \
    GAPB(o[0]=__builtin_amdgcn_mfma_f32_32x32x16_bf16(PAF(0),VFR(0),o[0],0,0,0), C0,0); \
    GAPB(o[1]=__builtin_amdgcn_mfma_f32_32x32x16_bf16(PAF(0),VFR(4),o[1],0,0,0), C0,4); \
    KRD(GL,0); GAPB(o[0]=__builtin_amdgcn_mfma_f32_32x32x16_bf16(PAF(1),VFR(1),o[0],0,0,0), C0,8); \
    KRD(GL,1); GAPB(o[1]=__builtin_amdgcn_mfma_f32_32x32x16_bf16(PAF(1),VFR(5),o[1],0,0,0), C0,12); \
    KRD(GL,2); GAPB(o[0]=__builtin_amdgcn_mfma_f32_32x32x16_bf16(PAF(2),VFR(2),o[0],0,0,0), C1,0); \
    KRD(GL,3); GAPB(o[1]=__builtin_amdgcn_mfma_f32_32x32x16_bf16(PAF(2),VFR(6),o[1],0,0,0), C1,4); \
    GAPB(o[0]=__builtin_amdgcn_mfma_f32_32x32x16_bf16(PAF(3),VFR(3),o[0],0,0,0), C1,8); \
    GAPB(o[1]=__builtin_amdgcn_mfma_f32_32x32x16_bf16(PAF(3),VFR(7),o[1],0,0,0), C1,12); \
    }while(0)
  int t=1;
  #undef CMASK
  #define CMASK(P0,P1,t) do{}while(0)
  for(;t+5<NT;t+=2){
    STEP(pB0,pB1,pA0,pA1,t,true,true,true);     WAIT_BAR(2); RESC(); ROT();
    STEP(pA0,pA1,pB0,pB1,t+1,true,true,true);   WAIT_BAR(2); RESC(); ROT();
  }
  #undef CMASK
  #define CMASK(P0,P1,t) do{int jb_=(t)-(NT-4); if(jb_>=0)cmask(P0,P1,jb_,qrel,hi);}while(0)
  #define ENDW(tt) do{ if((tt)+3<NT){WAIT_BAR(2);} else if((tt)+2<NT){WAIT_BAR(1);} else {WAIT_BAR(0);} }while(0)
  for(;t+1<NT;t+=2){
    STEP(pB0,pB1,pA0,pA1,t,(t+3<NT),(t+1<NT),(t+1<NT));       ENDW(t);   RESC(); ROT();
    STEP(pA0,pA1,pB0,pB1,t+1,(t+4<NT),(t+2<NT),(t+2<NT));     ENDW(t+1); RESC(); ROT();
  }
  STEP(pB0,pB1,pA0,pA1,NT-1,false,false,false); RESC();
  { float sacc=pB0[0]+pB0[1]; _Pragma("unroll") for(int r=2;r<16;++r)sacc+=pB0[r]; _Pragma("unroll") for(int r=0;r<16;++r)sacc+=pB1[r]; l_reg+=sacc;
    pw0=(u32x4){PKW(pB0,0),PKW(pB0,2),PKW(pB0,4),PKW(pB0,6)};pw1=(u32x4){PKW(pB0,8),PKW(pB0,10),PKW(pB0,12),PKW(pB0,14)};pw2=(u32x4){PKW(pB1,0),PKW(pB1,2),PKW(pB1,4),PKW(pB1,6)};pw3=(u32x4){PKW(pB1,8),PKW(pB1,10),PKW(pB1,12),PKW(pB1,14)};
    SBAR(); pv(o,vb0+sl_cur,PAF(0),PAF(1),PAF(2),PAF(3)); }
  #undef PKW
  #undef PAF
  #undef VFR
  #undef PIN
  #undef MX3
  #undef GAPA
  #undef GAPB
  #undef EX
  #undef VRD
  #undef KRD
  #undef STEP
  #undef ENDW
  {auto rr=__builtin_amdgcn_permlane32_swap(__float_as_uint(l_reg),__float_as_uint(l_reg),false,false);l_reg=__uint_as_float(rr[0])+__uint_as_float(rr[1]);}
  if(hi==0)wsf[32+r32]=l_reg;asm volatile("s_waitcnt lgkmcnt(0)":::"memory");
  float rli[16];
  #pragma unroll
  for(int r=0;r<16;++r)rli[r]=__builtin_amdgcn_rcpf(wsf[32+crow(r,hi)]);
  bf16*Ow=O+(rowbase+q0+wid*QBLK)*DM+co;
  { bf16*stg=(bf16*)(shm+LDS_OST)+wid*2048;
    #pragma unroll
    for(int r=0;r<16;++r){const int orow=crow(r,hi);
      #pragma unroll
      for(int d0=0;d0<2;++d0)stg[orow*64+d0*32+r32]=__float2bfloat16(o[d0][r]*rli[r]);}
    asm volatile("s_waitcnt lgkmcnt(0)":::"memory");
    #pragma unroll
    for(int i=0;i<4;++i){const int row=i*8+(lane>>3),ch=lane&7; const u32x4 v=*(const u32x4*)(stg+row*64+ch*8); ATTN_STORE16(Ow+(long)row*DM+ch*8,v);} }
  asm volatile("s_waitcnt lgkmcnt(0)\n\ts_barrier":::"memory");
  #undef DMA_K
  #undef DMA_V
  #undef CMASK
  #undef START
  #undef RESC
  #undef ROT
}
constexpr int DV_LDS_V=NSLOT*SLOTB, DV_LDS_WS=DV_LDS_V+NSLOT*2*SLOTB, DV_LDS_OST=DV_LDS_WS+NW*64*4, DV_LDS_BYTES=DV_LDS_OST+NW*4096;
static_assert(DV_LDS_BYTES<=LDS_BYTES,"dv variant fits the attention LDS budget");
template<int THRL> __device__ __forceinline__ void attn_unit_dv(int b,int cq,int ck,int cv,int co,int qb,const bf16*Q,const bf16*__restrict__ K,const bf16*__restrict__ V,bf16*O,char*shm){
  constexpr bool BIAS=false; constexpr int LDS_V=DV_LDS_V, LDS_WS=DV_LDS_WS, LDS_OST=DV_LDS_OST;
  int tid_=threadIdx.x; asm volatile("":"+v"(tid_)); const int tid=tid_,lane=tid&63,r32=lane&31,hi=lane>>5; const int wid=__builtin_amdgcn_readfirstlane(tid>>6);
  const long rowbase=(long)b*SEQ; const int q0=qb*QB;
  const bf16*Qw=Q+(rowbase+q0+wid*QBLK)*DM+cq;
  const bf16*Kh=K+rowbase*DM+ck,*Vh=V+rowbase*DM+cv;
  const unsigned lds0=(unsigned)(uintptr_t)shm;
  float*wsf=(float*)(shm+LDS_WS)+wid*64;
  const bf16*ksrc=Kh+(long)lane*DM+wid*8;
  const bf16*vsrc=Vh+(long)(16*(wid&3)+(lane>>2))*DM+(wid>>2)*32+(lane&3)*8;
  const unsigned kdst=lds0+LDS_K+wid*1024, vdst=lds0+LDS_V+wid*1024;
  #define DMA_K(t,slot) glds16(ksrc+(long)(t)*KVBLK*DM,(unsigned)__builtin_amdgcn_readfirstlane(kdst+(slot)))
  #define DMA_V(t,slot) do{ glds16(vsrc+(long)(t)*KVBLK*DM,(unsigned)__builtin_amdgcn_readfirstlane(vdst+2*(slot))); glds16(vsrc+(long)(t)*KVBLK*DM+64,(unsigned)__builtin_amdgcn_readfirstlane(vdst+2*(slot)+8192)); }while(0)
  const int vb0=(int)(lds0+LDS_V)+((lane>>4)&1)*32+(lane&3)*8+(4*hi+((lane&15)>>2))*64;
  const char*Kbase=shm+LDS_K; bf16x8 kf[8];
  const lds_cptr shm3=(lds_cptr)shm; const lds_cptr kp0=shm3+LDS_K+hi*1024+r32*16; const lds_cptr vp0=shm3+LDS_V+((lane>>4)&1)*32+(lane&3)*8+(4*hi+((lane&15)>>2))*64;
  const int NT=(q0+QB)/KVBLK;
  DMA_K(0,0);DMA_V(0,0);DMA_K(1,SLOTB);
  bf16x8 qr[4];
  #pragma unroll
  for(int d0=0;d0<4;++d0)qr[d0]=*reinterpret_cast<const bf16x8*>(&Qw[(long)r32*DM+d0*16+hi*8]);
  float mhat=0.f,l_reg=0.f;f32x16 o[4];o[0]=f32x16{};o[1]=f32x16{};o[2]=f32x16{};o[3]=f32x16{};const f32x16 negm=f32x16{};
  const int qrel=wid*QBLK+r32;
  #define CMASK(P0,P1,t) do{int jb_=(t)-(NT-4); if(jb_>=0)cmask(P0,P1,jb_,qrel,hi);}while(0)
  bool resc=false;
  #define START(P0,P1) do{ const float rm=rowmax(P0,P1); resc=false; \
    { const float dl=BIAS?__builtin_fmaxf(rm,0.f):rm; mhat=fadd_s(mhat,dl); \
      _Pragma("unroll") for(int r=0;r<16;++r){P0[r]=fsub_s(P0[r],dl);P1[r]=fsub_s(P1[r],dl);} \
      } \
    _Pragma("unroll") for(int r=0;r<16;++r)P0[r]=__builtin_amdgcn_exp2f(P0[r]); }while(0)
  #define RESC() do{ if(resc){ asm volatile("s_waitcnt lgkmcnt(0)":::"memory"); \
      _Pragma("unroll") for(int d_=0;d_<4;++d_) _Pragma("unroll") for(int r=0;r<16;++r)o[d_][r]*=wsf[crow(r,hi)]; } }while(0)
  f32x16 pA0,pA1,pB0,pB1;
  int sl_prev=0,sl_cur=0,sl_next=SLOTB;
  #define ROT() do{sl_prev=sl_cur;sl_cur=sl_next;sl_next=(sl_next==(NSLOT-1)*SLOTB)?0:sl_next+SLOTB;}while(0)
  DMA_K(2,2*SLOTB);
  WAIT_BAR(4);
  qkt<false>(pA0,pA1,Kbase,qr,negm,r32,hi); asm volatile("s_nop 15\n\ts_nop 7":"+v"(pA0),"+v"(pA1));CMASK(pA0,pA1,0);
  START(pA0,pA1);
  _Pragma("unroll") for(int r=0;r<16;++r)pA1[r]=__builtin_amdgcn_exp2f(pA1[r]);
  WAIT_BAR(0);
  DMA_K(3,0);DMA_V(1,SLOTB);
  ROT();
  kload8(kf,kp0+sl_cur);
  WAIT_BAR(3);
  s16x4 vlo[8],vhi[8]; u32x4 pw0,pw1,pw2,pw3;
  #define PKW(P,B) cvtpk_s(P[B],P[B+1])
  #define PAF(k) __builtin_bit_cast(bf16x8,pw##k)
  #define VFR(i) (bf16x8){vlo[i][0],vlo[i][1],vlo[i][2],vlo[i][3],vhi[i][0],vhi[i][1],vhi[i][2],vhi[i][3]}
  #define PIN(x) asm volatile("":"+v"(x))
  #define MX3(a,b,c) __builtin_fmaxf(__builtin_fmaxf((a),(b)),(c))
  #define GAPA(MF,A0,A1,A2,A3,W0,W1,PW) do{ MF; sacc+=A0; sacc+=A1; sacc+=A2; sacc+=A3; PIN(sacc); W0; W1; PIN(PW); SBAR(); }while(0)
  #define EX(v) __builtin_amdgcn_exp2f(v)
  #define GAPB(MF,X,B) do{ MF; X[B]=EX(X[B]); X[B+1]=EX(X[B+1]); X[B+2]=EX(X[B+2]); X[B+3]=EX(X[B+3]); PIN(X); SBAR(); }while(0)
  #define VRD(i) do{ vlo[i]=vtr(vp_+(((i)>>2)*4096+((i)&3)*1024)); vhi[i]=vtr(vp_+(((i)>>2)*4096+((i)&3)*1024+512)); }while(0)
  #define VRD2(i) do{ vlo[i]=vtr(vp_+(8192+((i)>>2)*4096+((i)&3)*1024)); vhi[i]=vtr(vp_+(8192+((i)>>2)*4096+((i)&3)*1024+512)); }while(0)
  #define GAPB2(MF,X,B) do{ MF; X[B]=EX(X[B]-mhat); X[B+1]=EX(X[B+1]-mhat); PIN(X); SBAR(); }while(0)
  #define KRD(G,j) do{ if(G){ kload2(kf,kp0+sl_next,j); SBAR(); } }while(0)
  #define STEP(C0,C1,P0,P1,t,GK,GV,GL) do{ SBAR(); \
    const lds_cptr vp_=vp0+2*sl_prev; \
    VRD(0); SBAR(); float sacc=(P0[0]+P0[1]); \
    GAPA(C0=__builtin_amdgcn_mfma_f32_32x32x16_bf16(kf[0],qr[0],negm,0,0,0), P0[2],P0[3],P0[4],P0[5],     pw0[0]=PKW(P0,0), pw0[1]=PKW(P0,2), pw0); \
    VRD(4); SBAR(); GAPA(C1=__builtin_amdgcn_mfma_f32_32x32x16_bf16(kf[1],qr[0],negm,0,0,0), P0[6],P0[7],P0[8],P0[9],     pw0[2]=PKW(P0,4), pw0[3]=PKW(P0,6), pw0); \
    VRD(1); SBAR(); GAPA(C0=__builtin_amdgcn_mfma_f32_32x32x16_bf16(kf[2],qr[1],C0,0,0,0),   P0[10],P0[11],P0[12],P0[13], pw1[0]=PKW(P0,8), pw1[1]=PKW(P0,10), pw1); \
    VRD(5); SBAR(); GAPA(C1=__builtin_amdgcn_mfma_f32_32x32x16_bf16(kf[3],qr[1],C1,0,0,0),   P0[14],P0[15],P1[0],P1[1],   pw1[2]=PKW(P0,12),pw1[3]=PKW(P0,14), pw1); \
    VRD(2); SBAR(); GAPA(C0=__builtin_amdgcn_mfma_f32_32x32x16_bf16(kf[4],qr[2],C0,0,0,0),   P1[2],P1[3],P1[4],P1[5],     pw2[0]=PKW(P1,0), pw2[1]=PKW(P1,2), pw2); \
    VRD(6); SBAR(); GAPA(C1=__builtin_amdgcn_mfma_f32_32x32x16_bf16(kf[5],qr[2],C1,0,0,0),   P1[6],P1[7],P1[8],P1[9],     pw2[2]=PKW(P1,4), pw2[3]=PKW(P1,6), pw2); \
    VRD(3); SBAR(); GAPA(C0=__builtin_amdgcn_mfma_f32_32x32x16_bf16(kf[6],qr[3],C0,0,0,0),   P1[10],P1[11],P1[12],P1[13], pw3[0]=PKW(P1,8), pw3[1]=PKW(P1,10), pw3); \
    VRD(7); SBAR(); GAPA(C1=__builtin_amdgcn_mfma_f32_32x32x16_bf16(kf[7],qr[3],C1,0,0,0),   P1[14],P1[15],0.f,0.f,       pw3[2]=PKW(P1,12),pw3[3]=PKW(P1,14), pw3); \
    l_reg+=sacc; \
    if(GK){DMA_K((t)+3,sl_cur);} if(GV){DMA_V((t)+1,sl_next);} \
    CMASK(C0,C1,t); \
    { float a=MX3(C0[0],C0[1],C1[0]),b=MX3(C0[2],C0[3],C1[1]); a=MX3(a,C1[2],C1[3]); \
      _Pragma("unroll") for(int r=4;r<16;r+=4){a=MX3(a,C0[r],C0[r+1]);b=MX3(b,C0[r+2],C0[r+3]);a=MX3(a,C1[r],C1[r+1]);b=MX3(b,C1[r+2],C1[r+3]);} \
      float rm=__builtin_fmaxf(a,b); { auto rr=__builtin_amdgcn_permlane32_swap(__float_as_uint(rm),__float_as_uint(rm),false,false); rm=__builtin_fmaxf(__uint_as_float(rr[0]),__uint_as_float(rr[1])); } \
      resc=false; \
      rm-=mhat; \
      if(__builtin_expect(__any(rm>(float)THRL),0)){ const float dl=__builtin_fmaxf(rm,0.f); mhat+=dl; \
        const float f=__builtin_amdgcn_exp2f(-dl); l_reg*=f; if(hi==0)wsf[r32]=f; resc=true; } } \
    SBAR(); \
    GAPB2(o[0]=__builtin_amdgcn_mfma_f32_32x32x16_bf16(PAF(0),VFR(0),o[0],0,0,0), C0,0);  VRD2(0); SBAR(); \
    GAPB2(o[1]=__builtin_amdgcn_mfma_f32_32x32x16_bf16(PAF(0),VFR(4),o[1],0,0,0), C0,2);  VRD2(4); SBAR(); \
    KRD(GL,0); GAPB2(o[0]=__builtin_amdgcn_mfma_f32_32x32x16_bf16(PAF(1),VFR(1),o[0],0,0,0), C0,4);  VRD2(1); SBAR(); \
    KRD(GL,1); GAPB2(o[1]=__builtin_amdgcn_mfma_f32_32x32x16_bf16(PAF(1),VFR(5),o[1],0,0,0), C0,6);  VRD2(5); SBAR(); \
    KRD(GL,2); GAPB2(o[0]=__builtin_amdgcn_mfma_f32_32x32x16_bf16(PAF(2),VFR(2),o[0],0,0,0), C0,8);  VRD2(2); SBAR(); \
    KRD(GL,3); GAPB2(o[1]=__builtin_amdgcn_mfma_f32_32x32x16_bf16(PAF(2),VFR(6),o[1],0,0,0), C0,10); VRD2(6); SBAR(); \
    GAPB2(o[0]=__builtin_amdgcn_mfma_f32_32x32x16_bf16(PAF(3),VFR(3),o[0],0,0,0), C0,12); VRD2(3); SBAR(); \
    GAPB2(o[1]=__builtin_amdgcn_mfma_f32_32x32x16_bf16(PAF(3),VFR(7),o[1],0,0,0), C0,14); VRD2(7); SBAR(); \
    GAPB2(o[2]=__builtin_amdgcn_mfma_f32_32x32x16_bf16(PAF(0),VFR(0),o[2],0,0,0), C1,0); \
    GAPB2(o[3]=__builtin_amdgcn_mfma_f32_32x32x16_bf16(PAF(0),VFR(4),o[3],0,0,0), C1,2); \
    GAPB2(o[2]=__builtin_amdgcn_mfma_f32_32x32x16_bf16(PAF(1),VFR(1),o[2],0,0,0), C1,4); \
    GAPB2(o[3]=__builtin_amdgcn_mfma_f32_32x32x16_bf16(PAF(1),VFR(5),o[3],0,0,0), C1,6); \
    GAPB2(o[2]=__builtin_amdgcn_mfma_f32_32x32x16_bf16(PAF(2),VFR(2),o[2],0,0,0), C1,8); \
    GAPB2(o[3]=__builtin_amdgcn_mfma_f32_32x32x16_bf16(PAF(2),VFR(6),o[3],0,0,0), C1,10); \
    GAPB2(o[2]=__builtin_amdgcn_mfma_f32_32x32x16_bf16(PAF(3),VFR(3),o[2],0,0,0), C1,12); \
    GAPB2(o[3]=__builtin_amdgcn_mfma_f32_32x32x16_bf16(PAF(3),VFR(7),o[3],0,0,0), C1,14); \
    }while(0)
  int t=1;
  #undef CMASK
  #define CMASK(P0,P1,t) do{}while(0)
  for(;t+5<NT;t+=2){
    STEP(pB0,pB1,pA0,pA1,t,true,true,true);     WAIT_BAR(3); RESC(); ROT();
    STEP(pA0,pA1,pB0,pB1,t+1,true,true,true);   WAIT_BAR(3); RESC(); ROT();
  }
  #undef CMASK
  #define CMASK(P0,P1,t) do{int jb_=(t)-(NT-4); if(jb_>=0)cmask(P0,P1,jb_,qrel,hi);}while(0)
  #define ENDW(tt) do{ if((tt)+3<NT){WAIT_BAR(3);} else if((tt)+2<NT){WAIT_BAR(2);} else {WAIT_BAR(0);} }while(0)
  for(;t+1<NT;t+=2){
    STEP(pB0,pB1,pA0,pA1,t,(t+3<NT),(t+1<NT),(t+1<NT));       ENDW(t);   RESC(); ROT();
    STEP(pA0,pA1,pB0,pB1,t+1,(t+4<NT),(t+2<NT),(t+2<NT));     ENDW(t+1); RESC(); ROT();
  }
  STEP(pB0,pB1,pA0,pA1,NT-1,false,false,false); RESC();
  { float sacc=pB0[0]+pB0[1]; _Pragma("unroll") for(int r=2;r<16;++r)sacc+=pB0[r]; _Pragma("unroll") for(int r=0;r<16;++r)sacc+=pB1[r]; l_reg+=sacc;
    pw0=(u32x4){PKW(pB0,0),PKW(pB0,2),PKW(pB0,4),PKW(pB0,6)};pw1=(u32x4){PKW(pB0,8),PKW(pB0,10),PKW(pB0,12),PKW(pB0,14)};pw2=(u32x4){PKW(pB1,0),PKW(pB1,2),PKW(pB1,4),PKW(pB1,6)};pw3=(u32x4){PKW(pB1,8),PKW(pB1,10),PKW(pB1,12),PKW(pB1,14)};
    SBAR(); pv(o,vb0+2*sl_cur,PAF(0),PAF(1),PAF(2),PAF(3)); pv(o+2,vb0+2*sl_cur+8192,PAF(0),PAF(1),PAF(2),PAF(3)); }
  #undef PKW
  #undef PAF
  #undef VFR
  #undef PIN
  #undef MX3
  #undef GAPA
  #undef GAPB
  #undef EX
  #undef VRD
  #undef VRD2
  #undef GAPB2
  #undef KRD
  #undef STEP
  #undef ENDW
  {auto rr=__builtin_amdgcn_permlane32_swap(__float_as_uint(l_reg),__float_as_uint(l_reg),false,false);l_reg=__uint_as_float(rr[0])+__uint_as_float(rr[1]);}
  if(hi==0)wsf[32+r32]=l_reg;asm volatile("s_waitcnt lgkmcnt(0)":::"memory");
  float rli[16];
  #pragma unroll
  for(int r=0;r<16;++r)rli[r]=__builtin_amdgcn_rcpf(wsf[32+crow(r,hi)]);
  bf16*Ow=O+(rowbase+q0+wid*QBLK)*DM+co;
  { bf16*stg=(bf16*)(shm+LDS_OST)+wid*2048;
    #pragma unroll
    for(int ps=0;ps<2;++ps){
      #pragma unroll
      for(int r=0;r<16;++r){const int orow=crow(r,hi);
        #pragma unroll
        for(int d0=0;d0<2;++d0)stg[orow*64+d0*32+r32]=__float2bfloat16(o[2*ps+d0][r]*rli[r]);}
      asm volatile("s_waitcnt lgkmcnt(0)":::"memory");
      #pragma unroll
      for(int i=0;i<4;++i){const int row=i*8+(lane>>3),ch=lane&7; const u32x4 v=*(const u32x4*)(stg+row*64+ch*8); ATTN_STORE16(Ow+(long)row*DM+ps*64+ch*8,v);}
      asm volatile("s_waitcnt lgkmcnt(0)":::"memory"); } }
  asm volatile("s_waitcnt lgkmcnt(0)\n\ts_barrier":::"memory");
  #undef DMA_K
  #undef DMA_V
  #undef CMASK
  #undef START
  #undef RESC
  #undef ROT
}
constexpr int ATTN_LDS_BYTES=LDS_BYTES;
#undef SBAR
#undef WAIT_BAR
}
#include <hip/hip_cooperative_groups.h>
namespace cg = cooperative_groups;
#ifndef PROBE_MASK
#define PROBE_MASK 0
#endif
#ifndef MK_SPLIT
#define MK_SPLIT 0
#endif
constexpr int NWAVES = 8;
constexpr int BATCH = 4, SEQ = 8192, T = BATCH * SEQ, D = 1024, FF = 4096, PLE = 256, DEPTH = 4, NFH = 16;
constexpr int TH = T / 2;
constexpr size_t MiB = 1u << 20;
constexpr size_t WS_ROWSS = 8 * MiB;
constexpr size_t WS_T0 = 1 * MiB;
constexpr float SKIP_LOG2 = -160.0f;
constexpr size_t WS_CS = 2 * MiB;
constexpr size_t WS_FLOG = 4 * MiB;
constexpr size_t WS_CK = 6 * MiB;
constexpr size_t W_QKV = 16 * MiB;
constexpr size_t W_O = 23 * MiB;
constexpr size_t W_1 = 25 * MiB;
constexpr size_t W_2 = 33 * MiB;
constexpr size_t W_PLE = 41 * MiB;
constexpr size_t W_G = 42 * MiB;
constexpr size_t WS_HBX = 48 * MiB, WS_HBY = 112 * MiB, WS_R1 = 176 * MiB, WS_PL = 432 * MiB, WS_END = 496 * MiB;
constexpr int RING_BYTES = 131072, LDS_BYTES = 147456;
static_assert(attn_body::ATTN_LDS_BYTES <= RING_BYTES, "attention LDS");

#define GAS __attribute__((address_space(1)))
#define LAS __attribute__((address_space(3)))
typedef unsigned short bf16;
typedef unsigned v4u __attribute__((ext_vector_type(4)));
typedef float f32x4 __attribute__((ext_vector_type(4)));
#define LDS_WAIT() asm volatile("s_waitcnt lgkmcnt(0)" ::: "memory")
__device__ __forceinline__ unsigned f2bf(float f) { unsigned u = __builtin_bit_cast(unsigned, f); return (u + 0x7fffu + ((u >> 16) & 1u)) >> 16; }
__device__ __forceinline__ unsigned pk2(float lo, float hi) { return f2bf(lo) | (f2bf(hi) << 16); }
__device__ __forceinline__ float wave_sum(float v) {
    v += pg8::lane_xor<1>(v); v += pg8::lane_xor<2>(v); v += pg8::lane_xor<4>(v); v += pg8::lane_xor<8>(v); v += pg8::lane_xor<16>(v);
    return pg8::half_sum(v);
}

constexpr int N_PHASES = 1 + 7 + 7 + 7 + 6 + 1;
enum { K_PRO = 0, K_QKVA, K_ATTA, K_COMB, K_QKVB, K_SCAN, K_ATTB, K_RES, K_W1, K_GATE, K_FIN };
struct Args { const float* in[21]; float* out; unsigned char* ws; float inv_freq[8]; int ph_lo, ph_hi; int prog[N_PHASES + 1]; };

#define CAS __attribute__((address_space(4)))
struct Frame { LAS unsigned char* lds; int tid, lane, wave, vcu, G; const CAS Args* a; };

__device__ __forceinline__ void transpose_item(const float* W, int ldw, int coff, int ncols, int K, const float* gain, bf16* WT, int row_off, LAS float* scr, int item, int nblk, int lane) {
    const int kb = item / nblk, nb = item % nblk, k0 = 64 * kb, n0 = 32 * nb;
#pragma unroll
    for (int i = 0; i < 8; ++i) { const int kk = 8 * i + (lane >> 3), n4 = (lane & 7) * 4, n = n0 + n4;
        f32x4 v = (n < ncols) ? *(const GAS f32x4*)(W + (size_t)(k0 + kk) * ldw + coff + n) : (f32x4){0.f, 0.f, 0.f, 0.f};
        if (gain) v = v * gain[k0 + kk];
        LAS float* d = scr + kk * 33 + n4; d[0] = v.x; d[1] = v.y; d[2] = v.z; d[3] = v.w; }
    LDS_WAIT(); asm volatile("" ::: "memory");
    const int c = lane & 7;
#pragma unroll
    for (int j = 0; j < 4; ++j) { const int n = (lane >> 3) + 8 * j; const LAS float* s = scr + (8 * c) * 33 + n;
        v4u o; o.x = pk2(s[0 * 33], s[1 * 33]); o.y = pk2(s[2 * 33], s[3 * 33]); o.z = pk2(s[4 * 33], s[5 * 33]); o.w = pk2(s[6 * 33], s[7 * 33]);
        *(GAS v4u*)(WT + (size_t)(row_off + n0 + n) * K + k0 + 8 * c) = o; }
    LDS_WAIT(); asm volatile("" ::: "memory");
}

__device__ __forceinline__ void convert_layer(Frame& F, int L) {
    const CAS Args& A = *F.a; unsigned char* ws = A.ws;
    LAS float* scr = (LAS float*)(F.lds + F.wave * 16384);
    const int gw = F.vcu * NWAVES + F.wave, NGW = F.G * NWAVES;
    bf16* Wqkv = (bf16*)(ws + W_QKV); bf16* Wo = (bf16*)(ws + W_O); bf16* W1 = (bf16*)(ws + W_1); bf16* W2 = (bf16*)(ws + W_2); bf16* Wp = (bf16*)(ws + W_PLE); bf16* Wg = (bf16*)(ws + W_G + (size_t)(L & 1) * 2 * MiB);
    const bool isA = L < 2; const int j = L - 2;
    const int I_QKV = isA ? 16 * 96 : 16 * 32, I_KV = (!isA && j == 0) ? 16 * 64 : 0, I_F = (!isA && j == 0) ? 16 : 0, I_O = 16 * 32, I_1 = 16 * 128, I_2 = 64 * 32, I_G = 16 * 32, I_P = 4 * 32;
    const int NIT = I_QKV + I_KV + I_F + I_O + I_1 + I_2 + I_G + I_P;
    for (int it = gw; it < NIT; it += NGW) {
        int r = it;
        if (r < I_QKV) { if (isA) transpose_item(A.in[4] + (size_t)L * D * 3 * D, 3 * D, 0, 3 * D, D, A.in[3] + L * D, Wqkv, 0, scr, r, 96, F.lane);
                         else transpose_item(A.in[12] + (size_t)j * D * D, D, 0, D, D, A.in[11] + j * D, Wqkv, 0, scr, r, 32, F.lane); continue; } r -= I_QKV;
        if (r < I_KV) { transpose_item(A.in[9], 2 * D + NFH, 0, 2 * D, D, A.in[8], Wqkv, D, scr, r, 64, F.lane); continue; } r -= I_KV;
        if (r < I_F) { transpose_item(A.in[9], 2 * D + NFH, 2 * D, NFH, D, A.in[8], Wqkv, 3 * D, scr, r, 1, F.lane); continue; } r -= I_F;
        if (r < I_O) { transpose_item(isA ? A.in[7] + (size_t)L * D * D : A.in[13] + (size_t)j * D * D, D, 0, D, D, nullptr, Wo, 0, scr, r, 32, F.lane); continue; } r -= I_O;
        if (r < I_1) { transpose_item(A.in[15] + (size_t)L * D * FF, FF, 0, FF, D, A.in[14] + L * D, W1, 0, scr, r, 128, F.lane); continue; } r -= I_1;
        if (r < I_2) { transpose_item(A.in[16] + (size_t)L * FF * D, D, 0, D, FF, nullptr, W2, 0, scr, r, 32, F.lane); continue; } r -= I_2;
        if (r < I_G) { transpose_item(A.in[18] + (size_t)L * D * D, D, 0, D, D, A.in[17] + L * D, Wg, 0, scr, r, 32, F.lane); continue; } r -= I_G;
        transpose_item(A.in[19] + (size_t)L * PLE * D, D, 0, D, PLE, nullptr, Wp, 0, scr, r, 32, F.lane);
    }
}

__device__ __forceinline__ void sincos_red(double r, float& s, float& c) {
    const double r2 = r * r;
    double sp = -1.0 / 51090942171709440000.0;
    sp = sp * r2 + 1.0 / 121645100408832000.0;
    sp = sp * r2 - 1.0 / 355687428096000.0;
    sp = sp * r2 + 1.0 / 1307674368000.0;
    sp = sp * r2 - 1.0 / 6227020800.0;
    sp = sp * r2 + 1.0 / 39916800.0;
    sp = sp * r2 - 1.0 / 362880.0;
    sp = sp * r2 + 1.0 / 5040.0;
    sp = sp * r2 - 1.0 / 120.0;
    sp = sp * r2 + 1.0 / 6.0;
    sp = sp * r2 - 1.0;
    s = (float)(-(sp * r));
    double cp = 1.0 / 1124000727777607680000.0;
    cp = cp * r2 - 1.0 / 2432902008176640000.0;
    cp = cp * r2 + 1.0 / 6402373705728000.0;
    cp = cp * r2 - 1.0 / 20922789888000.0;
    cp = cp * r2 + 1.0 / 87178291200.0;
    cp = cp * r2 - 1.0 / 479001600.0;
    cp = cp * r2 + 1.0 / 3628800.0;
    cp = cp * r2 - 1.0 / 40320.0;
    cp = cp * r2 + 1.0 / 720.0;
    cp = cp * r2 - 1.0 / 24.0;
    cp = cp * r2 + 0.5;
    c = (float)(1.0 - cp * r2);
}

__device__ __forceinline__ void p0_prologue(Frame& F) {
    const CAS Args& A = *F.a; unsigned char* ws = A.ws;
    const int gw = F.vcu * NWAVES + F.wave, NGW = F.G * NWAVES, gt = gw * 64 + F.lane, NGT = NGW * 64;
    float* rowss = (float*)(ws + WS_ROWSS);
    bf16* hbx = (bf16*)(ws + WS_HBX);
    for (int m0 = gw; m0 < T; m0 += 2 * NGW) {
        const int m1 = (m0 + NGW < T) ? m0 + NGW : m0;
        const GAS f32x4* xa = (const GAS f32x4*)(A.in[0] + (size_t)m0 * D) + F.lane; const GAS f32x4* xb = (const GAS f32x4*)(A.in[0] + (size_t)m1 * D) + F.lane;
        const f32x4 a0 = xa[0], a1 = xa[64], a2 = xa[128], a3 = xa[192], b0 = xb[0], b1 = xb[64], b2 = xb[128], b3 = xb[192];
#define XROW(m, v0, v1, v2, v3) { float s = 0.f; GAS unsigned long long* o8 = (GAS unsigned long long*)(hbx + (size_t)(m) * D) + F.lane; \
            XQ(0, v0) XQ(1, v1) XQ(2, v2) XQ(3, v3) s = wave_sum(s); if (F.lane < 16) rowss[(size_t)(m) * 16 + F.lane] = (F.lane == 0) ? s : 0.f; }
#define XQ(j, v) { const unsigned lo = pk2(v.x, v.y), hi = pk2(v.z, v.w); o8[64 * j] = (unsigned long long)lo | ((unsigned long long)hi << 32); \
            const float q0 = __builtin_bit_cast(float, lo << 16), q1 = __builtin_bit_cast(float, lo & 0xffff0000u), q2 = __builtin_bit_cast(float, hi << 16), q3 = __builtin_bit_cast(float, hi & 0xffff0000u); s += (q0 * q0 + q1 * q1) + (q2 * q2 + q3 * q3); }
        XROW(m0, a0, a1, a2, a3)
        if (m1 != m0) XROW(m1, b0, b1, b2, b3)
#undef XQ
#undef XROW
    }
    float* cs = (float*)(ws + WS_CS); const int* pos = (const int*)A.in[2];
    for (int i = gt; i < T * 8; i += NGT) { const int row = i >> 3, jj = i & 7;
        const float ang = (float)pos[row] * A.inv_freq[jj]; const double a = (double)ang;
        const double n = __builtin_rint(a * 0.15915494309189535); const double r = __builtin_fma(-n, 6.283185307179586, a) - n * 2.4492935982947064e-16;
        float s, c; sincos_red(r, s, c); cs[row * 16 + jj] = c; cs[row * 16 + 8 + jj] = s; }
}

__device__ __forceinline__ void convert_p(Frame& F, int L, bf16* pb) {
    const CAS Args& A = *F.a; const int gt = (F.vcu * NWAVES + F.wave) * 64 + F.lane, NGT = F.G * NWAVES * 64;
    const GAS f32x4* src = (const GAS f32x4*)(A.in[1] + (size_t)L * T * PLE); GAS v4u* dst = (GAS v4u*)pb;
#pragma unroll 4
    for (int i = gt; i < T * PLE / 8; i += NGT) { const f32x4 a = src[2 * i], b = src[2 * i + 1]; v4u o; o.x = pk2(a.x, a.y); o.y = pk2(a.z, a.w); o.z = pk2(b.x, b.y); o.w = pk2(b.z, b.w); dst[i] = o; }
}

__device__ __forceinline__ void scan_phase(Frame& F) {
    unsigned char* ws = F.a->ws; const float* flog = (const float*)(ws + WS_FLOG); float* ck = (float*)(ws + WS_CK);
    LAS float* wtot = (LAS float*)F.lds;
    for (int bh = blockIdx.x; bh < BATCH * NFH; bh += F.G) { const int b = bh >> 4, h = bh & 15, t0 = F.tid * 16;
        float v0, v1, v2, v3, v4, v5, v6, v7, v8, v9, v10, v11, v12, v13, v14, v15;
        const float* src = flog + ((size_t)b * SEQ + t0) * 16 + h;
        v0 = src[0]; v1 = v0 + src[16]; v2 = v1 + src[32]; v3 = v2 + src[48]; v4 = v3 + src[64]; v5 = v4 + src[80]; v6 = v5 + src[96]; v7 = v6 + src[112];
        v8 = v7 + src[128]; v9 = v8 + src[144]; v10 = v9 + src[160]; v11 = v10 + src[176]; v12 = v11 + src[192]; v13 = v12 + src[208]; v14 = v13 + src[224]; v15 = v14 + src[240];
        float incl = v15, tot = v15;
#define BSTEP(M) { const float pt = pg8::lane_xor<M>(tot); if (F.lane & M) incl += pt; tot += pt; }
        BSTEP(1) BSTEP(2) BSTEP(4) BSTEP(8) BSTEP(16)
#undef BSTEP
        { const float lowtot = __builtin_bit_cast(float, __builtin_amdgcn_readlane(__builtin_bit_cast(int, tot), 0)); if (F.lane & 32) incl += lowtot; }
        if (F.lane == 63) wtot[F.wave] = incl;
        LDS_WAIT(); __syncthreads();
        float base = incl - v15;
        for (int w = 0; w < F.wave; ++w) base += wtot[w];
        const float L2E = 1.4426950408889634f;
        f32x4* dst = (f32x4*)(ck + (size_t)bh * SEQ + t0);
        dst[0] = (f32x4){(v0 + base) * L2E, (v1 + base) * L2E, (v2 + base) * L2E, (v3 + base) * L2E};
        dst[1] = (f32x4){(v4 + base) * L2E, (v5 + base) * L2E, (v6 + base) * L2E, (v7 + base) * L2E};
        dst[2] = (f32x4){(v8 + base) * L2E, (v9 + base) * L2E, (v10 + base) * L2E, (v11 + base) * L2E};
        dst[3] = (f32x4){(v12 + base) * L2E, (v13 + base) * L2E, (v14 + base) * L2E, (v15 + base) * L2E};
        asm volatile("s_waitcnt vmcnt(0)" ::: "memory"); __syncthreads();
        if (F.tid < 32) { const int qb = F.tid, ntf = 4 * qb; const float* cb = ck + (size_t)bh * SEQ; const float cq0 = cb[qb * 256];
            int lo = 0, hi2 = ntf;
            while (lo < hi2) { const int mid = (lo + hi2) >> 1; if (cq0 - cb[64 * mid + 63] >= SKIP_LOG2) hi2 = mid; else lo = mid + 1; }
            ((int*)(ws + WS_T0))[bh * 32 + qb] = lo & ~1; }
        __syncthreads();
    }
}

__device__ __forceinline__ void combine_phase(Frame& F, int L, const bf16* O1, const bf16* O2, bf16* On) {
    const CAS Args& A = *F.a; const int gw = F.vcu * NWAVES + F.wave, NGW = F.G * NWAVES;
    const float lam_init = (L == 0) ? 0.2f : 0.35550906759096924f;
    const float* lp = A.in[5] + L * 4 * 64;
    const float s1 = wave_sum(lp[F.lane] * lp[64 + F.lane]), s2 = wave_sum(lp[128 + F.lane] * lp[192 + F.lane]);
    const float lam = expf(s1) - expf(s2) + lam_init;
    const float* gp = A.in[6] + L * 128 + 16 * (F.lane & 7);
    const f32x4 g0 = *(const f32x4*)gp, g1 = *(const f32x4*)(gp + 4), g2 = *(const f32x4*)(gp + 8), g3 = *(const f32x4*)(gp + 12);
    const float post = 1.0f - lam_init;
#define CB(k, aw, bw) o[2 * (k)] = __builtin_bit_cast(float, (aw) << 16) - lam * __builtin_bit_cast(float, (bw) << 16); o[2 * (k) + 1] = __builtin_bit_cast(float, (aw) & 0xffff0000u) - lam * __builtin_bit_cast(float, (bw) & 0xffff0000u);
#define CROW(off, a0, a1, b0, b1) { float o[16]; \
        CB(0, a0.x, b0.x) CB(1, a0.y, b0.y) CB(2, a0.z, b0.z) CB(3, a0.w, b0.w) CB(4, a1.x, b1.x) CB(5, a1.y, b1.y) CB(6, a1.z, b1.z) CB(7, a1.w, b1.w) \
        float ss = 0.f; _Pragma("unroll") for (int k = 0; k < 16; ++k) ss += o[k] * o[k]; \
        ss += pg8::lane_xor<1>(ss); ss += pg8::lane_xor<2>(ss); ss += pg8::lane_xor<4>(ss); \
        const float rs = __builtin_amdgcn_rsqf(ss * (1.0f / 128.0f) + 1e-6f) * post; v4u w0, w1; \
        w0.x = pk2(o[0] * rs * g0.x, o[1] * rs * g0.y); w0.y = pk2(o[2] * rs * g0.z, o[3] * rs * g0.w); w0.z = pk2(o[4] * rs * g1.x, o[5] * rs * g1.y); w0.w = pk2(o[6] * rs * g1.z, o[7] * rs * g1.w); \
        w1.x = pk2(o[8] * rs * g2.x, o[9] * rs * g2.y); w1.y = pk2(o[10] * rs * g2.z, o[11] * rs * g2.w); w1.z = pk2(o[12] * rs * g3.x, o[13] * rs * g3.y); w1.w = pk2(o[14] * rs * g3.z, o[15] * rs * g3.w); \
        *(GAS v4u*)(On + (off)) = w0; *(GAS v4u*)(On + (off) + 8) = w1; }
    for (int r0 = gw; r0 < T; r0 += 2 * NGW) {
        const int r1 = (r0 + NGW < T) ? r0 + NGW : r0;
        const size_t off0 = (size_t)r0 * D + 16 * F.lane, off1 = (size_t)r1 * D + 16 * F.lane;
        const v4u a0 = *(const GAS v4u*)(O1 + off0), a1 = *(const GAS v4u*)(O1 + off0 + 8), b0 = *(const GAS v4u*)(O2 + off0), b1 = *(const GAS v4u*)(O2 + off0 + 8);
        const v4u c0 = *(const GAS v4u*)(O1 + off1), c1 = *(const GAS v4u*)(O1 + off1 + 8), d0 = *(const GAS v4u*)(O2 + off1), d1 = *(const GAS v4u*)(O2 + off1 + 8);
        CROW(off0, a0, a1, b0, b1)
        if (r1 != r0) CROW(off1, c0, c1, d0, d1)
    }
#undef CROW
#undef CB
}

__device__ __forceinline__ void final_phase(Frame& F, const bf16* hb, float* out) {
    const CAS Args& A = *F.a; const int gw = F.vcu * NWAVES + F.wave, NGW = F.G * NWAVES;
    const GAS f32x4* gp = (const GAS f32x4*)A.in[20] + 4 * F.lane;
    const f32x4 g0 = gp[0], g1 = gp[1], g2 = gp[2], g3 = gp[3];
#define UB(o, k, w) o[2 * (k)] = __builtin_bit_cast(float, (w) << 16); o[2 * (k) + 1] = __builtin_bit_cast(float, (w) & 0xffff0000u);
#define FROW(off, a0, a1) { float o[16]; UB(o, 0, a0.x) UB(o, 1, a0.y) UB(o, 2, a0.z) UB(o, 3, a0.w) UB(o, 4, a1.x) UB(o, 5, a1.y) UB(o, 6, a1.z) UB(o, 7, a1.w) \
        float s = 0.f; _Pragma("unroll") for (int k = 0; k < 16; ++k) s += o[k] * o[k]; \
        const float rs = 1.0f / sqrtf(wave_sum(s) * (1.0f / D) + 1e-6f); GAS f32x4* op = (GAS f32x4*)(out + (off)); \
        op[0] = (f32x4){o[0] * rs * g0.x, o[1] * rs * g0.y, o[2] * rs * g0.z, o[3] * rs * g0.w}; op[1] = (f32x4){o[4] * rs * g1.x, o[5] * rs * g1.y, o[6] * rs * g1.z, o[7] * rs * g1.w}; \
        op[2] = (f32x4){o[8] * rs * g2.x, o[9] * rs * g2.y, o[10] * rs * g2.z, o[11] * rs * g2.w}; op[3] = (f32x4){o[12] * rs * g3.x, o[13] * rs * g3.y, o[14] * rs * g3.z, o[15] * rs * g3.w}; }
    for (int m0 = gw; m0 < T; m0 += 2 * NGW) {
        const int m1 = (m0 + NGW < T) ? m0 + NGW : m0;
        const size_t off0 = (size_t)m0 * D + 16 * F.lane, off1 = (size_t)m1 * D + 16 * F.lane;
        const v4u a0 = *(const GAS v4u*)(hb + off0), a1 = *(const GAS v4u*)(hb + off0 + 8), b0 = *(const GAS v4u*)(hb + off1), b1 = *(const GAS v4u*)(hb + off1 + 8);
        FROW(off0, a0, a1)
        if (m1 != m0) FROW(off1, b0, b1)
    }
#undef FROW
#undef UB
}

template <bool BIAS> __device__ __forceinline__ void attn_phase(Frame& F, const bf16* Q, const bf16* K, const bf16* V, bf16* O1, bf16* O2, const float* ck, unsigned* qctr, const int* t0tab) {
    using abf = attn_body::bf16;
    if constexpr (BIAS) {
        volatile LAS unsigned* uw = (volatile LAS unsigned*)(F.lds + RING_BYTES + 128);
        unsigned mine = 0u; if (threadIdx.x == 0) mine = __hip_atomic_fetch_add(qctr, 1u, __ATOMIC_RELAXED, __HIP_MEMORY_SCOPE_AGENT);
        for (;;) {
            if (threadIdx.x == 0) *uw = mine;
            __syncthreads();
            const int u = (int)__builtin_amdgcn_readfirstlane(*uw);
            if (u >= BATCH * 16 * 32) break;
            if (threadIdx.x == 0) mine = __hip_atomic_fetch_add(qctr, 1u, __ATOMIC_RELAXED, __HIP_MEMORY_SCOPE_AGENT);
            const int qb = 31 - (u >> 6), bhv = u & 63, b = bhv >> 4, h = bhv & 15;
            const float* cb = ck + (size_t)bhv * SEQ;
            const int t0 = __builtin_amdgcn_readfirstlane(t0tab[bhv * 32 + qb]);
            attn_body::attn_unit<8, true>(b, h * 64, h * 64, h * 64, h * 64, qb, (const abf*)Q, (const abf*)K, (const abf*)V, (abf*)O1, cb, (char*)F.lds, t0);
        }
    } else {
        const int nslot = BATCH * 16 * 8;
        for (int sl = F.vcu; sl < nslot; sl += F.G) { const int bhv = sl >> 3, s = sl & 7;
            for (int k = 0; k < 4; ++k) { const int qb = (k == 0) ? s : (k == 1) ? 15 - s : (k == 2) ? 16 + s : 31 - s;
                const int b = bhv >> 4, hc = bhv & 15;
                attn_body::attn_unit_dv<8>(b, hc * 64, hc * 64, (hc >> 1) * 128, (hc >> 1) * 128, qb, (const abf*)Q, (const abf*)K, (const abf*)V, (abf*)((hc & 1) ? O2 : O1), (char*)F.lds); }
        }
    }
}

#define XB_TMO      128
#define XB_XCNT(j)  (256  + 64 * (j))
#define XB_XSUB(j)  (1280 + 64 * (j))
#define XB_XGEN(j)  (2304 + 64 * (j))
#define XB_TOP      3328
#define XB_TOPGEN   3392
#define XCD_BAR_WORDS 3456
#define XB_SPIN_CAP (1u << 18)

__device__ __forceinline__ unsigned xb_ld(unsigned* p)              { return __hip_atomic_load(p, __ATOMIC_RELAXED, __HIP_MEMORY_SCOPE_AGENT); }
__device__ __forceinline__ unsigned xb_add(unsigned* p, unsigned v) { return __hip_atomic_fetch_add(p, v, __ATOMIC_RELAXED, __HIP_MEMORY_SCOPE_AGENT); }
__device__ __forceinline__ unsigned xb_xcc_id() { return (unsigned)__builtin_amdgcn_s_getreg((3 << 11) | 20) & 0xFu; }
#define XB_SPIN(cond, bar) do { unsigned _sp = 0; while (cond) { __builtin_amdgcn_s_sleep(1); \
    if ((++_sp & 255u) == 0u) { if (xb_ld(&(bar)[XB_TMO])) break; if (_sp > XB_SPIN_CAP) { atomicAdd(&(bar)[XB_TMO], 1u); break; } } } } while (0)

struct XcdBarrier {
    unsigned* bar; unsigned x;
    volatile LAS unsigned* st;
};

__device__ __forceinline__ XcdBarrier xcd_barrier_post(unsigned* bar, volatile LAS unsigned* st) {
    XcdBarrier b; b.bar = bar; b.x = xb_xcc_id(); b.st = st;
    if (threadIdx.x == 0) (void)xb_add(&bar[XB_XCNT(b.x)], 1u);
    return b;
}
__device__ __forceinline__ void xcd_barrier_complete(unsigned* bar, unsigned x, unsigned& nloc, unsigned& nx) {
    const unsigned G = gridDim.x * gridDim.y * gridDim.z;
    unsigned sum, cnt, mine, sp = 0u;
    for (;;) {
        sum = 0u; cnt = 0u; mine = 0u;
#pragma unroll
        for (unsigned j = 0; j < 16; ++j) { const unsigned c = xb_ld(&bar[XB_XCNT(j)]); sum += c; cnt += (c > 0u) ? 1u : 0u; mine = (j == x) ? c : mine; }
        if (sum == G) break;
        __builtin_amdgcn_s_sleep(1);
        if ((++sp & 255u) == 0u) { if (xb_ld(&bar[XB_TMO])) break; if (sp > XB_SPIN_CAP) { atomicAdd(&bar[XB_TMO], 1u); break; } }
    }
    nloc = mine > 0u ? mine : 1u; nx = cnt > 0u ? cnt : 1u;
}

__device__ __forceinline__ void xcd_barrier(const XcdBarrier& b) {
    asm volatile("s_waitcnt vmcnt(0)" ::: "memory");
    __syncthreads();
    if (threadIdx.x == 0) {
        unsigned* bar = b.bar;
        __builtin_amdgcn_s_waitcnt(0);
        unsigned nloc = b.st[0], nx = b.st[1];
        if (nloc == 0u) { xcd_barrier_complete(bar, b.x, nloc, nx); b.st[0] = nloc; b.st[1] = nx; }
        const unsigned old = xb_add(&bar[XB_XSUB(b.x)], 1u);
        const unsigned gen = old / nloc;
        if (old + 1u == (gen + 1u) * nloc) {
            __builtin_amdgcn_fence(__ATOMIC_RELEASE, "agent");
            asm volatile("s_waitcnt vmcnt(0)" ::: "memory");
            const unsigned og = xb_add(&bar[XB_TOP], 1u);
            const unsigned tg = og / nx;
            if (og + 1u == (tg + 1u) * nx) xb_add(&bar[XB_TOPGEN], 1u);
            else XB_SPIN(xb_ld(&bar[XB_TOPGEN]) == tg, bar);
            __builtin_amdgcn_fence(__ATOMIC_ACQUIRE, "agent");
            xb_add(&bar[XB_XGEN(b.x)], 1u);
            asm volatile("s_waitcnt vmcnt(0)" ::: "memory");
        } else {
            XB_SPIN(xb_ld(&bar[XB_XGEN(b.x)]) == gen, bar);
            __builtin_amdgcn_fence(__ATOMIC_ACQUIRE, "agent");
            asm volatile("s_waitcnt vmcnt(0)" ::: "memory");
        }
    }
    __syncthreads();
}

constexpr size_t WS_CTL = 0, CTL_ZERO_BYTES = 16384;
constexpr int LDSCTL_OFF = RING_BYTES;
__global__ void __launch_bounds__(NWAVES * 64, 2) yoco_fwd(Args args) {
    extern __shared__ __attribute__((aligned(16))) unsigned char lds[];
    cg::grid_group grid = cg::this_grid();
    using pg8::Gemm; using pg8::StaticOrder; using pg8::EpiQKV; using pg8::EpiRes; using pg8::EpiBf; using pg8::gemm_phase;
    const size_t E64 = 64 * MiB / 2;
    const int ph_lo = args.ph_lo, ph_hi = args.ph_hi;
    if (threadIdx.x < 64) ((LAS unsigned*)((LAS unsigned char*)lds + LDSCTL_OFF))[threadIdx.x] = 0u;
    __syncthreads();
    if (ph_hi - ph_lo > 1 && threadIdx.x == 0) (void)xb_add((unsigned*)(args.ws + WS_CTL) + XB_XCNT(xb_xcc_id()), 1u);
    if (ph_lo == 0) {
        const CAS Args* ap = (const CAS Args*)__builtin_amdgcn_kernarg_segment_ptr(); asm volatile("" : "+s"(ap));
        Frame F; F.a = ap; F.lds = (LAS unsigned char*)lds;
        { int t_ = threadIdx.x; asm volatile("" : "+v"(t_)); F.tid = t_; F.lane = t_ & 63; F.wave = __builtin_amdgcn_readfirstlane(t_ >> 6); }
        int bx = blockIdx.x, G_ = gridDim.x; asm volatile("" : "+s"(bx), "+s"(G_)); F.G = G_; F.vcu = (G_ % 8 == 0) ? (bx % 8) * (G_ / 8) + bx / 8 : bx;
        p0_prologue(F);
    }
    for (int ph = ph_lo; ph < ph_hi; ++ph) {
        const CAS Args* ap = (const CAS Args*)__builtin_amdgcn_kernarg_segment_ptr(); asm volatile("" : "+s"(ap));
        Frame F; F.a = ap; F.lds = (LAS unsigned char*)lds;
#define FRESH_TID() do { int t_ = threadIdx.x; asm volatile("" : "+v"(t_)); F.tid = t_; F.lane = t_ & 63; F.wave = __builtin_amdgcn_readfirstlane(t_ >> 6); } while (0)
        int bx = blockIdx.x, G_ = gridDim.x; asm volatile("" : "+s"(bx), "+s"(G_)); F.G = G_; F.vcu = (G_ % 8 == 0) ? (bx % 8) * (G_ / 8) + bx / 8 : bx;
        const int code = ap->prog[ph], kind = code & 255, L = (code >> 8) & 255, hf = (code >> 16) & 1, w2 = (code >> 17) & 1, full = (code >> 18) & 1;
        const int MH = full ? T : TH;
        unsigned char* ws = ap->ws; LAS unsigned char* ring = F.lds;
        float* rowss = (float*)(ws + WS_ROWSS); bf16* OA1 = (bf16*)ap->out; bf16* OA2 = OA1 + (size_t)T * D;
        bf16* hbX = (bf16*)(ws + WS_HBX); bf16* hbY = (bf16*)(ws + WS_HBY); bf16* R1 = (bf16*)(ws + WS_R1);
        int conv = -1;
#if PROBE_MASK
        const unsigned long long pt0 = __builtin_amdgcn_s_memrealtime();
#endif
        switch (kind) {
        case K_PRO: conv = 0; break;
        case K_QKVA: { Gemm g{hbX, (bf16*)(ws + W_QKV), T, 3 * D, D}; StaticOrder S; S.init(T, 3 * D, F.G, bx);
            EpiQKV<0> E{R1, (long long)(64 * MiB), (long long)(128 * MiB), rowss + (size_t)((3 * L) & 3) * T * 16, (const float*)(ws + WS_CS), nullptr, nullptr};
            gemm_phase<EpiQKV<0>, StaticOrder, PG8_ALIGN, PG8_SP2>(ring, g, S, E); } break;
        case K_ATTA: attn_phase<false>(F, R1, R1 + E64, R1 + 2 * E64, OA1, OA2, nullptr, nullptr, nullptr); break;
        case K_COMB: FRESH_TID(); combine_phase(F, L, OA1, OA2, R1 + 3 * E64); break;
        case K_QKVB: { const int N = (L == 2) ? 3 * D + 256 : D; Gemm g{hbX, (bf16*)(ws + W_QKV), T, N, D}; StaticOrder S; S.init(T, N, F.G, bx);
            EpiQKV<1> E{R1, (long long)((unsigned long long)OA1 - (unsigned long long)R1), (long long)((unsigned long long)OA2 - (unsigned long long)R1), rowss + (size_t)((3 * L) & 3) * T * 16, nullptr, (float*)(ws + WS_FLOG), ap->in[10]};
            gemm_phase<EpiQKV<1>, StaticOrder, PG8_ALIGN, PG8_SP2>(ring, g, S, E); } break;
        case K_SCAN: FRESH_TID(); scan_phase(F); break;
        case K_ATTB: attn_phase<true>(F, R1, OA1, OA2, R1, nullptr, (const float*)(ws + WS_CK), (unsigned*)(ws + WS_CTL) + 3584 + 64 * (L - 2), (const int*)(ws + WS_T0)); break;
        case K_RES: {
            Gemm g{w2 ? R1 : (L < 2 ? R1 + 3 * E64 : R1), (bf16*)(ws + (w2 ? W_2 : W_O)), w2 ? MH : T, D, w2 ? FF : D}; StaticOrder S; S.init(g.M, D, F.G, bx);
            EpiRes<0> E{hbX, w2 ? hbY : hbX, rowss + (size_t)((3 * L + 1 + w2) & 3) * T * 16, nullptr, nullptr, w2 ? hf * TH : 0};
            gemm_phase<EpiRes<0>, StaticOrder, PG8_ALIGN, PG8_SP2>(ring, g, S, E);
            if (!w2) { FRESH_TID(); convert_p(F, L, hbY); } } break;
        case K_W1: { { Gemm g{hbX + (size_t)hf * TH * D, (bf16*)(ws + W_1), MH, FF, D}; StaticOrder S; S.init(MH, FF, F.G, bx);
                EpiBf<1> E{R1, FF, rowss + (size_t)((3 * L + 1) & 3) * T * 16, hf * TH};
                gemm_phase<EpiBf<1>, StaticOrder, PG8_ALIGN, PG8_SP2>(ring, g, S, E); }
            if (hf == 0) { Gemm g2{hbY, (bf16*)(ws + W_PLE), T, D, PLE}; StaticOrder S2; S2.init(T, D, F.G, bx);
                EpiBf<0> E2{(bf16*)(ws + WS_PL), D, nullptr, 0};
                gemm_phase<EpiBf<0>, StaticOrder, PG8_ALIGN, PG8_SP2>(ring, g2, S2, E2); } } break;
        case K_GATE: { Gemm g{hbY, (bf16*)(ws + W_G + (size_t)(L & 1) * 2 * MiB), T, D, D}; StaticOrder S; S.init(T, D, F.G, bx);
            EpiRes<1> E{hbY, hbX, rowss + (size_t)((3 * L + 3) & 3) * T * 16, rowss + (size_t)((3 * L + 2) & 3) * T * 16, (const bf16*)(ws + WS_PL), 0};
            gemm_phase<EpiRes<1>, StaticOrder, PG8_ALIGN, PG8_SP2>(ring, g, S, E);
            if (L + 1 < DEPTH) conv = L + 1; } break;
        default: FRESH_TID(); final_phase(F, hbX, ap->out); break;
        }
        if (conv >= 0) { FRESH_TID(); convert_layer(F, conv); }
#if PROBE_MASK
        if ((PROBE_MASK >> kind) & 1) { const unsigned long long pt1 = __builtin_amdgcn_s_memrealtime(); while (__builtin_amdgcn_s_memrealtime() - pt1 < pt1 - pt0) __builtin_amdgcn_s_sleep(8); }
#endif
        if (ph + 1 < ph_hi) {
            if (ph_hi < 0) grid.sync();
            else { XcdBarrier xb; xb.bar = (unsigned*)(ap->ws + WS_CTL); xb.x = xb_xcc_id(); xb.st = (volatile LAS unsigned*)((LAS unsigned char*)lds + LDSCTL_OFF + 32); xcd_barrier(xb); }
        }
    }
}

static void build_prog(int* prog) {
    int n = 0; prog[n++] = K_PRO;
    for (int L = 0; L < DEPTH; ++L) {
        if (L < 2) { prog[n++] = K_QKVA | L << 8; prog[n++] = K_ATTA | L << 8; prog[n++] = K_COMB | L << 8; }
        else { prog[n++] = K_QKVB | L << 8; if (L == 2) prog[n++] = K_SCAN | L << 8; prog[n++] = K_ATTB | L << 8; }
        prog[n++] = K_RES | L << 8;
        prog[n++] = K_W1 | L << 8 | 1 << 18; prog[n++] = K_RES | L << 8 | 1 << 17 | 1 << 18;
        prog[n++] = K_GATE | L << 8;
    }
    prog[n++] = K_FIN;
    if (n != N_PHASES) fprintf(stderr, "build_prog: %d phases, N_PHASES %d\n", n, N_PHASES);
    while (n < N_PHASES + 1) prog[n++] = K_FIN;
}

extern "C" void kernel_launch(void* const* d_in, const int* in_sizes, int n_in, void* d_out, int out_size, void* d_ws, size_t ws_size, hipStream_t stream) {
    static int grid = 0;
    if (grid == 0) {
        if (n_in != 21 || out_size != T * D || ws_size < WS_END) { fprintf(stderr, "kernel_launch: unexpected problem (n_in %d out %d ws %zu)\n", n_in, out_size, ws_size); grid = -1; return; }
        int dev = 0, cus = 0, per_cu = 0;
        if (hipGetDevice(&dev) != hipSuccess || hipDeviceGetAttribute(&cus, hipDeviceAttributeMultiprocessorCount, dev) != hipSuccess) { grid = -1; return; }
        if (hipFuncSetAttribute((const void*)yoco_fwd, hipFuncAttributeMaxDynamicSharedMemorySize, LDS_BYTES) != hipSuccess) { fprintf(stderr, "kernel_launch: hipFuncSetAttribute failed\n"); grid = -1; return; }
        if (hipOccupancyMaxActiveBlocksPerMultiprocessor(&per_cu, (const void*)yoco_fwd, NWAVES * 64, LDS_BYTES) != hipSuccess || per_cu < 1) { fprintf(stderr, "kernel_launch: occupancy query says %d\n", per_cu); per_cu = 1; }
        (void)hipGetLastError();
        grid = cus;
    }
    if (grid < 0) return;
    Args a{};
    for (int i = 0; i < 21; ++i) a.in[i] = (const float*)d_in[i];
    a.out = (float*)d_out; a.ws = (unsigned char*)d_ws;
    for (int j = 0; j < 8; ++j) { const float p = powf(500000.0f, (float)(2 * j) / 16.0f); a.inv_freq[j] = 1.0f / p; }
    build_prog(a.prog);
#if MK_SPLIT
    for (int p = 0; p < N_PHASES; ++p) { a.ph_lo = p; a.ph_hi = p + 1; hipLaunchKernelGGL(yoco_fwd, dim3(grid), dim3(NWAVES * 64), LDS_BYTES, stream, a); }
#else
    a.ph_lo = 0; a.ph_hi = N_PHASES;
    (void)hipMemsetAsync((char*)d_ws + WS_CTL, 0, CTL_ZERO_BYTES, stream);
    void* kargs[] = {&a};
    const hipError_t e = hipLaunchCooperativeKernel((const void*)yoco_fwd, dim3(grid), dim3(NWAVES * 64), kargs, LDS_BYTES, stream);
    if (e != hipSuccess) fprintf(stderr, "kernel_launch: cooperative launch failed: %s (grid %d)\n", hipGetErrorString(e), grid);
#endif
}
```

```cpp
#include <hip/hip_runtime.h>
#include <cstdio>
#include <cstdint>
namespace pg8 {
#define PG8_LAS __attribute__((address_space(3)))
typedef unsigned short bf16_t;
typedef short bf16x8 __attribute__((ext_vector_type(8)));
typedef float f32x4 __attribute__((ext_vector_type(4)));
typedef unsigned u32x4 __attribute__((ext_vector_type(4)));
constexpr int BM = 256, BK = 64, HALF = 128, HTB = HALF * BK * 2  , STAGE_BYTES = 8 * HTB, NXCD = 8, WGM = 8;

__host__ __device__ __forceinline__ int lds_byte(int r, int c) { const int st = (r >> 4) * 2 + (c >> 5), rr = r & 15, cc = c & 31, ob = rr * 64 + cc * 2; return st * 1024 + (ob ^ (((ob >> 9) & 1) << 5)); }
__host__ __device__ __forceinline__ void stage_rc(int b, int& R, int& C) { const int st = b / 1024, sb = b % 1024, swz = sb ^ (((sb >> 9) & 1) << 5); R = (st >> 1) * 16 + swz / 64; C = (st & 1) * 32 + (swz % 64) / 2; }
__host__ __device__ __forceinline__ int perm32(int rho) { const int n = rho >> 4, i = rho & 15; return 8 * (i >> 2) + 4 * n + (i & 3); }

struct Unit { int pm, pn; };
struct Gemm { const bf16_t* A; const bf16_t* Bt; int M, N, K; };

struct StaticOrder {
    int nM, nN, nwg, G, c;
    __host__ __device__ void init(int M, int N, int G_, int c_) { nM = M / BM; nN = N / BM; nwg = nM * nN; G = G_; c = c_; }
    __host__ __device__ bool next(int i, Unit& u) const {
        const long L = (long)i * G + c; if (L >= nwg) return false;
        int wgid = (int)L; { const int q = nwg / NXCD, r = nwg % NXCD, xcd = wgid % NXCD, off = wgid / NXCD; wgid = (xcd < r ? xcd * (q + 1) : r * (q + 1) + (xcd - r) * q) + off; }
        const int nig = WGM * nN, gid = wgid / nig, fm = gid * WGM, gsz = (nM - fm) < WGM ? (nM - fm) : WGM;
        u.pm = fm + ((wgid % nig) % gsz); u.pn = (wgid % nig) / gsz; return true;
    }
    __device__ __forceinline__ void a_ready(const Unit&) const {}
    __device__ __forceinline__ void done(const Unit&) const {}
};

__device__ __forceinline__ unsigned cvt_pk_bf16(float lo, float hi) { unsigned r; asm volatile("v_cvt_pk_bf16_f32 %0, %1, %2" : "=v"(r) : "v"(lo), "v"(hi)); return r; }
typedef float f32x2 __attribute__((ext_vector_type(2)));
template <int M> __device__ __forceinline__ float lane_xor(float v) { return __builtin_bit_cast(float, __builtin_amdgcn_ds_swizzle(__builtin_bit_cast(int, v), 0x1f | (M << 10))); }
__device__ __forceinline__ float half_sum(float v) { auto rr = __builtin_amdgcn_permlane32_swap(__float_as_uint(v), __float_as_uint(v), false, false); return __uint_as_float(rr[0]) + __uint_as_float(rr[1]); }
typedef float f32x2 __attribute__((ext_vector_type(2)));
typedef unsigned u32x2 __attribute__((ext_vector_type(2)));
constexpr float QK_C2 = 0.125f * 1.4426950408889634f;
__device__ __forceinline__ float rstd_of(const float* rowss, int row) { const f32x4* p = (const f32x4*)(rowss + (size_t)row * 16); const f32x4 a = p[0], b = p[1], c = p[2], d = p[3];
    const float s = (((a[0] + a[1]) + (a[2] + a[3])) + ((b[0] + b[1]) + (b[2] + b[3]))) + (((c[0] + c[1]) + (c[2] + c[3])) + ((d[0] + d[1]) + (d[2] + d[3]))); return __builtin_amdgcn_rsqf(s * (1.0f / 1024.0f) + 1e-6f); }
__device__ __forceinline__ f32x4 rstd_pre(const float* rowss, int row, int fq) { return *(const f32x4*)(rowss + (size_t)row * 16 + 4 * fq); }
__device__ __forceinline__ float rstd_fin(const f32x4 p) { float s = (p[0] + p[1]) + (p[2] + p[3]); s += lane_xor<16>(s); s = half_sum(s); return __builtin_amdgcn_rsqf(s * (1.0f / 1024.0f) + 1e-6f); }
__device__ __forceinline__ float bf2f(unsigned short b) { return __builtin_bit_cast(float, (unsigned)b << 16); }

template <int ACT  > struct EpiBf {
    static constexpr bool PERM = true, AFTER_DRAIN = false;
    bf16_t* O; int ldc; const float* rowss; int row_off;
    __device__ __forceinline__ void operator()(const f32x4 (&acc)[2][2][4][2], const Unit& u, int wr, int wc, int fr, int fq) const {
        const int row0 = u.pm * BM + wr * 64 + fr, col0 = u.pn * BM + wc * 32 + 8 * fq;
        f32x4 rp[2][4];
        if (rowss) {
#pragma unroll
            for (int ai = 0; ai < 2; ++ai)
#pragma unroll
                for (int m = 0; m < 4; ++m) rp[ai][m] = rstd_pre(rowss, row_off + row0 + ai * HALF + m * 16, fq); }
#pragma unroll
        for (int ai = 0; ai < 2; ++ai)
#pragma unroll
            for (int m = 0; m < 4; ++m) { const int rl = row0 + ai * HALF + m * 16; const float rs = rowss ? rstd_fin(rp[ai][m]) : 1.0f; bf16_t* rowp = O + (size_t)rl * ldc + col0;
#pragma unroll
                for (int bj = 0; bj < 2; ++bj) { f32x4 v0 = acc[ai][bj][m][0] * rs, v1 = acc[ai][bj][m][1] * rs;
                    if (ACT == 1) {
#pragma unroll
                        for (int i = 0; i < 4; ++i) { const float a = __builtin_fmaxf(v0[i], 0.f), b = __builtin_fmaxf(v1[i], 0.f); v0[i] = a * a; v1[i] = b * b; } }
                    u32x4 w; w.x = cvt_pk_bf16(v0[0], v0[1]); w.y = cvt_pk_bf16(v0[2], v0[3]); w.z = cvt_pk_bf16(v1[0], v1[1]); w.w = cvt_pk_bf16(v1[2], v1[3]);
                    *(u32x4*)(rowp + bj * HALF) = w; } }
    }
};

template <int MODE> struct EpiQKV {
    static constexpr bool PERM = true, AFTER_DRAIN = false;
    bf16_t* O; long long offK, offV; const float* rowss; const float* cs; float* flog; const float* bfg;
    __device__ __forceinline__ void operator()(const f32x4 (&acc)[2][2][4][2], const Unit& u, int wr, int wc, int fr, int fq) const {
        const int colt = u.pn * BM, t = colt >> 10, cl = colt & 1023;
        const int row0 = u.pm * BM + wr * 64 + fr;
        f32x4 rp[2][4];
#pragma unroll
        for (int ai = 0; ai < 2; ++ai)
#pragma unroll
            for (int m = 0; m < 4; ++m) rp[ai][m] = rstd_pre(rowss, row0 + ai * HALF + m * 16, fq);
        float rsv[2][4];
#pragma unroll
        for (int ai = 0; ai < 2; ++ai)
#pragma unroll
            for (int m = 0; m < 4; ++m) rsv[ai][m] = rstd_fin(rp[ai][m]);
        if (MODE == 1 && t == 3) {
            if (wc == 0 && fq < 2) {
                const f32x4 b0 = *(const f32x4*)(bfg + 8 * fq), b1 = *(const f32x4*)(bfg + 8 * fq + 4);
#pragma unroll
                for (int ai = 0; ai < 2; ++ai)
#pragma unroll
                    for (int m = 0; m < 4; ++m) { const int row = row0 + ai * HALF + m * 16; const float rs = rsv[ai][m];
                        f32x4 v0 = acc[ai][0][m][0] * rs + b0, v1 = acc[ai][0][m][1] * rs + b1;
#pragma unroll
                        for (int i = 0; i < 4; ++i) { v0[i] = __builtin_fminf(v0[i], 0.f) - __logf(1.0f + __expf(-__builtin_fabsf(v0[i]))); v1[i] = __builtin_fminf(v1[i], 0.f) - __logf(1.0f + __expf(-__builtin_fabsf(v1[i])));     }
                        *(f32x4*)(flog + (size_t)row * 16 + 8 * fq) = v0; *(f32x4*)(flog + (size_t)row * 16 + 8 * fq + 4) = v1; }
            }
            return;
        }
        bf16_t* base = (bf16_t*)((char*)O + ((t == 0) ? 0ll : (t == 1) ? offK : offV)); const float sc = (t == 0) ? QK_C2 : 1.0f;
        const bool rope = (MODE == 0) && (t < 2) && !(wc & 1);
        const float sgn = (fq == 0) ? -1.0f : 1.0f;
        const int col0 = cl + wc * 32 + 8 * fq;
#pragma unroll
        for (int ai = 0; ai < 2; ++ai)
#pragma unroll
            for (int m = 0; m < 4; ++m) { const int row = row0 + ai * HALF + m * 16; const float rs = rsv[ai][m]; bf16_t* rowp = base + (size_t)row * 1024 + col0;
                f32x4 c0, c1, s0, s1;
                if (rope) { const float* cp = cs + (size_t)row * 16; c0 = *(const f32x4*)(cp); c1 = *(const f32x4*)(cp + 4); s0 = *(const f32x4*)(cp + 8) * sgn; s1 = *(const f32x4*)(cp + 12) * sgn; }
#pragma unroll
                for (int bj = 0; bj < 2; ++bj) { f32x4 v0 = acc[ai][bj][m][0] * rs, v1 = acc[ai][bj][m][1] * rs;
                    if (rope) { f32x4 p0, p1;
#pragma unroll
                        for (int i = 0; i < 4; ++i) { p0[i] = lane_xor<16>(v0[i]); p1[i] = lane_xor<16>(v1[i]); }
                        const f32x4 r0 = v0 * c0 + p0 * s0, r1 = v1 * c1 + p1 * s1;
                        if (fq < 2) { v0 = r0; v1 = r1; } }
                    v0 = v0 * sc; v1 = v1 * sc;
                    u32x4 w; w.x = cvt_pk_bf16(v0[0], v0[1]); w.y = cvt_pk_bf16(v0[2], v0[3]); w.z = cvt_pk_bf16(v1[0], v1[1]); w.w = cvt_pk_bf16(v1[2], v1[3]);
                    *(u32x4*)(rowp + bj * HALF) = w; } }
    }
};

template <int MODE> struct EpiRes {
    static constexpr bool PERM = true, AFTER_DRAIN = false;
    const bf16_t* res; bf16_t* hb; float* rowss_out; const float* rowss_in; const bf16_t* pl; int row_off;
    static __device__ __forceinline__ void unpack8(const u32x4 w, float (&f)[8]) {
        f[0] = __builtin_bit_cast(float, w.x << 16); f[1] = __builtin_bit_cast(float, w.x & 0xffff0000u); f[2] = __builtin_bit_cast(float, w.y << 16); f[3] = __builtin_bit_cast(float, w.y & 0xffff0000u);
        f[4] = __builtin_bit_cast(float, w.z << 16); f[5] = __builtin_bit_cast(float, w.z & 0xffff0000u); f[6] = __builtin_bit_cast(float, w.w << 16); f[7] = __builtin_bit_cast(float, w.w & 0xffff0000u); }
    __device__ __forceinline__ void operator()(const f32x4 (&acc)[2][2][4][2], const Unit& u, int wr, int wc, int fr, int fq) const {
        const int col0 = u.pn * BM + wc * 32 + 8 * fq, rowb = row_off + u.pm * BM + wr * 64 + fr;
#pragma unroll
        for (int am = 0; am < 4; ++am) { const int ai = am >> 1, mh = (am & 1) * 2;
            u32x4 rw[2][2], pw[2][2]; f32x4 rp[2];
#pragma unroll
            for (int mm = 0; mm < 2; ++mm) { const int rowq = rowb + ai * HALF + (mh + mm) * 16; if (MODE == 1) rp[mm] = rstd_pre(rowss_in, rowq, fq);
#pragma unroll
                for (int bj = 0; bj < 2; ++bj) { const size_t c = (size_t)rowq * 1024 + col0 + bj * HALF; rw[mm][bj] = *(const u32x4*)(res + c); if (MODE == 1) pw[mm][bj] = *(const u32x4*)(pl + c); } }
#pragma unroll
            for (int mm = 0; mm < 2; ++mm) { const int m = mh + mm; const int row = rowb + ai * HALF + m * 16; const size_t off = (size_t)row * 1024 + col0;
                float rs = 0.f; if (MODE == 1) rs = rstd_fin(rp[mm]);
                float ss = 0.f;
#pragma unroll
                for (int bj = 0; bj < 2; ++bj) { float r[8], o[8]; unpack8(rw[mm][bj], r);
                    const f32x4 a0 = acc[ai][bj][m][0], a1 = acc[ai][bj][m][1];
                    if (MODE == 1) { float p[8]; unpack8(pw[mm][bj], p);
#pragma unroll
                        for (int i = 0; i < 4; ++i) { const float g0 = __builtin_amdgcn_rcpf(1.0f + __builtin_amdgcn_exp2f(-a0[i] * rs * 1.4426950408889634f)), g1 = __builtin_amdgcn_rcpf(1.0f + __builtin_amdgcn_exp2f(-a1[i] * rs * 1.4426950408889634f));
                            o[i] = r[i] + p[i] * g0; o[4 + i] = r[4 + i] + p[4 + i] * g1; }
                    } else {
#pragma unroll
                        for (int i = 0; i < 4; ++i) { o[i] = r[i] + a0[i]; o[4 + i] = r[4 + i] + a1[i]; } }
                    u32x4 w; w.x = cvt_pk_bf16(o[0], o[1]); w.y = cvt_pk_bf16(o[2], o[3]); w.z = cvt_pk_bf16(o[4], o[5]); w.w = cvt_pk_bf16(o[6], o[7]);
                    *(u32x4*)(hb + off + bj * HALF) = w;
                    float q[8]; unpack8(w, q);
                    ss += ((q[0] * q[0] + q[1] * q[1]) + (q[2] * q[2] + q[3] * q[3])) + ((q[4] * q[4] + q[5] * q[5]) + (q[6] * q[6] + q[7] * q[7])); }
                ss += lane_xor<16>(ss); ss = half_sum(ss);
                if (fq == 0) rowss_out[(size_t)row * 16 + u.pn * 4 + wc] = ss;
            }
        }
    }
};

template <class Epi, class Sched, bool ALIGN_EPI = false, bool SP2 = false>
__device__ __forceinline__ void gemm_phase(PG8_LAS unsigned char* lds, const Gemm g, const Sched& S, const Epi& E) {
    int tid_ = threadIdx.x; asm volatile("" : "+v"(tid_));
    const int tid = tid_, wid = __builtin_amdgcn_readfirstlane(tid >> 6), lane = tid & 63, wr = wid >> 2, wc = wid & 3, fr = lane & 15, fq = lane >> 4;
    const int K = g.K, nt = K / BK;
    unsigned voffA[2], voffB[2];
#pragma unroll
    for (int i = 0; i < 2; ++i) { int R, C; stage_rc(tid * 16 + i * 8192, R, C); const int Rb = Epi::PERM ? ((R & ~31) + perm32(R & 31)) : R;
        voffA[i] = (unsigned)(R * K + C) * 2u; voffB[i] = (unsigned)(Rb * K + C) * 2u; }
    const size_t kstep = (size_t)(BK * 2);
    const size_t hstep = (size_t)HALF * K * 2;
    const size_t tstep = 2 * hstep;
    const unsigned ldsw = (unsigned)wid * 1024u;
    const int aoff = lds_byte(wr * 64 + fr, fq * 8), boff = lds_byte(wc * 32 + fr, fq * 8);
#define PG8_SA(b, h) (((b) * 2 + (h)) * HTB)
#define PG8_SB(b, h) ((4 + (b) * 2 + (h)) * HTB)
#define PG8_STAGE(bufoff, gbase, voff) do { _Pragma("unroll") for (int _i = 0; _i < 2; ++_i) \
        __builtin_amdgcn_global_load_lds((const unsigned*)((const char*)(gbase) + (voff)[_i]), (PG8_LAS unsigned*)(lds + (bufoff) + ldsw + _i * 8192), 16, 0, 0); } while (0)
#define PG8_LDA(dst, b, h) do { _Pragma("unroll") for (int m = 0; m < 4; ++m) _Pragma("unroll") for (int k = 0; k < 2; ++k) dst[m][k] = *(const PG8_LAS bf16x8*)(lds + PG8_SA(b, h) + aoff + m * 2048 + k * 1024); } while (0)
#define PG8_LDB(dst, b, h) do { _Pragma("unroll") for (int n = 0; n < 2; ++n) _Pragma("unroll") for (int k = 0; k < 2; ++k) dst[n][k] = *(const PG8_LAS bf16x8*)(lds + PG8_SB(b, h) + boff + n * 2048 + k * 1024); } while (0)
#define PG8_MMA(ai, bj, At, Bt) do { __builtin_amdgcn_s_setprio(1); _Pragma("unroll") for (int m = 0; m < 4; ++m) _Pragma("unroll") for (int n = 0; n < 2; ++n) _Pragma("unroll") for (int k = 0; k < 2; ++k) \
        acc[ai][bj][m][n] = __builtin_amdgcn_mfma_f32_16x16x32_bf16(Bt[n][k], At[m][k], acc[ai][bj][m][n], 0, 0, 0); __builtin_amdgcn_s_setprio(0); } while (0)
#define PG8_WAIT_V(n) asm volatile("s_waitcnt vmcnt(" #n ")" ::: "memory")
#define PG8_WAIT_L(n) asm volatile("s_waitcnt lgkmcnt(" #n ")" ::: "memory")
#define PG8_BAR __builtin_amdgcn_s_barrier()
#define PG8_SCHED __builtin_amdgcn_sched_barrier(0)
    Unit cur, nxt; int ui = 0;
    if (!S.next(0, cur)) return;
    f32x4 acc[2][2][4][2];
#pragma unroll
    for (int a = 0; a < 2; ++a)
#pragma unroll
        for (int b = 0; b < 2; ++b)
#pragma unroll
            for (int m = 0; m < 4; ++m)
#pragma unroll
                for (int n = 0; n < 2; ++n) acc[a][b][m][n] = (f32x4){0.f, 0.f, 0.f, 0.f};
    bf16x8 At[4][2], B0[2][2], B1[2][2];
    const char* cA = (const char*)g.A + (size_t)cur.pm * tstep; const char* cB = (const char*)g.Bt + (size_t)cur.pn * tstep;
    S.a_ready(cur);
    if constexpr (SP2) {
        PG8_STAGE(PG8_SB(0, 0), cB, voffB); PG8_STAGE(PG8_SB(0, 1), cB + hstep, voffB); PG8_STAGE(PG8_SA(0, 0), cA, voffA); PG8_STAGE(PG8_SA(0, 1), cA + hstep, voffA);
        if (wr == 1) PG8_BAR;
        PG8_WAIT_V(2); PG8_BAR;
        PG8_STAGE(PG8_SB(1, 0), cB + kstep, voffB); PG8_STAGE(PG8_SA(1, 0), cA + kstep, voffA); PG8_STAGE(PG8_SB(1, 1), cB + hstep + kstep, voffB);
        PG8_WAIT_V(6); PG8_BAR;
    } else {
        PG8_STAGE(PG8_SB(0, 0), cB, voffB); PG8_STAGE(PG8_SA(0, 0), cA, voffA); PG8_STAGE(PG8_SB(0, 1), cB + hstep, voffB); PG8_STAGE(PG8_SA(0, 1), cA + hstep, voffA);
        if (wr == 1) PG8_BAR;
        PG8_WAIT_V(4); PG8_BAR;
        PG8_STAGE(PG8_SB(1, 0), cB + kstep, voffB); PG8_STAGE(PG8_SA(1, 0), cA + kstep, voffA); PG8_STAGE(PG8_SB(1, 1), cB + hstep + kstep, voffB);
        PG8_WAIT_V(6); PG8_BAR;
    }
    for (;;) {
        const bool has_next = S.next(ui + 1, nxt);
        const char* nA = has_next ? (const char*)g.A + (size_t)nxt.pm * tstep : cA; const char* nB = has_next ? (const char*)g.Bt + (size_t)nxt.pn * tstep : cB;
        for (int t = 0; t < nt; t += 2) {
            const bool last = (t == nt - 2);
            const char* a1 = cA + (size_t)(t + 1) * kstep;
            const char* a2 = last ? nA : cA + (size_t)(t + 2) * kstep; const char* b2 = last ? nB : cB + (size_t)(t + 2) * kstep;
            const char* a3 = a2 + kstep; const char* b3 = b2 + kstep;
            if (last && has_next) S.a_ready(nxt);
            if constexpr (SP2) {
            PG8_LDB(B0, 0, 0); PG8_LDB(B1, 0, 1); PG8_SCHED; PG8_LDA(At, 0, 0); PG8_STAGE(PG8_SA(1, 1), a1 + hstep, voffA);
            PG8_WAIT_V(8); PG8_WAIT_L(0); PG8_BAR; PG8_MMA(0, 0, At, B0); PG8_MMA(0, 1, At, B1); PG8_BAR; PG8_SCHED;
            PG8_LDA(At, 0, 1); PG8_STAGE(PG8_SB(0, 0), b2, voffB); PG8_STAGE(PG8_SB(0, 1), b2 + hstep, voffB); PG8_STAGE(PG8_SA(0, 0), a2, voffA);
            PG8_WAIT_V(8); PG8_WAIT_L(0); PG8_BAR; PG8_MMA(1, 0, At, B0); PG8_MMA(1, 1, At, B1); PG8_BAR; PG8_SCHED;
            PG8_LDB(B0, 1, 0); PG8_LDB(B1, 1, 1); PG8_SCHED; PG8_LDA(At, 1, 0); PG8_STAGE(PG8_SA(0, 1), a2 + hstep, voffA);
            PG8_WAIT_V(8); PG8_WAIT_L(0); PG8_BAR; PG8_MMA(0, 0, At, B0); PG8_MMA(0, 1, At, B1); PG8_BAR; PG8_SCHED;
            PG8_LDA(At, 1, 1); PG8_STAGE(PG8_SB(1, 0), b3, voffB); PG8_STAGE(PG8_SB(1, 1), b3 + hstep, voffB); PG8_STAGE(PG8_SA(1, 0), a3, voffA);
            PG8_WAIT_V(8); PG8_WAIT_L(0); PG8_BAR; PG8_MMA(1, 0, At, B0); PG8_MMA(1, 1, At, B1); PG8_BAR; PG8_SCHED;
            } else {
            PG8_LDB(B0, 0, 0); PG8_SCHED; PG8_LDA(At, 0, 0); PG8_STAGE(PG8_SA(1, 1), a1 + hstep, voffA);
            PG8_WAIT_L(8); PG8_BAR; PG8_WAIT_L(0); PG8_MMA(0, 0, At, B0); PG8_BAR; PG8_SCHED;
            PG8_LDB(B1, 0, 1); PG8_STAGE(PG8_SB(0, 0), b2, voffB);
            PG8_BAR; PG8_WAIT_L(0); PG8_MMA(0, 1, At, B1); PG8_BAR;
            PG8_LDA(At, 0, 1); PG8_STAGE(PG8_SA(0, 0), a2, voffA);
            PG8_BAR; PG8_WAIT_L(0); PG8_MMA(1, 0, At, B0); PG8_BAR; PG8_SCHED;
            PG8_STAGE(PG8_SB(0, 1), b2 + hstep, voffB);
            PG8_WAIT_V(6); PG8_BAR; PG8_MMA(1, 1, At, B1); PG8_BAR;
            PG8_LDB(B0, 1, 0); PG8_SCHED; PG8_LDA(At, 1, 0); PG8_STAGE(PG8_SA(0, 1), a2 + hstep, voffA);
            PG8_WAIT_L(8); PG8_BAR; PG8_WAIT_L(0); PG8_MMA(0, 0, At, B0); PG8_BAR; PG8_SCHED;
            PG8_LDB(B1, 1, 1); PG8_STAGE(PG8_SB(1, 0), b3, voffB);
            PG8_BAR; PG8_WAIT_L(0); PG8_MMA(0, 1, At, B1); PG8_BAR;
            PG8_LDA(At, 1, 1); PG8_STAGE(PG8_SA(1, 0), a3, voffA);
            PG8_BAR; PG8_WAIT_L(0); PG8_MMA(1, 0, At, B0); PG8_BAR; PG8_SCHED;
            PG8_STAGE(PG8_SB(1, 1), b3 + hstep, voffB);
            PG8_WAIT_V(6); PG8_BAR; PG8_MMA(1, 1, At, B1); PG8_BAR;
            }
        }
        if constexpr (ALIGN_EPI) { if (wr == 0) PG8_BAR; }
        if constexpr (!Epi::AFTER_DRAIN) { int te_ = threadIdx.x; asm volatile("" : "+v"(te_)); const int le_ = te_ & 63, we_ = __builtin_amdgcn_readfirstlane(te_ >> 6);
            E(acc, cur, we_ >> 2, we_ & 3, le_ & 15, le_ >> 4); S.done(cur); }
        if (!has_next) break;
#pragma unroll
        for (int a = 0; a < 2; ++a)
#pragma unroll
            for (int b = 0; b < 2; ++b)
#pragma unroll
                for (int m = 0; m < 4; ++m)
#pragma unroll
                    for (int n = 0; n < 2; ++n) acc[a][b][m][n] = (f32x4){0.f, 0.f, 0.f, 0.f};
        cur = nxt; cA = nA; cB = nB; ++ui;
        if constexpr (ALIGN_EPI) { if (wr == 1) PG8_BAR; }
    }
    PG8_WAIT_V(0);
    if constexpr (!ALIGN_EPI) { if (wr == 0) PG8_BAR; }
    PG8_BAR;
    if constexpr (Epi::AFTER_DRAIN) { E.fused(acc, cur, wr, wc, fr, fq, lds, wid, lane); S.done(cur); }
#undef PG8_SA
#undef PG8_SB
#undef PG8_STAGE
#undef PG8_LDA
#undef PG8_LDB
#undef PG8_MMA
#undef PG8_WAIT_V
#undef PG8_WAIT_L
#undef PG8_BAR
#undef PG8_SCHED
}
}

#ifndef PG8_SP2
#define PG8_SP2 true
#endif
#ifndef PG8_ALIGN
#define PG8_ALIGN true
#endif
#include <hip/hip_bf16.h>
#include <cmath>
namespace attn_body {
using bf16=__hip_bfloat16;
using bf16x8=__attribute__((ext_vector_type(8)))short;
using s16x4=__attribute__((ext_vector_type(4)))short;
using f32x16=__attribute__((ext_vector_type(16)))float;
using u32x4=__attribute__((ext_vector_type(4)))unsigned;
constexpr int BATCH=4,NHEAD=16,SEQ=8192,D=64,DM=NHEAD*D;
constexpr int NW=8,QBLK=32,QB=QBLK*NW,KVBLK=64,NQB=SEQ/QB;
constexpr int ATTN_PITCH=DM, ATTN_UNIT_ROWS=QB;
__device__ __forceinline__ int crow(int r,int hi){return (r&3)+8*(r>>2)+4*hi;}
#define SBAR() __builtin_amdgcn_sched_barrier(0)
__device__ __forceinline__ void cmask(f32x16&p0,f32x16&p1,int jb,int qrel,int hi){
  const float NEG=-INFINITY; int kb=64*jb+4*hi;
  #pragma unroll
  for(int r=0;r<16;++r){int kv=kb+(r&3)+8*(r>>2); if(kv>qrel)p0[r]=NEG; if(kv+32>qrel)p1[r]=NEG;}
}

constexpr int NSLOT=3, SLOTB=8192;
constexpr int LDS_K=0, LDS_V=NSLOT*SLOTB, LDS_WS=2*NSLOT*SLOTB, LDS_OST=LDS_WS+NW*64*4, LDS_BIAS=LDS_OST+NW*4096  , LDS_BYTES=LDS_BIAS+32768;
constexpr float C2=0.125f*1.4426950408889634f;
__device__ __forceinline__ void glds16(const void*gsrc,unsigned lds_dst){unsigned keep;
  asm volatile("s_mov_b32 %0, m0\n\ts_mov_b32 m0, %2\n\ts_nop 0\n\tglobal_load_lds_dwordx4 %1, off\n\ts_mov_b32 m0, %0":"=&s"(keep):"v"(gsrc),"s"(lds_dst):"memory");}
__device__ __forceinline__ float max3f(float a,float b,float c){float r;asm("v_max3_f32 %0, %1, %2, %3":"=v"(r):"v"(a),"v"(b),"v"(c));return r;}
__device__ __forceinline__ float max2f(float a,float b){float r;asm("v_max_f32_e32 %0, %1, %2":"=v"(r):"v"(a),"v"(b));return r;}
__device__ __forceinline__ float fadd_s(float a,float b){float r;asm("v_add_f32_e32 %0, %1, %2":"=v"(r):"v"(a),"v"(b));return r;}
__device__ __forceinline__ float fsub_s(float a,float b){float r;asm("v_sub_f32_e32 %0, %1, %2":"=v"(r):"v"(a),"v"(b));return r;}
typedef float f32x2_t __attribute__((ext_vector_type(2))); typedef __bf16 bf16x2_t __attribute__((ext_vector_type(2)));
__device__ __forceinline__ unsigned cvtpk_s(float lo,float hi){f32x2_t v={lo,hi};bf16x2_t b=__builtin_convertvector(v,bf16x2_t);return __builtin_bit_cast(unsigned,b);}
#define WAIT_BAR(N) asm volatile("s_waitcnt vmcnt(" #N ") lgkmcnt(0)\n\ts_barrier":::"memory")

template<bool ACCUM> __device__ __forceinline__ void qkt(f32x16&p0,f32x16&p1,const char*Kslot,const bf16x8*qr,const f32x16&negm,int r32,int hi){
  const char*kb=Kslot+hi*1024+r32*16;
  #pragma unroll
  for(int d0=0;d0<4;++d0){
    const bf16x8 b0=*reinterpret_cast<const bf16x8*>(kb+d0*2048);
    const bf16x8 b1=*reinterpret_cast<const bf16x8*>(kb+d0*2048+512);
    if(d0==0&&!ACCUM){p0=__builtin_amdgcn_mfma_f32_32x32x16_bf16(b0,qr[0],negm,0,0,0);p1=__builtin_amdgcn_mfma_f32_32x32x16_bf16(b1,qr[0],negm,0,0,0);}
    else{p0=__builtin_amdgcn_mfma_f32_32x32x16_bf16(b0,qr[d0],p0,0,0,0);p1=__builtin_amdgcn_mfma_f32_32x32x16_bf16(b1,qr[d0],p1,0,0,0);}}
}
typedef __attribute__((address_space(3))) const char* lds_cptr;
typedef short v4i16_t __attribute__((ext_vector_type(4)));
__device__ __forceinline__ void kload8(bf16x8*kf,lds_cptr kp){
  kf[0]=*(const __attribute__((address_space(3))) bf16x8*)(kp);      kf[1]=*(const __attribute__((address_space(3))) bf16x8*)(kp+512);
  kf[2]=*(const __attribute__((address_space(3))) bf16x8*)(kp+2048); kf[3]=*(const __attribute__((address_space(3))) bf16x8*)(kp+2560);
  kf[4]=*(const __attribute__((address_space(3))) bf16x8*)(kp+4096); kf[5]=*(const __attribute__((address_space(3))) bf16x8*)(kp+4608);
  kf[6]=*(const __attribute__((address_space(3))) bf16x8*)(kp+6144); kf[7]=*(const __attribute__((address_space(3))) bf16x8*)(kp+6656);
}
__device__ __forceinline__ void kload2(bf16x8*kf,lds_cptr kp,int j){ kf[2*j]=*(const __attribute__((address_space(3))) bf16x8*)(kp+j*2048); kf[2*j+1]=*(const __attribute__((address_space(3))) bf16x8*)(kp+j*2048+512); }
__device__ __forceinline__ s16x4 vtr(lds_cptr p){ return __builtin_bit_cast(s16x4,__builtin_amdgcn_ds_read_tr16_b64_v4i16((__attribute__((address_space(3))) v4i16_t*)p)); }
__device__ __forceinline__ float rowmax(const f32x16&p0,const f32x16&p1){
  float a=max3f(p0[0],p0[1],p1[0]),b=max3f(p0[2],p0[3],p1[1]);a=max3f(a,p1[2],p1[3]);
  #pragma unroll
  for(int r=4;r<16;r+=4){a=max3f(a,p0[r],p0[r+1]);b=max3f(b,p0[r+2],p0[r+3]);a=max3f(a,p1[r],p1[r+1]);b=max3f(b,p1[r+2],p1[r+3]);}
  const float m=max2f(a,b);
  auto rr=__builtin_amdgcn_permlane32_swap(__float_as_uint(m),__float_as_uint(m),false,false);
  return max2f(__uint_as_float(rr[0]),__uint_as_float(rr[1]));
}
__device__ __forceinline__ void pv(f32x16*o,int vb,bf16x8 pa0,bf16x8 pa1,bf16x8 pa2,bf16x8 pa3){
  #pragma unroll
  for(int d0=0;d0<2;++d0){s16x4 lo[4],hi[4];
    #pragma unroll
    for(int ks=0;ks<4;++ks){
      asm volatile("ds_read_b64_tr_b16 %0,%1 offset:%c2":"=&v"(lo[ks]):"v"(vb),"i"(d0*4096+ks*1024):"memory");
      asm volatile("ds_read_b64_tr_b16 %0,%1 offset:%c2":"=&v"(hi[ks]):"v"(vb),"i"(d0*4096+ks*1024+512):"memory");}
    asm volatile("s_waitcnt lgkmcnt(0)":::"memory");SBAR();
    #define PK(k) (bf16x8){lo[k][0],lo[k][1],lo[k][2],lo[k][3],hi[k][0],hi[k][1],hi[k][2],hi[k][3]}
    o[d0]=__builtin_amdgcn_mfma_f32_32x32x16_bf16(pa0,PK(0),o[d0],0,0,0);
    o[d0]=__builtin_amdgcn_mfma_f32_32x32x16_bf16(pa1,PK(1),o[d0],0,0,0);
    o[d0]=__builtin_amdgcn_mfma_f32_32x32x16_bf16(pa2,PK(2),o[d0],0,0,0);
    o[d0]=__builtin_amdgcn_mfma_f32_32x32x16_bf16(pa3,PK(3),o[d0],0,0,0);
    #undef PK
  }
}

#ifndef ATTN_STORE16
#define ATTN_STORE16(p,v) (*(u32x4*)(p)=(v))
#endif
typedef float f32x4b __attribute__((ext_vector_type(4)));
__device__ __forceinline__ void binit(f32x16&c0,f32x16&c1,lds_cptr bp,float nm){
  #pragma unroll
  for(int g=0;g<4;++g){ const f32x4b a=*(const __attribute__((address_space(3))) f32x4b*)(bp+g*32); const f32x4b bb=*(const __attribute__((address_space(3))) f32x4b*)(bp+128+g*32);
    #pragma unroll
    for(int i=0;i<4;++i){ c0[4*g+i]=nm-a[i]; c1[4*g+i]=nm-bb[i]; } }
}
__device__ __forceinline__ void bload(f32x16&c0,f32x16&c1,lds_cptr bp){
  #pragma unroll
  for(int g=0;g<4;++g){ const f32x4b a=*(const __attribute__((address_space(3))) f32x4b*)(bp+g*32); const f32x4b bb=*(const __attribute__((address_space(3))) f32x4b*)(bp+128+g*32);
    #pragma unroll
    for(int i=0;i<4;++i){ c0[4*g+i]=a[i]; c1[4*g+i]=bb[i]; } }
}
__device__ __forceinline__ void bfin(f32x16&c0,f32x16&c1,float nm){
  #pragma unroll
  for(int r=0;r<16;++r){ c0[r]=nm-c0[r]; c1[r]=nm-c1[r]; }
}
template<int THRL,bool BIAS> __device__ __forceinline__ void attn_unit(int b,int cq,int ck,int cv,int co,int qb,const bf16*Q,const bf16*__restrict__ K,const bf16*__restrict__ V,bf16*O,const float*cb,char*shm,int t0){
  int tid_=threadIdx.x; asm volatile("":"+v"(tid_)); const int tid=tid_,lane=tid&63,r32=lane&31,hi=lane>>5; const int wid=__builtin_amdgcn_readfirstlane(tid>>6);
  const long rowbase=(long)b*SEQ; const int q0=qb*QB;
  const bf16*Qw=Q+(rowbase+q0+wid*QBLK)*DM+cq;
  const bf16*Kh=K+(rowbase+(long)t0*KVBLK)*DM+ck,*Vh=V+(rowbase+(long)t0*KVBLK)*DM+cv;
  const unsigned lds0=(unsigned)(uintptr_t)shm;
  float*wsf=(float*)(shm+LDS_WS)+wid*64;
  const bf16*ksrc=Kh+(long)lane*DM+wid*8;
  const bf16*vsrc=Vh+(long)(16*(wid&3)+(lane>>2))*DM+(wid>>2)*32+(lane&3)*8;
  const unsigned kdst=lds0+LDS_K+wid*1024, vdst=lds0+LDS_V+wid*1024;
  #define DMA_K(t,slot) glds16(ksrc+(long)(t)*KVBLK*DM,(unsigned)__builtin_amdgcn_readfirstlane(kdst+(slot)))
  #define DMA_V(t,slot) glds16(vsrc+(long)(t)*KVBLK*DM,(unsigned)__builtin_amdgcn_readfirstlane(vdst+(slot)))
  const int vb0=(int)(lds0+LDS_V)+((lane>>4)&1)*32+(lane&3)*8+(4*hi+((lane&15)>>2))*64;
  const char*Kbase=shm+LDS_K; bf16x8 kf[8];
  const lds_cptr shm3=(lds_cptr)shm; const lds_cptr kp0=shm3+LDS_K+hi*1024+r32*16; const lds_cptr vp0=shm3+LDS_V+((lane>>4)&1)*32+(lane&3)*8+(4*hi+((lane&15)>>2))*64;
  const int NT=(q0+QB)/KVBLK-t0;
  float cqv=0.f,nm=0.f; const lds_cptr bp0=shm3+LDS_BIAS+hi*16+t0*256;
  if constexpr(BIAS){ for(int p=(t0>>2)+wid;p<=qb;p+=NW) glds16(cb+p*256+lane*4,(unsigned)__builtin_amdgcn_readfirstlane(lds0+LDS_BIAS+p*1024));
    cqv=cb[q0+wid*QBLK+r32]; }
  DMA_K(0,0);DMA_V(0,0);DMA_K(1,SLOTB);
  bf16x8 qr[4];
  #pragma unroll
  for(int d0=0;d0<4;++d0)qr[d0]=*reinterpret_cast<const bf16x8*>(&Qw[(long)r32*DM+d0*16+hi*8]);
  float mhat=0.f,l_reg=0.f;f32x16 o[2];o[0]=f32x16{};o[1]=f32x16{};f32x16 negm=f32x16{};if constexpr(!BIAS)asm volatile("":"+v"(negm));
  const int qrel=wid*QBLK+r32;
  #define CMASK(P0,P1,t) do{int jb_=(t)-(NT-4); if(jb_>=0)cmask(P0,P1,jb_,qrel,hi);}while(0)
  bool resc=false;
  #define START(P0,P1) do{ const float rm=rowmax(P0,P1); resc=false; \
    { const float dl=BIAS?__builtin_fmaxf(rm,0.f):rm; mhat=fadd_s(mhat,dl); \
      _Pragma("unroll") for(int r=0;r<16;++r){P0[r]=fsub_s(P0[r],dl);P1[r]=fsub_s(P1[r],dl);} \
      if constexpr(BIAS){ nm=cqv-mhat; } else { _Pragma("unroll") for(int r=0;r<16;++r)negm[r]=-mhat; asm volatile("":"+v"(negm)); } } \
    _Pragma("unroll") for(int r=0;r<16;++r)P0[r]=__builtin_amdgcn_exp2f(P0[r]); }while(0)
  #define RESC() do{ if(resc){ asm volatile("s_waitcnt lgkmcnt(0)":::"memory"); \
      _Pragma("unroll") for(int d_=0;d_<2;++d_) _Pragma("unroll") for(int r=0;r<16;++r)o[d_][r]*=wsf[crow(r,hi)]; } }while(0)
  f32x16 pA0,pA1,pB0,pB1;
  int sl_prev=0,sl_cur=0,sl_next=SLOTB;
  #define ROT() do{sl_prev=sl_cur;sl_cur=sl_next;sl_next=(sl_next==(NSLOT-1)*SLOTB)?0:sl_next+SLOTB;}while(0)
  DMA_K(2,2*SLOTB);
  WAIT_BAR(3);
  if constexpr(BIAS){ nm=cqv; binit(pA0,pA1,bp0,nm); qkt<true>(pA0,pA1,Kbase,qr,negm,r32,hi); } else { qkt<false>(pA0,pA1,Kbase,qr,negm,r32,hi); } asm volatile("s_nop 15\n\ts_nop 7":"+v"(pA0),"+v"(pA1));CMASK(pA0,pA1,0);
  START(pA0,pA1);
  _Pragma("unroll") for(int r=0;r<16;++r)pA1[r]=__builtin_amdgcn_exp2f(pA1[r]);
  if constexpr(BIAS){ binit(pB0,pB1,bp0+256,nm); }
  WAIT_BAR(0);
  DMA_K(3,0);DMA_V(1,SLOTB);
  ROT();
  kload8(kf,kp0+sl_cur);
  WAIT_BAR(2);
  s16x4 vlo[8],vhi[8]; u32x4 pw0,pw1,pw2,pw3;
  #define PKW(P,B) cvtpk_s(P[B],P[B+1])
  #define PAF(k) __builtin_bit_cast(bf16x8,pw##k)
  #define VFR(i) (bf16x8){vlo[i][0],vlo[i][1],vlo[i][2],vlo[i][3],vhi[i][0],vhi[i][1],vhi[i][2],vhi[i][3]}
  #define PIN(x) asm volatile("":"+v"(x))
  #define MX3(a,b,c) __builtin_fmaxf(__builtin_fmaxf((a),(b)),(c))
  #define GAPA(MF,A0,A1,A2,A3,W0,W1,PW) do{ MF; sacc+=A0; sacc+=A1; sacc+=A2; sacc+=A3; PIN(sacc); W0; W1; PIN(PW); SBAR(); }while(0)
  #define EX(v) __builtin_amdgcn_exp2f(v)
  #define GAPB(MF,X,B) do{ MF; X[B]=EX(X[B]); X[B+1]=EX(X[B+1]); X[B+2]=EX(X[B+2]); X[B+3]=EX(X[B+3]); PIN(X); SBAR(); }while(0)
  #define VRD(i) do{ vlo[i]=vtr(vp_+(((i)>>2)*4096+((i)&3)*1024)); vhi[i]=vtr(vp_+(((i)>>2)*4096+((i)&3)*1024+512)); }while(0)
  #define KRD(G,j) do{ if(G){ kload2(kf,kp0+sl_next,j); SBAR(); } }while(0)
  #define STEP(C0,C1,P0,P1,t,GK,GV,GL) do{ SBAR(); \
    const lds_cptr vp_=vp0+sl_prev; \
    VRD(0); SBAR(); float sacc=(P0[0]+P0[1]); \
    GAPA(C0=__builtin_amdgcn_mfma_f32_32x32x16_bf16(kf[0],qr[0],BIAS?C0:negm,0,0,0), P0[2],P0[3],P0[4],P0[5],     pw0[0]=PKW(P0,0), pw0[1]=PKW(P0,2), pw0); \
    VRD(4); SBAR(); GAPA(C1=__builtin_amdgcn_mfma_f32_32x32x16_bf16(kf[1],qr[0],BIAS?C1:negm,0,0,0), P0[6],P0[7],P0[8],P0[9],     pw0[2]=PKW(P0,4), pw0[3]=PKW(P0,6), pw0); \
    VRD(1); SBAR(); GAPA(C0=__builtin_amdgcn_mfma_f32_32x32x16_bf16(kf[2],qr[1],C0,0,0,0),   P0[10],P0[11],P0[12],P0[13], pw1[0]=PKW(P0,8), pw1[1]=PKW(P0,10), pw1); \
    VRD(5); SBAR(); GAPA(C1=__builtin_amdgcn_mfma_f32_32x32x16_bf16(kf[3],qr[1],C1,0,0,0),   P0[14],P0[15],P1[0],P1[1],   pw1[2]=PKW(P0,12),pw1[3]=PKW(P0,14), pw1); \
    VRD(2); SBAR(); GAPA(C0=__builtin_amdgcn_mfma_f32_32x32x16_bf16(kf[4],qr[2],C0,0,0,0),   P1[2],P1[3],P1[4],P1[5],     pw2[0]=PKW(P1,0), pw2[1]=PKW(P1,2), pw2); \
    VRD(6); SBAR(); GAPA(C1=__builtin_amdgcn_mfma_f32_32x32x16_bf16(kf[5],qr[2],C1,0,0,0),   P1[6],P1[7],P1[8],P1[9],     pw2[2]=PKW(P1,4), pw2[3]=PKW(P1,6), pw2); \
    VRD(3); SBAR(); GAPA(C0=__builtin_amdgcn_mfma_f32_32x32x16_bf16(kf[6],qr[3],C0,0,0,0),   P1[10],P1[11],P1[12],P1[13], pw3[0]=PKW(P1,8), pw3[1]=PKW(P1,10), pw3); \
    VRD(7); SBAR(); GAPA(C1=__builtin_amdgcn_mfma_f32_32x32x16_bf16(kf[7],qr[3],C1,0,0,0),   P1[14],P1[15],0.f,0.f,       pw3[2]=PKW(P1,12),pw3[3]=PKW(P1,14), pw3); \
    l_reg+=sacc; \
    if(GK){DMA_K((t)+3,sl_cur);} if(GV){DMA_V((t)+1,sl_next);} \
    CMASK(C0,C1,t); \
    { float a=MX3(C0[0],C0[1],C1[0]),b=MX3(C0[2],C0[3],C1[1]); a=MX3(a,C1[2],C1[3]); \
      _Pragma("unroll") for(int r=4;r<16;r+=4){a=MX3(a,C0[r],C0[r+1]);b=MX3(b,C0[r+2],C0[r+3]);a=MX3(a,C1[r],C1[r+1]);b=MX3(b,C1[r+2],C1[r+3]);} \
      float rm=__builtin_fmaxf(a,b); { auto rr=__builtin_amdgcn_permlane32_swap(__float_as_uint(rm),__float_as_uint(rm),false,false); rm=__builtin_fmaxf(__uint_as_float(rr[0]),__uint_as_float(rr[1])); } \
      resc=false; \
      if(__builtin_expect(__any(rm>(float)THRL),0)){ const float dl=__builtin_fmaxf(rm,0.f); mhat+=dl; \
        _Pragma("unroll") for(int r=0;r<16;++r){C0[r]-=dl;C1[r]-=dl;} \
        if constexpr(BIAS){ nm=cqv-mhat; } else { _Pragma("unroll") for(int r=0;r<16;++r)negm[r]=-mhat; asm volatile("":"+v"(negm)); } \
        const float f=__builtin_amdgcn_exp2f(-dl); l_reg*=f; if(hi==0)wsf[r32]=f; resc=true; } } \
    SBAR(); \
    if constexpr(BIAS){ if(GL){ bload(P0,P1,bp0+((t)+1)*256); SBAR(); } } \
    GAPB(o[0]=__builtin_amdgcn_mfma_f32_32x32x16_bf16(PAF(0),VFR(0),o[0],0,0,0), C0,0); \
    GAPB(o[1]=__builtin_amdgcn_mfma_f32_32x32x16_bf16(PAF(0),VFR(4),o[1],0,0,0), C0,4); \
    KRD(GL,0); GAPB(o[0]=__builtin_amdgcn_mfma_f32_32x32x16_bf16(PAF(1),VFR(1),o[0],0,0,0), C0,8); \
    KRD(GL,1); GAPB(o[1]=__builtin_amdgcn_mfma_f32_32x32x16_bf16(PAF(1),VFR(5),o[1],0,0,0), C0,12); \
    KRD(GL,2); GAPB(o[0]=__builtin_amdgcn_mfma_f32_32x32x16_bf16(PAF(2),VFR(2),o[0],0,0,0), C1,0); \
    KRD(GL,3); GAPB(o[1]=__builtin_amdgcn_mfma_f32_32x32x16_bf16(PAF(2),VFR(6),o[1],0,0,0), C1,4); \
    GAPB(o[0]=__builtin_amdgcn_mfma_f32_32x32x16_bf16(PAF(3),VFR(3),o[0],0,0,0), C1,8); \
    GAPB(o[1]=__builtin_amdgcn_mfma_f32_32x32x16_bf16(PAF(3),VFR(7),o[1],0,0,0), C1,12); \
    if constexpr(BIAS){ if(GL){ bfin(P0,P1,nm); SBAR(); } } \
    }while(0)
  int t=1;
  #undef CMASK
  #define CMASK(P0,P1,t) do{}while(0)
  for(;t+5<NT;t+=2){
    STEP(pB0,pB1,pA0,pA1,t,true,true,true);     WAIT_BAR(2); RESC(); ROT();
    STEP(pA0,pA1,pB0,pB1,t+1,true,true,true);   WAIT_BAR(2); RESC(); ROT();
  }
  #undef CMASK
  #define CMASK(P0,P1,t) do{int jb_=(t)-(NT-4); if(jb_>=0)cmask(P0,P1,jb_,qrel,hi);}while(0)
  #define ENDW(tt) do{ if((tt)+3<NT){WAIT_BAR(2);} else if((tt)+2<NT){WAIT_BAR(1);} else {WAIT_BAR(0);} }while(0)
  for(;t+1<NT;t+=2){
    STEP(pB0,pB1,pA0,pA1,t,(t+3<NT),(t+1<NT),(t+1<NT));       ENDW(t);   RESC(); ROT();
    STEP(pA0,pA1,pB0,pB1,t+1,(t+4<NT),(t+2<NT),(t+2<NT));     ENDW(t+1); RESC(); ROT();
  }
  STEP(pB0,pB1,pA0,pA1,NT-1,false,false,false); RESC();
  { float sacc=pB0[0]+pB0[1]; _Pragma("unroll") for(int r=2;r<16;++r)sacc+=pB0[r]; _Pragma("unroll") for(int r=0;r<16;++r)sacc+=pB1[r]; l_reg+=sacc;
    pw0=(u32x4){PKW(pB0,0),PKW(pB0,2),PKW(pB0,4),PKW(pB0,6)};pw1=(u32x4){PKW(pB0,8),PKW(pB0,10),PKW(pB0,12),PKW(pB0,14)};pw2=(u32x4){PKW(pB1,0),PKW(pB1,2),PKW(pB1,4),PKW(pB1,6)};pw3=(u32x4){PKW(pB1,8),PKW(pB1,10),PKW(pB1,12),PKW(pB1,14)};
    SBAR(); pv(o,vb0+sl_cur,PAF(0),PAF(1),PAF(2),PAF(3)); }
  #undef PKW
  #undef PAF
  #undef VFR
  #undef PIN
  #undef MX3
  #undef GAPA
  #undef GAPB
  #undef EX
  #undef VRD
  #undef KRD
  #undef STEP
  #undef ENDW
  {auto rr=__builtin_amdgcn_permlane32_swap(__float_as_uint(l_reg),__float_as_uint(l_reg),false,false);l_reg=__uint_as_float(rr[0])+__uint_as_float(rr[1]);}
  if(hi==0)wsf[32+r32]=l_reg;asm volatile("s_waitcnt lgkmcnt(0)":::"memory");
  float rli[16];
  #pragma unroll
  for(int r=0;r<16;++r)rli[r]=__builtin_amdgcn_rcpf(wsf[32+crow(r,hi)]);
  bf16*Ow=O+(rowbase+q0+wid*QBLK)*DM+co;
  { bf16*stg=(bf16*)(shm+LDS_OST)+wid*2048;
    #pragma unroll
    for(int r=0;r<16;++r){const int orow=crow(r,hi);
      #pragma unroll
      for(int d0=0;d0<2;++d0)stg[orow*64+d0*32+r32]=__float2bfloat16(o[d0][r]*rli[r]);}
    asm volatile("s_waitcnt lgkmcnt(0)":::"memory");
    #pragma unroll
    for(int i=0;i<4;++i){const int row=i*8+(lane>>3),ch=lane&7; const u32x4 v=*(const u32x4*)(stg+row*64+ch*8); ATTN_STORE16(Ow+(long)row*DM+ch*8,v);} }
  asm volatile("s_waitcnt lgkmcnt(0)\n\ts_barrier":::"memory");
  #undef DMA_K
  #undef DMA_V
  #undef CMASK
  #undef START
  #undef RESC
  #undef ROT
}
constexpr int DV_LDS_V=NSLOT*SLOTB, DV_LDS_WS=DV_LDS_V+NSLOT*2*SLOTB, DV_LDS_OST=DV_LDS_WS+NW*64*4, DV_LDS_BYTES=DV_LDS_OST+NW*4096;
static_assert(DV_LDS_BYTES<=LDS_BYTES,"dv variant fits the attention LDS budget");
template<int THRL> __device__ __forceinline__ void attn_unit_dv(int b,int cq,int ck,int cv,int co,int qb,const bf16*Q,const bf16*__restrict__ K,const bf16*__restrict__ V,bf16*O,char*shm){
  constexpr bool BIAS=false; constexpr int LDS_V=DV_LDS_V, LDS_WS=DV_LDS_WS, LDS_OST=DV_LDS_OST;
  int tid_=threadIdx.x; asm volatile("":"+v"(tid_)); const int tid=tid_,lane=tid&63,r32=lane&31,hi=lane>>5; const int wid=__builtin_amdgcn_readfirstlane(tid>>6);
  const long rowbase=(long)b*SEQ; const int q0=qb*QB;
  const bf16*Qw=Q+(rowbase+q0+wid*QBLK)*DM+cq;
  const bf16*Kh=K+rowbase*DM+ck,*Vh=V+rowbase*DM+cv;
  const unsigned lds0=(unsigned)(uintptr_t)shm;
  float*wsf=(float*)(shm+LDS_WS)+wid*64;
  const bf16*ksrc=Kh+(long)lane*DM+wid*8;
  const bf16*vsrc=Vh+(long)(16*(wid&3)+(lane>>2))*DM+(wid>>2)*32+(lane&3)*8;
  const unsigned kdst=lds0+LDS_K+wid*1024, vdst=lds0+LDS_V+wid*1024;
  #define DMA_K(t,slot) glds16(ksrc+(long)(t)*KVBLK*DM,(unsigned)__builtin_amdgcn_readfirstlane(kdst+(slot)))
  #define DMA_V(t,slot) do{ glds16(vsrc+(long)(t)*KVBLK*DM,(unsigned)__builtin_amdgcn_readfirstlane(vdst+2*(slot))); glds16(vsrc+(long)(t)*KVBLK*DM+64,(unsigned)__builtin_amdgcn_readfirstlane(vdst+2*(slot)+8192)); }while(0)
  const int vb0=(int)(lds0+LDS_V)+((lane>>4)&1)*32+(lane&3)*8+(4*hi+((lane&15)>>2))*64;
  const char*Kbase=shm+LDS_K; bf16x8 kf[8];
  const lds_cptr shm3=(lds_cptr)shm; const lds_cptr kp0=shm3+LDS_K+hi*1024+r32*16; const lds_cptr vp0=shm3+LDS_V+((lane>>4)&1)*32+(lane&3)*8+(4*hi+((lane&15)>>2))*64;
  const int NT=(q0+QB)/KVBLK;
  DMA_K(0,0);DMA_V(0,0);DMA_K(1,SLOTB);
  bf16x8 qr[4];
  #pragma unroll
  for(int d0=0;d0<4;++d0)qr[d0]=*reinterpret_cast<const bf16x8*>(&Qw[(long)r32*DM+d0*16+hi*8]);
  float mhat=0.f,l_reg=0.f;f32x16 o[4];o[0]=f32x16{};o[1]=f32x16{};o[2]=f32x16{};o[3]=f32x16{};const f32x16 negm=f32x16{};
  const int qrel=wid*QBLK+r32;
  #define CMASK(P0,P1,t) do{int jb_=(t)-(NT-4); if(jb_>=0)cmask(P0,P1,jb_,qrel,hi);}while(0)
  bool resc=false;
  #define START(P0,P1) do{ const float rm=rowmax(P0,P1); resc=false; \
    { const float dl=BIAS?__builtin_fmaxf(rm,0.f):rm; mhat=fadd_s(mhat,dl); \
      _Pragma("unroll") for(int r=0;r<16;++r){P0[r]=fsub_s(P0[r],dl);P1[r]=fsub_s(P1[r],dl);} \
      } \
    _Pragma("unroll") for(int r=0;r<16;++r)P0[r]=__builtin_amdgcn_exp2f(P0[r]); }while(0)
  #define RESC() do{ if(resc){ asm volatile("s_waitcnt lgkmcnt(0)":::"memory"); \
      _Pragma("unroll") for(int d_=0;d_<4;++d_) _Pragma("unroll") for(int r=0;r<16;++r)o[d_][r]*=wsf[crow(r,hi)]; } }while(0)
  f32x16 pA0,pA1,pB0,pB1;
  int sl_prev=0,sl_cur=0,sl_next=SLOTB;
  #define ROT() do{sl_prev=sl_cur;sl_cur=sl_next;sl_next=(sl_next==(NSLOT-1)*SLOTB)?0:sl_next+SLOTB;}while(0)
  DMA_K(2,2*SLOTB);
  WAIT_BAR(4);
  qkt<false>(pA0,pA1,Kbase,qr,negm,r32,hi); asm volatile("s_nop 15\n\ts_nop 7":"+v"(pA0),"+v"(pA1));CMASK(pA0,pA1,0);
  START(pA0,pA1);
  _Pragma("unroll") for(int r=0;r<16;++r)pA1[r]=__builtin_amdgcn_exp2f(pA1[r]);
  WAIT_BAR(0);
  DMA_K(3,0);DMA_V(1,SLOTB);
  ROT();
  kload8(kf,kp0+sl_cur);
  WAIT_BAR(3);
  s16x4 vlo[8],vhi[8]; u32x4 pw0,pw1,pw2,pw3;
  #define PKW(P,B) cvtpk_s(P[B],P[B+1])
  #define PAF(k) __builtin_bit_cast(bf16x8,pw##k)
  #define VFR(i) (bf16x8){vlo[i][0],vlo[i][1],vlo[i][2],vlo[i][3],vhi[i][0],vhi[i][1],vhi[i][2],vhi[i][3]}
  #define PIN(x) asm volatile("":"+v"(x))
  #define MX3(a,b,c) __builtin_fmaxf(__builtin_fmaxf((a),(b)),(c))
  #define GAPA(MF,A0,A1,A2,A3,W0,W1,PW) do{ MF; sacc+=A0; sacc+=A1; sacc+=A2; sacc+=A3; PIN(sacc); W0; W1; PIN(PW); SBAR(); }while(0)
  #define EX(v) __builtin_amdgcn_exp2f(v)
  #define GAPB(MF,X,B) do{ MF; X[B]=EX(X[B]); X[B+1]=EX(X[B+1]); X[B+2]=EX(X[B+2]); X[B+3]=EX(X[B+3]); PIN(X); SBAR(); }while(0)
  #define VRD(i) do{ vlo[i]=vtr(vp_+(((i)>>2)*4096+((i)&3)*1024)); vhi[i]=vtr(vp_+(((i)>>2)*4096+((i)&3)*1024+512)); }while(0)
  #define VRD2(i) do{ vlo[i]=vtr(vp_+(8192+((i)>>2)*4096+((i)&3)*1024)); vhi[i]=vtr(vp_+(8192+((i)>>2)*4096+((i)&3)*1024+512)); }while(0)
  #define GAPB2(MF,X,B) do{ MF; X[B]=EX(X[B]-mhat); X[B+1]=EX(X[B+1]-mhat); PIN(X); SBAR(); }while(0)
  #define KRD(G,j) do{ if(G){ kload2(kf,kp0+sl_next,j); SBAR(); } }while(0)
  #define STEP(C0,C1,P0,P1,t,GK,GV,GL) do{ SBAR(); \
    const lds_cptr vp_=vp0+2*sl_prev; \
    VRD(0); SBAR(); float sacc=(P0[0]+P0[1]); \
    GAPA(C0=__builtin_amdgcn_mfma_f32_32x32x16_bf16(kf[0],qr[0],negm,0,0,0), P0[2],P0[3],P0[4],P0[5],     pw0[0]=PKW(P0,0), pw0[1]=PKW(P0,2), pw0); \
    VRD(4); SBAR(); GAPA(C1=__builtin_amdgcn_mfma_f32_32x32x16_bf16(kf[1],qr[0],negm,0,0,0), P0[6],P0[7],P0[8],P0[9],     pw0[2]=PKW(P0,4), pw0[3]=PKW(P0,6), pw0); \
    VRD(1); SBAR(); GAPA(C0=__builtin_amdgcn_mfma_f32_32x32x16_bf16(kf[2],qr[1],C0,0,0,0),   P0[10],P0[11],P0[12],P0[13], pw1[0]=PKW(P0,8), pw1[1]=PKW(P0,10), pw1); \
    VRD(5); SBAR(); GAPA(C1=__builtin_amdgcn_mfma_f32_32x32x16_bf16(kf[3],qr[1],C1,0,0,0),   P0[14],P0[15],P1[0],P1[1],   pw1[2]=PKW(P0,12),pw1[3]=PKW(P0,14), pw1); \
    VRD(2); SBAR(); GAPA(C0=__builtin_amdgcn_mfma_f32_32x32x16_bf16(kf[4],qr[2],C0,0,0,0),   P1[2],P1[3],P1[4],P1[5],     pw2[0]=PKW(P1,0), pw2[1]=PKW(P1,2), pw2); \
    VRD(6); SBAR(); GAPA(C1=__builtin_amdgcn_mfma_f32_32x32x16_bf16(kf[5],qr[2],C1,0,0,0),   P1[6],P1[7],P1[8],P1[9],     pw2[2]=PKW(P1,4), pw2[3]=PKW(P1,6), pw2); \
    VRD(3); SBAR(); GAPA(C0=__builtin_amdgcn_mfma_f32_32x32x16_bf16(kf[6],qr[3],C0,0,0,0),   P1[10],P1[11],P1[12],P1[13], pw3[0]=PKW(P1,8), pw3[1]=PKW(P1,10), pw3); \
    VRD(7); SBAR(); GAPA(C1=__builtin_amdgcn_mfma_f32_32x32x16_bf16(kf[7],qr[3],C1,0,0,0),   P1[14],P1[15],0.f,0.f,       pw3[2]=PKW(P1,12),pw3[3]=PKW(P1,14), pw3); \
    l_reg+=sacc; \
    if(GK){DMA_K((t)+3,sl_cur);} if(GV){DMA_V((t)+1,sl_next);} \
    CMASK(C0,C1,t); \
    { float a=MX3(C0[0],C0[1],C1[0]),b=MX3(C0[2],C0[3],C1[1]); a=MX3(a,C1[2],C1[3]); \
      _Pragma("unroll") for(int r=4;r<16;r+=4){a=MX3(a,C0[r],C0[r+1]);b=MX3(b,C0[r+2],C0[r+3]);a=MX3(a,C1[r],C1[r+1]);b=MX3(b,C1[r+2],C1[r+3]);} \
      float rm=__builtin_fmaxf(a,b); { auto rr=__builtin_amdgcn_permlane32_swap(__float_as_uint(rm),__float_as_uint(rm),false,false); rm=__builtin_fmaxf(__uint_as_float(rr[0]),__uint_as_float(rr[1])); } \
      resc=false; \
      rm-=mhat; \
      if(__builtin_expect(__any(rm>(float)THRL),0)){ const float dl=__builtin_fmaxf(rm,0.f); mhat+=dl; \
        const float f=__builtin_amdgcn_exp2f(-dl); l_reg*=f; if(hi==0)wsf[r32]=f; resc=true; } } \
    SBAR(); \
    GAPB2(o[0]=__builtin_amdgcn_mfma_f32_32x32x16_bf16(PAF(0),VFR(0),o[0],0,0,0), C0,0);  VRD2(0); SBAR(); \
    GAPB2(o[1]=__builtin_amdgcn_mfma_f32_32x32x16_bf16(PAF(0),VFR(4),o[1],0,0,0), C0,2);  VRD2(4); SBAR(); \
    KRD(GL,0); GAPB2(o[0]=__builtin_amdgcn_mfma_f32_32x32x16_bf16(PAF(1),VFR(1),o[0],0,0,0), C0,4);  VRD2(1); SBAR(); \
    KRD(GL,1); GAPB2(o[1]=__builtin_amdgcn_mfma_f32_32x32x16_bf16(PAF(1),VFR(5),o[1],0,0,0), C0,6);  VRD2(5); SBAR(); \
    KRD(GL,2); GAPB2(o[0]=__builtin_amdgcn_mfma_f32_32x32x16_bf16(PAF(2),VFR(2),o[0],0,0,0), C0,8);  VRD2(2); SBAR(); \
    KRD(GL,3); GAPB2(o[1]=__builtin_amdgcn_mfma_f32_32x32x16_bf16(PAF(2),VFR(6),o[1],0,0,0), C0,10); VRD2(6); SBAR(); \
    GAPB2(o[0]=__builtin_amdgcn_mfma_f32_32x32x16_bf16(PAF(3),VFR(3),o[0],0,0,0), C0,12); VRD2(3); SBAR(); \
    GAPB2(o[1]=__builtin_amdgcn_mfma_f32_32x32x16_bf16(PAF(3),VFR(7),o[1],0,0,0), C0,14); VRD2(7); SBAR(); \
    GAPB2(o[2]=__builtin_amdgcn_mfma_f32_32x32x16_bf16(PAF(0),VFR(0),o[2],0,0,0), C1,0); \
    GAPB2(o[3]=__builtin_amdgcn_mfma_f32_32x32x16_bf16(PAF(0),VFR(4),o[3],0,0,0), C1,2); \
    GAPB2(o[2]=__builtin_amdgcn_mfma_f32_32x32x16_bf16(PAF(1),VFR(1),o[2],0,0,0), C1,4); \
    GAPB2(o[3]=__builtin_amdgcn_mfma_f32_32x32x16_bf16(PAF(1),VFR(5),o[3],0,0,0), C1,6); \
    GAPB2(o[2]=__builtin_amdgcn_mfma_f32_32x32x16_bf16(PAF(2),VFR(2),o[2],0,0,0), C1,8); \
    GAPB2(o[3]=__builtin_amdgcn_mfma_f32_32x32x16_bf16(PAF(2),VFR(6),o[3],0,0,0), C1,10); \
    GAPB2(o[2]=__builtin_amdgcn_mfma_f32_32x32x16_bf16(PAF(3),VFR(3),o[2],0,0,0), C1,12); \
    GAPB2(o[3]=__builtin_amdgcn_mfma_f32_32x32x16_bf16(PAF(3),VFR(7),o[3],0,0,0), C1,14); \
    }while(0)
  int t=1;
  #undef CMASK
  #define CMASK(P0,P1,t) do{}while(0)
  for(;t+5<NT;t+=2){
    STEP(pB0,pB1,pA0,pA1,t,true,true,true);     WAIT_BAR(3); RESC(); ROT();
    STEP(pA0,pA1,pB0,pB1,t+1,true,true,true);   WAIT_BAR(3); RESC(); ROT();
  }
  #undef CMASK
  #define CMASK(P0,P1,t) do{int jb_=(t)-(NT-4); if(jb_>=0)cmask(P0,P1,jb_,qrel,hi);}while(0)
  #define ENDW(tt) do{ if((tt)+3<NT){WAIT_BAR(3);} else if((tt)+2<NT){WAIT_BAR(2);} else {WAIT_BAR(0);} }while(0)
  for(;t+1<NT;t+=2){
    STEP(pB0,pB1,pA0,pA1,t,(t+3<NT),(t+1<NT),(t+1<NT));       ENDW(t);   RESC(); ROT();
    STEP(pA0,pA1,pB0,pB1,t+1,(t+4<NT),(t+2<NT),(t+2<NT));     ENDW(t+1); RESC(); ROT();
  }
  STEP(pB0,pB1,pA0,pA1,NT-1,false,false,false); RESC();
  { float sacc=pB0[0]+pB0[1]; _Pragma("unroll") for(int r=2;r<16;++r)sacc+=pB0[r]; _Pragma("unroll") for(int r=0;r<16;++r)sacc+=pB1[r]; l_reg+=sacc;
    pw0=(u32x4){PKW(pB0,0),PKW(pB0,2),PKW(pB0,4),PKW(pB0,6)};pw1=(u32x4){PKW(pB0,8),PKW(pB0,10),PKW(pB0,12),PKW(pB0,14)};pw2=(u32x4){PKW(pB1,0),PKW(pB1,2),PKW(pB1,4),PKW(pB1,6)};pw3=(u32x4){PKW(pB1,8),PKW(pB1,10),PKW(pB1,12),PKW(pB1,14)};
    SBAR(); pv(o,vb0+2*sl_cur,PAF(0),PAF(1),PAF(2),PAF(3)); pv(o+2,vb0+2*sl_cur+8192,PAF(0),PAF(1),PAF(2),PAF(3)); }
  #undef PKW
  #undef PAF
  #undef VFR
  #undef PIN
  #undef MX3
  #undef GAPA
  #undef GAPB
  #undef EX
  #undef VRD
  #undef VRD2
  #undef GAPB2
  #undef KRD
  #undef STEP
  #undef ENDW
  {auto rr=__builtin_amdgcn_permlane32_swap(__float_as_uint(l_reg),__float_as_uint(l_reg),false,false);l_reg=__uint_as_float(rr[0])+__uint_as_float(rr[1]);}
  if(hi==0)wsf[32+r32]=l_reg;asm volatile("s_waitcnt lgkmcnt(0)":::"memory");
  float rli[16];
  #pragma unroll
  for(int r=0;r<16;++r)rli[r]=__builtin_amdgcn_rcpf(wsf[32+crow(r,hi)]);
  bf16*Ow=O+(rowbase+q0+wid*QBLK)*DM+co;
  { bf16*stg=(bf16*)(shm+LDS_OST)+wid*2048;
    #pragma unroll
    for(int ps=0;ps<2;++ps){
      #pragma unroll
      for(int r=0;r<16;++r){const int orow=crow(r,hi);
        #pragma unroll
        for(int d0=0;d0<2;++d0)stg[orow*64+d0*32+r32]=__float2bfloat16(o[2*ps+d0][r]*rli[r]);}
      asm volatile("s_waitcnt lgkmcnt(0)":::"memory");
      #pragma unroll
      for(int i=0;i<4;++i){const int row=i*8+(lane>>3),ch=lane&7; const u32x4 v=*(const u32x4*)(stg+row*64+ch*8); ATTN_STORE16(Ow+(long)row*DM+ps*64+ch*8,v);}
      asm volatile("s_waitcnt lgkmcnt(0)":::"memory"); } }
  asm volatile("s_waitcnt lgkmcnt(0)\n\ts_barrier":::"memory");
  #undef DMA_K
  #undef DMA_V
  #undef CMASK
  #undef START
  #undef RESC
  #undef ROT
}
constexpr int ATTN_LDS_BYTES=LDS_BYTES;
#undef SBAR
#undef WAIT_BAR
}
#include <hip/hip_cooperative_groups.h>
namespace cg = cooperative_groups;
#ifndef PROBE_MASK
#define PROBE_MASK 0
#endif
#ifndef MK_SPLIT
#define MK_SPLIT 0
#endif
constexpr int NWAVES = 8;
constexpr int BATCH = 4, SEQ = 8192, T = BATCH * SEQ, D = 1024, FF = 4096, PLE = 256, DEPTH = 4, NFH = 16;
constexpr int TH = T / 2;
constexpr size_t MiB = 1u << 20;
constexpr size_t WS_ROWSS = 8 * MiB;
constexpr size_t WS_T0 = 1 * MiB;
constexpr float SKIP_LOG2 = -160.0f;
constexpr size_t WS_CS = 2 * MiB;
constexpr size_t WS_FLOG = 4 * MiB;
constexpr size_t WS_CK = 6 * MiB;
constexpr size_t W_QKV = 16 * MiB;
constexpr size_t W_O = 23 * MiB;
constexpr size_t W_1 = 25 * MiB;
constexpr size_t W_2 = 33 * MiB;
constexpr size_t W_PLE = 41 * MiB;
constexpr size_t W_G = 42 * MiB;
constexpr size_t WS_HBX = 48 * MiB, WS_HBY = 112 * MiB, WS_R1 = 176 * MiB, WS_PL = 432 * MiB, WS_END = 496 * MiB;
constexpr int RING_BYTES = 131072, LDS_BYTES = 147456;
static_assert(attn_body::ATTN_LDS_BYTES <= RING_BYTES, "attention LDS");

#define GAS __attribute__((address_space(1)))
#define LAS __attribute__((address_space(3)))
typedef unsigned short bf16;
typedef unsigned v4u __attribute__((ext_vector_type(4)));
typedef float f32x4 __attribute__((ext_vector_type(4)));
#define LDS_WAIT() asm volatile("s_waitcnt lgkmcnt(0)" ::: "memory")
__device__ __forceinline__ unsigned f2bf(float f) { unsigned u = __builtin_bit_cast(unsigned, f); return (u + 0x7fffu + ((u >> 16) & 1u)) >> 16; }
__device__ __forceinline__ unsigned pk2(float lo, float hi) { return f2bf(lo) | (f2bf(hi) << 16); }
__device__ __forceinline__ float wave_sum(float v) {
    v += pg8::lane_xor<1>(v); v += pg8::lane_xor<2>(v); v += pg8::lane_xor<4>(v); v += pg8::lane_xor<8>(v); v += pg8::lane_xor<16>(v);
    return pg8::half_sum(v);
}

constexpr int N_PHASES = 1 + 7 + 7 + 7 + 6 + 1;
enum { K_PRO = 0, K_QKVA, K_ATTA, K_COMB, K_QKVB, K_SCAN, K_ATTB, K_RES, K_W1, K_GATE, K_FIN };
struct Args { const float* in[21]; float* out; unsigned char* ws; float inv_freq[8]; int ph_lo, ph_hi; int prog[N_PHASES + 1]; };

#define CAS __attribute__((address_space(4)))
struct Frame { LAS unsigned char* lds; int tid, lane, wave, vcu, G; const CAS Args* a; };

__device__ __forceinline__ void transpose_item(const float* W, int ldw, int coff, int ncols, int K, const float* gain, bf16* WT, int row_off, LAS float* scr, int item, int nblk, int lane) {
    const int kb = item / nblk, nb = item % nblk, k0 = 64 * kb, n0 = 32 * nb;
#pragma unroll
    for (int i = 0; i < 8; ++i) { const int kk = 8 * i + (lane >> 3), n4 = (lane & 7) * 4, n = n0 + n4;
        f32x4 v = (n < ncols) ? *(const GAS f32x4*)(W + (size_t)(k0 + kk) * ldw + coff + n) : (f32x4){0.f, 0.f, 0.f, 0.f};
        if (gain) v = v * gain[k0 + kk];
        LAS float* d = scr + kk * 33 + n4; d[0] = v.x; d[1] = v.y; d[2] = v.z; d[3] = v.w; }
    LDS_WAIT(); asm volatile("" ::: "memory");
    const int c = lane & 7;
#pragma unroll
    for (int j = 0; j < 4; ++j) { const int n = (lane >> 3) + 8 * j; const LAS float* s = scr + (8 * c) * 33 + n;
        v4u o; o.x = pk2(s[0 * 33], s[1 * 33]); o.y = pk2(s[2 * 33], s[3 * 33]); o.z = pk2(s[4 * 33], s[5 * 33]); o.w = pk2(s[6 * 33], s[7 * 33]);
        *(GAS v4u*)(WT + (size_t)(row_off + n0 + n) * K + k0 + 8 * c) = o; }
    LDS_WAIT(); asm volatile("" ::: "memory");
}

__device__ __forceinline__ void convert_layer(Frame& F, int L) {
    const CAS Args& A = *F.a; unsigned char* ws = A.ws;
    LAS float* scr = (LAS float*)(F.lds + F.wave * 16384);
    const int gw = F.vcu * NWAVES + F.wave, NGW = F.G * NWAVES;
    bf16* Wqkv = (bf16*)(ws + W_QKV); bf16* Wo = (bf16*)(ws + W_O); bf16* W1 = (bf16*)(ws + W_1); bf16* W2 = (bf16*)(ws + W_2); bf16* Wp = (bf16*)(ws + W_PLE); bf16* Wg = (bf16*)(ws + W_G + (size_t)(L & 1) * 2 * MiB);
    const bool isA = L < 2; const int j = L - 2;
    const int I_QKV = isA ? 16 * 96 : 16 * 32, I_KV = (!isA && j == 0) ? 16 * 64 : 0, I_F = (!isA && j == 0) ? 16 : 0, I_O = 16 * 32, I_1 = 16 * 128, I_2 = 64 * 32, I_G = 16 * 32, I_P = 4 * 32;
    const int NIT = I_QKV + I_KV + I_F + I_O + I_1 + I_2 + I_G + I_P;
    for (int it = gw; it < NIT; it += NGW) {
        int r = it;
        if (r < I_QKV) { if (isA) transpose_item(A.in[4] + (size_t)L * D * 3 * D, 3 * D, 0, 3 * D, D, A.in[3] + L * D, Wqkv, 0, scr, r, 96, F.lane);
                         else transpose_item(A.in[12] + (size_t)j * D * D, D, 0, D, D, A.in[11] + j * D, Wqkv, 0, scr, r, 32, F.lane); continue; } r -= I_QKV;
        if (r < I_KV) { transpose_item(A.in[9], 2 * D + NFH, 0, 2 * D, D, A.in[8], Wqkv, D, scr, r, 64, F.lane); continue; } r -= I_KV;
        if (r < I_F) { transpose_item(A.in[9], 2 * D + NFH, 2 * D, NFH, D, A.in[8], Wqkv, 3 * D, scr, r, 1, F.lane); continue; } r -= I_F;
        if (r < I_O) { transpose_item(isA ? A.in[7] + (size_t)L * D * D : A.in[13] + (size_t)j * D * D, D, 0, D, D, nullptr, Wo, 0, scr, r, 32, F.lane); continue; } r -= I_O;
        if (r < I_1) { transpose_item(A.in[15] + (size_t)L * D * FF, FF, 0, FF, D, A.in[14] + L * D, W1, 0, scr, r, 128, F.lane); continue; } r -= I_1;
        if (r < I_2) { transpose_item(A.in[16] + (size_t)L * FF * D, D, 0, D, FF, nullptr, W2, 0, scr, r, 32, F.lane); continue; } r -= I_2;
        if (r < I_G) { transpose_item(A.in[18] + (size_t)L * D * D, D, 0, D, D, A.in[17] + L * D, Wg, 0, scr, r, 32, F.lane); continue; } r -= I_G;
        transpose_item(A.in[19] + (size_t)L * PLE * D, D, 0, D, PLE, nullptr, Wp, 0, scr, r, 32, F.lane);
    }
}

__device__ __forceinline__ void sincos_red(double r, float& s, float& c) {
    const double r2 = r * r;
    double sp = -1.0 / 51090942171709440000.0;
    sp = sp * r2 + 1.0 / 121645100408832000.0;
    sp = sp * r2 - 1.0 / 355687428096000.0;
    sp = sp * r2 + 1.0 / 1307674368000.0;
    sp = sp * r2 - 1.0 / 6227020800.0;
    sp = sp * r2 + 1.0 / 39916800.0;
    sp = sp * r2 - 1.0 / 362880.0;
    sp = sp * r2 + 1.0 / 5040.0;
    sp = sp * r2 - 1.0 / 120.0;
    sp = sp * r2 + 1.0 / 6.0;
    sp = sp * r2 - 1.0;
    s = (float)(-(sp * r));
    double cp = 1.0 / 1124000727777607680000.0;
    cp = cp * r2 - 1.0 / 2432902008176640000.0;
    cp = cp * r2 + 1.0 / 6402373705728000.0;
    cp = cp * r2 - 1.0 / 20922789888000.0;
    cp = cp * r2 + 1.0 / 87178291200.0;
    cp = cp * r2 - 1.0 / 479001600.0;
    cp = cp * r2 + 1.0 / 3628800.0;
    cp = cp * r2 - 1.0 / 40320.0;
    cp = cp * r2 + 1.0 / 720.0;
    cp = cp * r2 - 1.0 / 24.0;
    cp = cp * r2 + 0.5;
    c = (float)(1.0 - cp * r2);
}

__device__ __forceinline__ void p0_prologue(Frame& F) {
    const CAS Args& A = *F.a; unsigned char* ws = A.ws;
    const int gw = F.vcu * NWAVES + F.wave, NGW = F.G * NWAVES, gt = gw * 64 + F.lane, NGT = NGW * 64;
    float* rowss = (float*)(ws + WS_ROWSS);
    bf16* hbx = (bf16*)(ws + WS_HBX);
    for (int m0 = gw; m0 < T; m0 += 2 * NGW) {
        const int m1 = (m0 + NGW < T) ? m0 + NGW : m0;
        const GAS f32x4* xa = (const GAS f32x4*)(A.in[0] + (size_t)m0 * D) + F.lane; const GAS f32x4* xb = (const GAS f32x4*)(A.in[0] + (size_t)m1 * D) + F.lane;
        const f32x4 a0 = xa[0], a1 = xa[64], a2 = xa[128], a3 = xa[192], b0 = xb[0], b1 = xb[64], b2 = xb[128], b3 = xb[192];
#define XROW(m, v0, v1, v2, v3) { float s = 0.f; GAS unsigned long long* o8 = (GAS unsigned long long*)(hbx + (size_t)(m) * D) + F.lane; \
            XQ(0, v0) XQ(1, v1) XQ(2, v2) XQ(3, v3) s = wave_sum(s); if (F.lane < 16) rowss[(size_t)(m) * 16 + F.lane] = (F.lane == 0) ? s : 0.f; }
#define XQ(j, v) { const unsigned lo = pk2(v.x, v.y), hi = pk2(v.z, v.w); o8[64 * j] = (unsigned long long)lo | ((unsigned long long)hi << 32); \
            const float q0 = __builtin_bit_cast(float, lo << 16), q1 = __builtin_bit_cast(float, lo & 0xffff0000u), q2 = __builtin_bit_cast(float, hi << 16), q3 = __builtin_bit_cast(float, hi & 0xffff0000u); s += (q0 * q0 + q1 * q1) + (q2 * q2 + q3 * q3); }
        XROW(m0, a0, a1, a2, a3)
        if (m1 != m0) XROW(m1, b0, b1, b2, b3)
#undef XQ
#undef XROW
    }
    float* cs = (float*)(ws + WS_CS); const int* pos = (const int*)A.in[2];
    for (int i = gt; i < T * 8; i += NGT) { const int row = i >> 3, jj = i & 7;
        const float ang = (float)pos[row] * A.inv_freq[jj]; const double a = (double)ang;
        const double n = __builtin_rint(a * 0.15915494309189535); const double r = __builtin_fma(-n, 6.283185307179586, a) - n * 2.4492935982947064e-16;
        float s, c; sincos_red(r, s, c); cs[row * 16 + jj] = c; cs[row * 16 + 8 + jj] = s; }
}

__device__ __forceinline__ void convert_p(Frame& F, int L, bf16* pb) {
    const CAS Args& A = *F.a; const int gt = (F.vcu * NWAVES + F.wave) * 64 + F.lane, NGT = F.G * NWAVES * 64;
    const GAS f32x4* src = (const GAS f32x4*)(A.in[1] + (size_t)L * T * PLE); GAS v4u* dst = (GAS v4u*)pb;
#pragma unroll 4
    for (int i = gt; i < T * PLE / 8; i += NGT) { const f32x4 a = src[2 * i], b = src[2 * i + 1]; v4u o; o.x = pk2(a.x, a.y); o.y = pk2(a.z, a.w); o.z = pk2(b.x, b.y); o.w = pk2(b.z, b.w); dst[i] = o; }
}

__device__ __forceinline__ void scan_phase(Frame& F) {
    unsigned char* ws = F.a->ws; const float* flog = (const float*)(ws + WS_FLOG); float* ck = (float*)(ws + WS_CK);
    LAS float* wtot = (LAS float*)F.lds;
    for (int bh = blockIdx.x; bh < BATCH * NFH; bh += F.G) { const int b = bh >> 4, h = bh & 15, t0 = F.tid * 16;
        float v0, v1, v2, v3, v4, v5, v6, v7, v8, v9, v10, v11, v12, v13, v14, v15;
        const float* src = flog + ((size_t)b * SEQ + t0) * 16 + h;
        v0 = src[0]; v1 = v0 + src[16]; v2 = v1 + src[32]; v3 = v2 + src[48]; v4 = v3 + src[64]; v5 = v4 + src[80]; v6 = v5 + src[96]; v7 = v6 + src[112];
        v8 = v7 + src[128]; v9 = v8 + src[144]; v10 = v9 + src[160]; v11 = v10 + src[176]; v12 = v11 + src[192]; v13 = v12 + src[208]; v14 = v13 + src[224]; v15 = v14 + src[240];
        float incl = v15, tot = v15;
#define BSTEP(M) { const float pt = pg8::lane_xor<M>(tot); if (F.lane & M) incl += pt; tot += pt; }
        BSTEP(1) BSTEP(2) BSTEP(4) BSTEP(8) BSTEP(16)
#undef BSTEP
        { const float lowtot = __builtin_bit_cast(float, __builtin_amdgcn_readlane(__builtin_bit_cast(int, tot), 0)); if (F.lane & 32) incl += lowtot; }
        if (F.lane == 63) wtot[F.wave] = incl;
        LDS_WAIT(); __syncthreads();
        float base = incl - v15;
        for (int w = 0; w < F.wave; ++w) base += wtot[w];
        const float L2E = 1.4426950408889634f;
        f32x4* dst = (f32x4*)(ck + (size_t)bh * SEQ + t0);
        dst[0] = (f32x4){(v0 + base) * L2E, (v1 + base) * L2E, (v2 + base) * L2E, (v3 + base) * L2E};
        dst[1] = (f32x4){(v4 + base) * L2E, (v5 + base) * L2E, (v6 + base) * L2E, (v7 + base) * L2E};
        dst[2] = (f32x4){(v8 + base) * L2E, (v9 + base) * L2E, (v10 + base) * L2E, (v11 + base) * L2E};
        dst[3] = (f32x4){(v12 + base) * L2E, (v13 + base) * L2E, (v14 + base) * L2E, (v15 + base) * L2E};
        asm volatile("s_waitcnt vmcnt(0)" ::: "memory"); __syncthreads();
        if (F.tid < 32) { const int qb = F.tid, ntf = 4 * qb; const float* cb = ck + (size_t)bh * SEQ; const float cq0 = cb[qb * 256];
            int lo = 0, hi2 = ntf;
            while (lo < hi2) { const int mid = (lo + hi2) >> 1; if (cq0 - cb[64 * mid + 63] >= SKIP_LOG2) hi2 = mid; else lo = mid + 1; }
            ((int*)(ws + WS_T0))[bh * 32 + qb] = lo & ~1; }
        __syncthreads();
    }
}

__device__ __forceinline__ void combine_phase(Frame& F, int L, const bf16* O1, const bf16* O2, bf16* On) {
    const CAS Args& A = *F.a; const int gw = F.vcu * NWAVES + F.wave, NGW = F.G * NWAVES;
    const float lam_init = (L == 0) ? 0.2f : 0.35550906759096924f;
    const float* lp = A.in[5] + L * 4 * 64;
    const float s1 = wave_sum(lp[F.lane] * lp[64 + F.lane]), s2 = wave_sum(lp[128 + F.lane] * lp[192 + F.lane]);
    const float lam = expf(s1) - expf(s2) + lam_init;
    const float* gp = A.in[6] + L * 128 + 16 * (F.lane & 7);
    const f32x4 g0 = *(const f32x4*)gp, g1 = *(const f32x4*)(gp + 4), g2 = *(const f32x4*)(gp + 8), g3 = *(const f32x4*)(gp + 12);
    const float post = 1.0f - lam_init;
#define CB(k, aw, bw) o[2 * (k)] = __builtin_bit_cast(float, (aw) << 16) - lam * __builtin_bit_cast(float, (bw) << 16); o[2 * (k) + 1] = __builtin_bit_cast(float, (aw) & 0xffff0000u) - lam * __builtin_bit_cast(float, (bw) & 0xffff0000u);
#define CROW(off, a0, a1, b0, b1) { float o[16]; \
        CB(0, a0.x, b0.x) CB(1, a0.y, b0.y) CB(2, a0.z, b0.z) CB(3, a0.w, b0.w) CB(4, a1.x, b1.x) CB(5, a1.y, b1.y) CB(6, a1.z, b1.z) CB(7, a1.w, b1.w) \
        float ss = 0.f; _Pragma("unroll") for (int k = 0; k < 16; ++k) ss += o[k] * o[k]; \
        ss += pg8::lane_xor<1>(ss); ss += pg8::lane_xor<2>(ss); ss += pg8::lane_xor<4>(ss); \
        const float rs = __builtin_amdgcn_rsqf(ss * (1.0f / 128.0f) + 1e-6f) * post; v4u w0, w1; \
        w0.x = pk2(o[0] * rs * g0.x, o[1] * rs * g0.y); w0.y = pk2(o[2] * rs * g0.z, o[3] * rs * g0.w); w0.z = pk2(o[4] * rs * g1.x, o[5] * rs * g1.y); w0.w = pk2(o[6] * rs * g1.z, o[7] * rs * g1.w); \
        w1.x = pk2(o[8] * rs * g2.x, o[9] * rs * g2.y); w1.y = pk2(o[10] * rs * g2.z, o[11] * rs * g2.w); w1.z = pk2(o[12] * rs * g3.x, o[13] * rs * g3.y); w1.w = pk2(o[14] * rs * g3.z, o[15] * rs * g3.w); \
        *(GAS v4u*)(On + (off)) = w0; *(GAS v4u*)(On + (off) + 8) = w1; }
    for (int r0 = gw; r0 < T; r0 += 2 * NGW) {
        const int r1 = (r0 + NGW < T) ? r0 + NGW : r0;
        const size_t off0 = (size_t)r0 * D + 16 * F.lane, off1 = (size_t)r1 * D + 16 * F.lane;
        const v4u a0 = *(const GAS v4u*)(O1 + off0), a1 = *(const GAS v4u*)(O1 + off0 + 8), b0 = *(const GAS v4u*)(O2 + off0), b1 = *(const GAS v4u*)(O2 + off0 + 8);
        const v4u c0 = *(const GAS v4u*)(O1 + off1), c1 = *(const GAS v4u*)(O1 + off1 + 8), d0 = *(const GAS v4u*)(O2 + off1), d1 = *(const GAS v4u*)(O2 + off1 + 8);
        CROW(off0, a0, a1, b0, b1)
        if (r1 != r0) CROW(off1, c0, c1, d0, d1)
    }
#undef CROW
#undef CB
}

__device__ __forceinline__ void final_phase(Frame& F, const bf16* hb, float* out) {
    const CAS Args& A = *F.a; const int gw = F.vcu * NWAVES + F.wave, NGW = F.G * NWAVES;
    const GAS f32x4* gp = (const GAS f32x4*)A.in[20] + 4 * F.lane;
    const f32x4 g0 = gp[0], g1 = gp[1], g2 = gp[2], g3 = gp[3];
#define UB(o, k, w) o[2 * (k)] = __builtin_bit_cast(float, (w) << 16); o[2 * (k) + 1] = __builtin_bit_cast(float, (w) & 0xffff0000u);
#define FROW(off, a0, a1) { float o[16]; UB(o, 0, a0.x) UB(o, 1, a0.y) UB(o, 2, a0.z) UB(o, 3, a0.w) UB(o, 4, a1.x) UB(o, 5, a1.y) UB(o, 6, a1.z) UB(o, 7, a1.w) \
        float s = 0.f; _Pragma("unroll") for (int k = 0; k < 16; ++k) s += o[k] * o[k]; \
        const float rs = 1.0f / sqrtf(wave_sum(s) * (1.0f / D) + 1e-6f); GAS f32x4* op = (GAS f32x4*)(out + (off)); \
        op[0] = (f32x4){o[0] * rs * g0.x, o[1] * rs * g0.y, o[2] * rs * g0.z, o[3] * rs * g0.w}; op[1] = (f32x4){o[4] * rs * g1.x, o[5] * rs * g1.y, o[6] * rs * g1.z, o[7] * rs * g1.w}; \
        op[2] = (f32x4){o[8] * rs * g2.x, o[9] * rs * g2.y, o[10] * rs * g2.z, o[11] * rs * g2.w}; op[3] = (f32x4){o[12] * rs * g3.x, o[13] * rs * g3.y, o[14] * rs * g3.z, o[15] * rs * g3.w}; }
    for (int m0 = gw; m0 < T; m0 += 2 * NGW) {
        const int m1 = (m0 + NGW < T) ? m0 + NGW : m0;
        const size_t off0 = (size_t)m0 * D + 16 * F.lane, off1 = (size_t)m1 * D + 16 * F.lane;
        const v4u a0 = *(const GAS v4u*)(hb + off0), a1 = *(const GAS v4u*)(hb + off0 + 8), b0 = *(const GAS v4u*)(hb + off1), b1 = *(const GAS v4u*)(hb + off1 + 8);
        FROW(off0, a0, a1)
        if (m1 != m0) FROW(off1, b0, b1)
    }
#undef FROW
#undef UB
}

template <bool BIAS> __device__ __forceinline__ void attn_phase(Frame& F, const bf16* Q, const bf16* K, const bf16* V, bf16* O1, bf16* O2, const float* ck, unsigned* qctr, const int* t0tab) {
    using abf = attn_body::bf16;
    if constexpr (BIAS) {
        volatile LAS unsigned* uw = (volatile LAS unsigned*)(F.lds + RING_BYTES + 128);
        unsigned mine = 0u; if (threadIdx.x == 0) mine = __hip_atomic_fetch_add(qctr, 1u, __ATOMIC_RELAXED, __HIP_MEMORY_SCOPE_AGENT);
        for (;;) {
            if (threadIdx.x == 0) *uw = mine;
            __syncthreads();
            const int u = (int)__builtin_amdgcn_readfirstlane(*uw);
            if (u >= BATCH * 16 * 32) break;
            if (threadIdx.x == 0) mine = __hip_atomic_fetch_add(qctr, 1u, __ATOMIC_RELAXED, __HIP_MEMORY_SCOPE_AGENT);
            const int qb = 31 - (u >> 6), bhv = u & 63, b = bhv >> 4, h = bhv & 15;
            const float* cb = ck + (size_t)bhv * SEQ;
            const int t0 = __builtin_amdgcn_readfirstlane(t0tab[bhv * 32 + qb]);
            attn_body::attn_unit<8, true>(b, h * 64, h * 64, h * 64, h * 64, qb, (const abf*)Q, (const abf*)K, (const abf*)V, (abf*)O1, cb, (char*)F.lds, t0);
        }
    } else {
        const int nslot = BATCH * 16 * 8;
        for (int sl = F.vcu; sl < nslot; sl += F.G) { const int bhv = sl >> 3, s = sl & 7;
            for (int k = 0; k < 4; ++k) { const int qb = (k == 0) ? s : (k == 1) ? 15 - s : (k == 2) ? 16 + s : 31 - s;
                const int b = bhv >> 4, hc = bhv & 15;
                attn_body::attn_unit_dv<8>(b, hc * 64, hc * 64, (hc >> 1) * 128, (hc >> 1) * 128, qb, (const abf*)Q, (const abf*)K, (const abf*)V, (abf*)((hc & 1) ? O2 : O1), (char*)F.lds); }
        }
    }
}

#define XB_TMO      128
#define XB_XCNT(j)  (256  + 64 * (j))
#define XB_XSUB(j)  (1280 + 64 * (j))
#define XB_XGEN(j)  (2304 + 64 * (j))
#define XB_TOP      3328
#define XB_TOPGEN   3392
#define XCD_BAR_WORDS 3456
#define XB_SPIN_CAP (1u << 18)

__device__ __forceinline__ unsigned xb_ld(unsigned* p)              { return __hip_atomic_load(p, __ATOMIC_RELAXED, __HIP_MEMORY_SCOPE_AGENT); }
__device__ __forceinline__ unsigned xb_add(unsigned* p, unsigned v) { return __hip_atomic_fetch_add(p, v, __ATOMIC_RELAXED, __HIP_MEMORY_SCOPE_AGENT); }
__device__ __forceinline__ unsigned xb_xcc_id() { return (unsigned)__builtin_amdgcn_s_getreg((3 << 11) | 20) & 0xFu; }
#define XB_SPIN(cond, bar) do { unsigned _sp = 0; while (cond) { __builtin_amdgcn_s_sleep(1); \
    if ((++_sp & 255u) == 0u) { if (xb_ld(&(bar)[XB_TMO])) break; if (_sp > XB_SPIN_CAP) { atomicAdd(&(bar)[XB_TMO], 1u); break; } } } } while (0)

struct XcdBarrier {
    unsigned* bar; unsigned x;
    volatile LAS unsigned* st;
};

__device__ __forceinline__ XcdBarrier xcd_barrier_post(unsigned* bar, volatile LAS unsigned* st) {
    XcdBarrier b; b.bar = bar; b.x = xb_xcc_id(); b.st = st;
    if (threadIdx.x == 0) (void)xb_add(&bar[XB_XCNT(b.x)], 1u);
    return b;
}
__device__ __forceinline__ void xcd_barrier_complete(unsigned* bar, unsigned x, unsigned& nloc, unsigned& nx) {
    const unsigned G = gridDim.x * gridDim.y * gridDim.z;
    unsigned sum, cnt, mine, sp = 0u;
    for (;;) {
        sum = 0u; cnt = 0u; mine = 0u;
#pragma unroll
        for (unsigned j = 0; j < 16; ++j) { const unsigned c = xb_ld(&bar[XB_XCNT(j)]); sum += c; cnt += (c > 0u) ? 1u : 0u; mine = (j == x) ? c : mine; }
        if (sum == G) break;
        __builtin_amdgcn_s_sleep(1);
        if ((++sp & 255u) == 0u) { if (xb_ld(&bar[XB_TMO])) break; if (sp > XB_SPIN_CAP) { atomicAdd(&bar[XB_TMO], 1u); break; } }
    }
    nloc = mine > 0u ? mine : 1u; nx = cnt > 0u ? cnt : 1u;
}

__device__ __forceinline__ void xcd_barrier(const XcdBarrier& b) {
    asm volatile("s_waitcnt vmcnt(0)" ::: "memory");
    __syncthreads();
    if (threadIdx.x == 0) {
        unsigned* bar = b.bar;
        __builtin_amdgcn_s_waitcnt(0);
        unsigned nloc = b.st[0], nx = b.st[1];
        if (nloc == 0u) { xcd_barrier_complete(bar, b.x, nloc, nx); b.st[0] = nloc; b.st[1] = nx; }
        const unsigned old = xb_add(&bar[XB_XSUB(b.x)], 1u);
        const unsigned gen = old / nloc;
        if (old + 1u == (gen + 1u) * nloc) {
            __builtin_amdgcn_fence(__ATOMIC_RELEASE, "agent");
            asm volatile("s_waitcnt vmcnt(0)" ::: "memory");
            const unsigned og = xb_add(&bar[XB_TOP], 1u);
            const unsigned tg = og / nx;
            if (og + 1u == (tg + 1u) * nx) xb_add(&bar[XB_TOPGEN], 1u);
            else XB_SPIN(xb_ld(&bar[XB_TOPGEN]) == tg, bar);
            __builtin_amdgcn_fence(__ATOMIC_ACQUIRE, "agent");
            xb_add(&bar[XB_XGEN(b.x)], 1u);
            asm volatile("s_waitcnt vmcnt(0)" ::: "memory");
        } else {
            XB_SPIN(xb_ld(&bar[XB_XGEN(b.x)]) == gen, bar);
            __builtin_amdgcn_fence(__ATOMIC_ACQUIRE, "agent");
            asm volatile("s_waitcnt vmcnt(0)" ::: "memory");
        }
    }
    __syncthreads();
}

constexpr size_t WS_CTL = 0, CTL_ZERO_BYTES = 16384;
constexpr int LDSCTL_OFF = RING_BYTES;
__global__ void __launch_bounds__(NWAVES * 64, 2) yoco_fwd(Args args) {
    extern __shared__ __attribute__((aligned(16))) unsigned char lds[];
    cg::grid_group grid = cg::this_grid();
    using pg8::Gemm; using pg8::StaticOrder; using pg8::EpiQKV; using pg8::EpiRes; using pg8::EpiBf; using pg8::gemm_phase;
    const size_t E64 = 64 * MiB / 2;
    const int ph_lo = args.ph_lo, ph_hi = args.ph_hi;
    if (threadIdx.x < 64) ((LAS unsigned*)((LAS unsigned char*)lds + LDSCTL_OFF))[threadIdx.x] = 0u;
    __syncthreads();
    if (ph_hi - ph_lo > 1 && threadIdx.x == 0) (void)xb_add((unsigned*)(args.ws + WS_CTL) + XB_XCNT(xb_xcc_id()), 1u);
    if (ph_lo == 0) {
        const CAS Args* ap = (const CAS Args*)__builtin_amdgcn_kernarg_segment_ptr(); asm volatile("" : "+s"(ap));
        Frame F; F.a = ap; F.lds = (LAS unsigned char*)lds;
        { int t_ = threadIdx.x; asm volatile("" : "+v"(t_)); F.tid = t_; F.lane = t_ & 63; F.wave = __builtin_amdgcn_readfirstlane(t_ >> 6); }
        int bx = blockIdx.x, G_ = gridDim.x; asm volatile("" : "+s"(bx), "+s"(G_)); F.G = G_; F.vcu = (G_ % 8 == 0) ? (bx % 8) * (G_ / 8) + bx / 8 : bx;
        p0_prologue(F);
    }
    for (int ph = ph_lo; ph < ph_hi; ++ph) {
        const CAS Args* ap = (const CAS Args*)__builtin_amdgcn_kernarg_segment_ptr(); asm volatile("" : "+s"(ap));
        Frame F; F.a = ap; F.lds = (LAS unsigned char*)lds;
#define FRESH_TID() do { int t_ = threadIdx.x; asm volatile("" : "+v"(t_)); F.tid = t_; F.lane = t_ & 63; F.wave = __builtin_amdgcn_readfirstlane(t_ >> 6); } while (0)
        int bx = blockIdx.x, G_ = gridDim.x; asm volatile("" : "+s"(bx), "+s"(G_)); F.G = G_; F.vcu = (G_ % 8 == 0) ? (bx % 8) * (G_ / 8) + bx / 8 : bx;
        const int code = ap->prog[ph], kind = code & 255, L = (code >> 8) & 255, hf = (code >> 16) & 1, w2 = (code >> 17) & 1, full = (code >> 18) & 1;
        const int MH = full ? T : TH;
        unsigned char* ws = ap->ws; LAS unsigned char* ring = F.lds;
        float* rowss = (float*)(ws + WS_ROWSS); bf16* OA1 = (bf16*)ap->out; bf16* OA2 = OA1 + (size_t)T * D;
        bf16* hbX = (bf16*)(ws + WS_HBX); bf16* hbY = (bf16*)(ws + WS_HBY); bf16* R1 = (bf16*)(ws + WS_R1);
        int conv = -1;
#if PROBE_MASK
        const unsigned long long pt0 = __builtin_amdgcn_s_memrealtime();
#endif
        switch (kind) {
        case K_PRO: conv = 0; break;
        case K_QKVA: { Gemm g{hbX, (bf16*)(ws + W_QKV), T, 3 * D, D}; StaticOrder S; S.init(T, 3 * D, F.G, bx);
            EpiQKV<0> E{R1, (long long)(64 * MiB), (long long)(128 * MiB), rowss + (size_t)((3 * L) & 3) * T * 16, (const float*)(ws + WS_CS), nullptr, nullptr};
            gemm_phase<EpiQKV<0>, StaticOrder, PG8_ALIGN, PG8_SP2>(ring, g, S, E); } break;
        case K_ATTA: attn_phase<false>(F, R1, R1 + E64, R1 + 2 * E64, OA1, OA2, nullptr, nullptr, nullptr); break;
        case K_COMB: FRESH_TID(); combine_phase(F, L, OA1, OA2, R1 + 3 * E64); break;
        case K_QKVB: { const int N = (L == 2) ? 3 * D + 256 : D; Gemm g{hbX, (bf16*)(ws + W_QKV), T, N, D}; StaticOrder S; S.init(T, N, F.G, bx);
            EpiQKV<1> E{R1, (long long)((unsigned long long)OA1 - (unsigned long long)R1), (long long)((unsigned long long)OA2 - (unsigned long long)R1), rowss + (size_t)((3 * L) & 3) * T * 16, nullptr, (float*)(ws + WS_FLOG), ap->in[10]};
            gemm_phase<EpiQKV<1>, StaticOrder, PG8_ALIGN, PG8_SP2>(ring, g, S, E); } break;
        case K_SCAN: FRESH_TID(); scan_phase(F); break;
        case K_ATTB: attn_phase<true>(F, R1, OA1, OA2, R1, nullptr, (const float*)(ws + WS_CK), (unsigned*)(ws + WS_CTL) + 3584 + 64 * (L - 2), (const int*)(ws + WS_T0)); break;
        case K_RES: {
            Gemm g{w2 ? R1 : (L < 2 ? R1 + 3 * E64 : R1), (bf16*)(ws + (w2 ? W_2 : W_O)), w2 ? MH : T, D, w2 ? FF : D}; StaticOrder S; S.init(g.M, D, F.G, bx);
            EpiRes<0> E{hbX, w2 ? hbY : hbX, rowss + (size_t)((3 * L + 1 + w2) & 3) * T * 16, nullptr, nullptr, w2 ? hf * TH : 0};
            gemm_phase<EpiRes<0>, StaticOrder, PG8_ALIGN, PG8_SP2>(ring, g, S, E);
            if (!w2) { FRESH_TID(); convert_p(F, L, hbY); } } break;
        case K_W1: { { Gemm g{hbX + (size_t)hf * TH * D, (bf16*)(ws + W_1), MH, FF, D}; StaticOrder S; S.init(MH, FF, F.G, bx);
                EpiBf<1> E{R1, FF, rowss + (size_t)((3 * L + 1) & 3) * T * 16, hf * TH};
                gemm_phase<EpiBf<1>, StaticOrder, PG8_ALIGN, PG8_SP2>(ring, g, S, E); }
            if (hf == 0) { Gemm g2{hbY, (bf16*)(ws + W_PLE), T, D, PLE}; StaticOrder S2; S2.init(T, D, F.G, bx);
                EpiBf<0> E2{(bf16*)(ws + WS_PL), D, nullptr, 0};
                gemm_phase<EpiBf<0>, StaticOrder, PG8_ALIGN, PG8_SP2>(ring, g2, S2, E2); } } break;
        case K_GATE: { Gemm g{hbY, (bf16*)(ws + W_G + (size_t)(L & 1) * 2 * MiB), T, D, D}; StaticOrder S; S.init(T, D, F.G, bx);
            EpiRes<1> E{hbY, hbX, rowss + (size_t)((3 * L + 3) & 3) * T * 16, rowss + (size_t)((3 * L + 2) & 3) * T * 16, (const bf16*)(ws + WS_PL), 0};
            gemm_phase<EpiRes<1>, StaticOrder, PG8_ALIGN, PG8_SP2>(ring, g, S, E);
            if (L + 1 < DEPTH) conv = L + 1; } break;
        default: FRESH_TID(); final_phase(F, hbX, ap->out); break;
        }
        if (conv >= 0) { FRESH_TID(); convert_layer(F, conv); }
#if PROBE_MASK
        if ((PROBE_MASK >> kind) & 1) { const unsigned long long pt1 = __builtin_amdgcn_s_memrealtime(); while (__builtin_amdgcn_s_memrealtime() - pt1 < pt1 - pt0) __builtin_amdgcn_s_sleep(8); }
#endif
        if (ph + 1 < ph_hi) {
            if (ph_hi < 0) grid.sync();
            else { XcdBarrier xb; xb.bar = (unsigned*)(ap->ws + WS_CTL); xb.x = xb_xcc_id(); xb.st = (volatile LAS unsigned*)((LAS unsigned char*)lds + LDSCTL_OFF + 32); xcd_barrier(xb); }
        }
    }
}

static void build_prog(int* prog) {
    int n = 0; prog[n++] = K_PRO;
    for (int L = 0; L < DEPTH; ++L) {
        if (L < 2) { prog[n++] = K_QKVA | L << 8; prog[n++] = K_ATTA | L << 8; prog[n++] = K_COMB | L << 8; }
        else { prog[n++] = K_QKVB | L << 8; if (L == 2) prog[n++] = K_SCAN | L << 8; prog[n++] = K_ATTB | L << 8; }
        prog[n++] = K_RES | L << 8;
        prog[n++] = K_W1 | L << 8 | 1 << 18; prog[n++] = K_RES | L << 8 | 1 << 17 | 1 << 18;
        prog[n++] = K_GATE | L << 8;
    }
    prog[n++] = K_FIN;
    if (n != N_PHASES) fprintf(stderr, "build_prog: %d phases, N_PHASES %d\n", n, N_PHASES);
    while (n < N_PHASES + 1) prog[n++] = K_FIN;
}

extern "C" void kernel_launch(void* const* d_in, const int* in_sizes, int n_in, void* d_out, int out_size, void* d_ws, size_t ws_size, hipStream_t stream) {
    static int grid = 0;
    if (grid == 0) {
        if (n_in != 21 || out_size != T * D || ws_size < WS_END) { fprintf(stderr, "kernel_launch: unexpected problem (n_in %d out %d ws %zu)\n", n_in, out_size, ws_size); grid = -1; return; }
        int dev = 0, cus = 0, per_cu = 0;
        if (hipGetDevice(&dev) != hipSuccess || hipDeviceGetAttribute(&cus, hipDeviceAttributeMultiprocessorCount, dev) != hipSuccess) { grid = -1; return; }
        if (hipFuncSetAttribute((const void*)yoco_fwd, hipFuncAttributeMaxDynamicSharedMemorySize, LDS_BYTES) != hipSuccess) { fprintf(stderr, "kernel_launch: hipFuncSetAttribute failed\n"); grid = -1; return; }
        if (hipOccupancyMaxActiveBlocksPerMultiprocessor(&per_cu, (const void*)yoco_fwd, NWAVES * 64, LDS_BYTES) != hipSuccess || per_cu < 1) { fprintf(stderr, "kernel_launch: occupancy query says %d\n", per_cu); per_cu = 1; }
        (void)hipGetLastError();
        grid = cus;
    }
    if (grid < 0) return;
    Args a{};
    for (int i = 0; i < 21; ++i) a.in[i] = (const float*)d_in[i];
    a.out = (float*)d_out; a.ws = (unsigned char*)d_ws;
    for (int j = 0; j < 8; ++j) { const float p = powf(500000.0f, (float)(2 * j) / 16.0f); a.inv_freq[j] = 1.0f / p; }
    build_prog(a.prog);
#if MK_SPLIT
    for (int p = 0; p < N_PHASES; ++p) { a.ph_lo = p; a.ph_hi = p + 1; hipLaunchKernelGGL(yoco_fwd, dim3(grid), dim3(NWAVES * 64), LDS_BYTES, stream, a); }
#else
    a.ph_lo = 0; a.ph_hi = N_PHASES;
    (void)hipMemsetAsync((char*)d_ws + WS_CTL, 0, CTL_ZERO_BYTES, stream);
    void* kargs[] = {&a};
    const hipError_t e = hipLaunchCooperativeKernel((const void*)yoco_fwd, dim3(grid), dim3(NWAVES * 64), kargs, LDS_BYTES, stream);
    if (e != hipSuccess) fprintf(stderr, "kernel_launch: cooperative launch failed: %s (grid %d)\n", hipGetErrorString(e), grid);
#endif
}
```

```cpp
#include <hip/hip_runtime.h>
#include <cstdio>
#include <cstdint>
namespace pg8 {
#define PG8_LAS __attribute__((address_space(3)))
typedef unsigned short bf16_t;
typedef short bf16x8 __attribute__((ext_vector_type(8)));
typedef float f32x4 __attribute__((ext_vector_type(4)));
typedef unsigned u32x4 __attribute__((ext_vector_type(4)));
constexpr int BM = 256, BK = 64, HALF = 128, HTB = HALF * BK * 2  , STAGE_BYTES = 8 * HTB, NXCD = 8, WGM = 8;

__host__ __device__ __forceinline__ int lds_byte(int r, int c) { const int st = (r >> 4) * 2 + (c >> 5), rr = r & 15, cc = c & 31, ob = rr * 64 + cc * 2; return st * 1024 + (ob ^ (((ob >> 9) & 1) << 5)); }
__host__ __device__ __forceinline__ void stage_rc(int b, int& R, int& C) { const int st = b / 1024, sb = b % 1024, swz = sb ^ (((sb >> 9) & 1) << 5); R = (st >> 1) * 16 + swz / 64; C = (st & 1) * 32 + (swz % 64) / 2; }
__host__ __device__ __forceinline__ int perm32(int rho) { const int n = rho >> 4, i = rho & 15; return 8 * (i >> 2) + 4 * n + (i & 3); }

struct Unit { int pm, pn; };
struct Gemm { const bf16_t* A; const bf16_t* Bt; int M, N, K; };

struct StaticOrder {
    int nM, nN, nwg, G, c;
    __host__ __device__ void init(int M, int N, int G_, int c_) { nM = M / BM; nN = N / BM; nwg = nM * nN; G = G_; c = c_; }
    __host__ __device__ bool next(int i, Unit& u) const {
        const long L = (long)i * G + c; if (L >= nwg) return false;
        int wgid = (int)L; { const int q = nwg / NXCD, r = nwg % NXCD, xcd = wgid % NXCD, off = wgid / NXCD; wgid = (xcd < r ? xcd * (q + 1) : r * (q + 1) + (xcd - r) * q) + off; }
        const int nig = WGM * nN, gid = wgid / nig, fm = gid * WGM, gsz = (nM - fm) < WGM ? (nM - fm) : WGM;
        u.pm = fm + ((wgid % nig) % gsz); u.pn = (wgid % nig) / gsz; return true;
    }
    __device__ __forceinline__ void a_ready(const Unit&) const {}
    __device__ __forceinline__ void done(const Unit&) const {}
};

__device__ __forceinline__ unsigned cvt_pk_bf16(float lo, float hi) { unsigned r; asm volatile("v_cvt_pk_bf16_f32 %0, %1, %2" : "=v"(r) : "v"(lo), "v"(hi)); return r; }
typedef float f32x2 __attribute__((ext_vector_type(2)));
template <int M> __device__ __forceinline__ float lane_xor(float v) { return __builtin_bit_cast(float, __builtin_amdgcn_ds_swizzle(__builtin_bit_cast(int, v), 0x1f | (M << 10))); }
__device__ __forceinline__ float half_sum(float v) { auto rr = __builtin_amdgcn_permlane32_swap(__float_as_uint(v), __float_as_uint(v), false, false); return __uint_as_float(rr[0]) + __uint_as_float(rr[1]); }
typedef float f32x2 __attribute__((ext_vector_type(2)));
typedef unsigned u32x2 __attribute__((ext_vector_type(2)));
constexpr float QK_C2 = 0.125f * 1.4426950408889634f;
__device__ __forceinline__ float rstd_of(const float* rowss, int row) { const f32x4* p = (const f32x4*)(rowss + (size_t)row * 16); const f32x4 a = p[0], b = p[1], c = p[2], d = p[3];
    const float s = (((a[0] + a[1]) + (a[2] + a[3])) + ((b[0] + b[1]) + (b[2] + b[3]))) + (((c[0] + c[1]) + (c[2] + c[3])) + ((d[0] + d[1]) + (d[2] + d[3]))); return __builtin_amdgcn_rsqf(s * (1.0f / 1024.0f) + 1e-6f); }
__device__ __forceinline__ f32x4 rstd_pre(const float* rowss, int row, int fq) { return *(const f32x4*)(rowss + (size_t)row * 16 + 4 * fq); }
__device__ __forceinline__ float rstd_fin(const f32x4 p) { float s = (p[0] + p[1]) + (p[2] + p[3]); s += lane_xor<16>(s); s = half_sum(s); return __builtin_amdgcn_rsqf(s * (1.0f / 1024.0f) + 1e-6f); }
__device__ __forceinline__ float bf2f(unsigned short b) { return __builtin_bit_cast(float, (unsigned)b << 16); }

template <int ACT  > struct EpiBf {
    static constexpr bool PERM = true, AFTER_DRAIN = false;
    bf16_t* O; int ldc; const float* rowss; int row_off;
    __device__ __forceinline__ void operator()(const f32x4 (&acc)[2][2][4][2], const Unit& u, int wr, int wc, int fr, int fq) const {
        const int row0 = u.pm * BM + wr * 64 + fr, col0 = u.pn * BM + wc * 32 + 8 * fq;
        f32x4 rp[2][4];
        if (rowss) {
#pragma unroll
            for (int ai = 0; ai < 2; ++ai)
#pragma unroll
                for (int m = 0; m < 4; ++m) rp[ai][m] = rstd_pre(rowss, row_off + row0 + ai * HALF + m * 16, fq); }
#pragma unroll
        for (int ai = 0; ai < 2; ++ai)
#pragma unroll
            for (int m = 0; m < 4; ++m) { const int rl = row0 + ai * HALF + m * 16; const float rs = rowss ? rstd_fin(rp[ai][m]) : 1.0f; bf16_t* rowp = O + (size_t)rl * ldc + col0;
#pragma unroll
                for (int bj = 0; bj < 2; ++bj) { f32x4 v0 = acc[ai][bj][m][0] * rs, v1 = acc[ai][bj][m][1] * rs;
                    if (ACT == 1) {
#pragma unroll
                        for (int i = 0; i < 4; ++i) { const float a = __builtin_fmaxf(v0[i], 0.f), b = __builtin_fmaxf(v1[i], 0.f); v0[i] = a * a; v1[i] = b * b; } }
                    u32x4 w; w.x = cvt_pk_bf16(v0[0], v0[1]); w.y = cvt_pk_bf16(v0[2], v0[3]); w.z = cvt_pk_bf16(v1[0], v1[1]); w.w = cvt_pk_bf16(v1[2], v1[3]);
                    *(u32x4*)(rowp + bj * HALF) = w; } }
    }
};

template <int MODE> struct EpiQKV {
    static constexpr bool PERM = true, AFTER_DRAIN = false;
    bf16_t* O; long long offK, offV; const float* rowss; const float* cs; float* flog; const float* bfg;
    __device__ __forceinline__ void operator()(const f32x4 (&acc)[2][2][4][2], const Unit& u, int wr, int wc, int fr, int fq) const {
        const int colt = u.pn * BM, t = colt >> 10, cl = colt & 1023;
        const int row0 = u.pm * BM + wr * 64 + fr;
        f32x4 rp[2][4];
#pragma unroll
        for (int ai = 0; ai < 2; ++ai)
#pragma unroll
            for (int m = 0; m < 4; ++m) rp[ai][m] = rstd_pre(rowss, row0 + ai * HALF + m * 16, fq);
        float rsv[2][4];
#pragma unroll
        for (int ai = 0; ai < 2; ++ai)
#pragma unroll
            for (int m = 0; m < 4; ++m) rsv[ai][m] = rstd_fin(rp[ai][m]);
        if (MODE == 1 && t == 3) {
            if (wc == 0 && fq < 2) {
                const f32x4 b0 = *(const f32x4*)(bfg + 8 * fq), b1 = *(const f32x4*)(bfg + 8 * fq + 4);
#pragma unroll
                for (int ai = 0; ai < 2; ++ai)
#pragma unroll
                    for (int m = 0; m < 4; ++m) { const int row = row0 + ai * HALF + m * 16; const float rs = rsv[ai][m];
                        f32x4 v0 = acc[ai][0][m][0] * rs + b0, v1 = acc[ai][0][m][1] * rs + b1;
#pragma unroll
                        for (int i = 0; i < 4; ++i) { v0[i] = __builtin_fminf(v0[i], 0.f) - __logf(1.0f + __expf(-__builtin_fabsf(v0[i]))); v1[i] = __builtin_fminf(v1[i], 0.f) - __logf(1.0f + __expf(-__builtin_fabsf(v1[i])));     }
                        *(f32x4*)(flog + (size_t)row * 16 + 8 * fq) = v0; *(f32x4*)(flog + (size_t)row * 16 + 8 * fq + 4) = v1; }
            }
            return;
        }
        bf16_t* base = (bf16_t*)((char*)O + ((t == 0) ? 0ll : (t == 1) ? offK : offV)); const float sc = (t == 0) ? QK_C2 : 1.0f;
        const bool rope = (MODE == 0) && (t < 2) && !(wc & 1);
        const float sgn = (fq == 0) ? -1.0f : 1.0f;
        const int col0 = cl + wc * 32 + 8 * fq;
#pragma unroll
        for (int ai = 0; ai < 2; ++ai)
#pragma unroll
            for (int m = 0; m < 4; ++m) { const int row = row0 + ai * HALF + m * 16; const float rs = rsv[ai][m]; bf16_t* rowp = base + (size_t)row * 1024 + col0;
                f32x4 c0, c1, s0, s1;
                if (rope) { const float* cp = cs + (size_t)row * 16; c0 = *(const f32x4*)(cp); c1 = *(const f32x4*)(cp + 4); s0 = *(const f32x4*)(cp + 8) * sgn; s1 = *(const f32x4*)(cp + 12) * sgn; }
#pragma unroll
                for (int bj = 0; bj < 2; ++bj) { f32x4 v0 = acc[ai][bj][m][0] * rs, v1 = acc[ai][bj][m][1] * rs;
                    if (rope) { f32x4 p0, p1;
#pragma unroll
                        for (int i = 0; i < 4; ++i) { p0[i] = lane_xor<16>(v0[i]); p1[i] = lane_xor<16>(v1[i]); }
                        const f32x4 r0 = v0 * c0 + p0 * s0, r1 = v1 * c1 + p1 * s1;
                        if (fq < 2) { v0 = r0; v1 = r1; } }
                    v0 = v0 * sc; v1 = v1 * sc;
                    u32x4 w; w.x = cvt_pk_bf16(v0[0], v0[1]); w.y = cvt_pk_bf16(v0[2], v0[3]); w.z = cvt_pk_bf16(v1[0], v1[1]); w.w = cvt_pk_bf16(v1[2], v1[3]);
                    *(u32x4*)(rowp + bj * HALF) = w; } }
    }
};

template <int MODE> struct EpiRes {
    static constexpr bool PERM = true, AFTER_DRAIN = false;
    const bf16_t* res; bf16_t* hb; float* rowss_out; const float* rowss_in; const bf16_t* pl; int row_off;
    static __device__ __forceinline__ void unpack8(const u32x4 w, float (&f)[8]) {
        f[0] = __builtin_bit_cast(float, w.x << 16); f[1] = __builtin_bit_cast(float, w.x & 0xffff0000u); f[2] = __builtin_bit_cast(float, w.y << 16); f[3] = __builtin_bit_cast(float, w.y & 0xffff0000u);
        f[4] = __builtin_bit_cast(float, w.z << 16); f[5] = __builtin_bit_cast(float, w.z & 0xffff0000u); f[6] = __builtin_bit_cast(float, w.w << 16); f[7] = __builtin_bit_cast(float, w.w & 0xffff0000u); }
    __device__ __forceinline__ void operator()(const f32x4 (&acc)[2][2][4][2], const Unit& u, int wr, int wc, int fr, int fq) const {
        const int col0 = u.pn * BM + wc * 32 + 8 * fq, rowb = row_off + u.pm * BM + wr * 64 + fr;
#pragma unroll
        for (int am = 0; am < 4; ++am) { const int ai = am >> 1, mh = (am & 1) * 2;
            u32x4 rw[2][2], pw[2][2]; f32x4 rp[2];
#pragma unroll
            for (int mm = 0; mm < 2; ++mm) { const int rowq = rowb + ai * HALF + (mh + mm) * 16; if (MODE == 1) rp[mm] = rstd_pre(rowss_in, rowq, fq);
#pragma unroll
                for (int bj = 0; bj < 2; ++bj) { const size_t c = (size_t)rowq * 1024 + col0 + bj * HALF; rw[mm][bj] = *(const u32x4*)(res + c); if (MODE == 1) pw[mm][bj] = *(const u32x4*)(pl + c); } }
#pragma unroll
            for (int mm = 0; mm < 2; ++mm) { const int m = mh + mm; const int row = rowb + ai * HALF + m * 16; const size_t off = (size_t)row * 1024 + col0;
                float rs = 0.f; if (MODE == 1) rs = rstd_fin(rp[mm]);
                float ss = 0.f;
#pragma unroll
                for (int bj = 0; bj < 2; ++bj) { float r[8], o[8]; unpack8(rw[mm][bj], r);
                    const f32x4 a0 = acc[ai][bj][m][0], a1 = acc[ai][bj][m][1];
                    if (MODE == 1) { float p[8]; unpack8(pw[mm][bj], p);
#pragma unroll
                        for (int i = 0; i < 4; ++i) { const float g0 = __builtin_amdgcn_rcpf(1.0f + __builtin_amdgcn_exp2f(-a0[i] * rs * 1.4426950408889634f)), g1 = __builtin_amdgcn_rcpf(1.0f + __builtin_amdgcn_exp2f(-a1[i] * rs * 1.4426950408889634f));
                            o[i] = r[i] + p[i] * g0; o[4 + i] = r[4 + i] + p[4 + i] * g1; }
                    } else {
#pragma unroll
                        for (int i = 0; i < 4; ++i) { o[i] = r[i] + a0[i]; o[4 + i] = r[4 + i] + a1[i]; } }
                    u32x4 w; w.x = cvt_pk_bf16(o[0], o[1]); w.y = cvt_pk_bf16(o[2], o[3]); w.z = cvt_pk_bf16(o[4], o[5]); w.w = cvt_pk_bf16(o[6], o[7]);
                    *(u32x4*)(hb + off + bj * HALF) = w;
                    float q[8]; unpack8(w, q);
                    ss += ((q[0] * q[0] + q[1] * q[1]) + (q[2] * q[2] + q[3] * q[3])) + ((q[4] * q[4] + q[5] * q[5]) + (q[6] * q[6] + q[7] * q[7])); }
                ss += lane_xor<16>(ss); ss = half_sum(ss);
                if (fq == 0) rowss_out[(size_t)row * 16 + u.pn * 4 + wc] = ss;
            }
        }
    }
};

template <class Epi, class Sched, bool ALIGN_EPI = false, bool SP2 = false>
__device__ __forceinline__ void gemm_phase(PG8_LAS unsigned char* lds, const Gemm g, const Sched& S, const Epi& E) {
    int tid_ = threadIdx.x; asm volatile("" : "+v"(tid_));
    const int tid = tid_, wid = __builtin_amdgcn_readfirstlane(tid >> 6), lane = tid & 63, wr = wid >> 2, wc = wid & 3, fr = lane & 15, fq = lane >> 4;
    const int K = g.K, nt = K / BK;
    unsigned voffA[2], voffB[2];
#pragma unroll
    for (int i = 0; i < 2; ++i) { int R, C; stage_rc(tid * 16 + i * 8192, R, C); const int Rb = Epi::PERM ? ((R & ~31) + perm32(R & 31)) : R;
        voffA[i] = (unsigned)(R * K + C) * 2u; voffB[i] = (unsigned)(Rb * K + C) * 2u; }
    const size_t kstep = (size_t)(BK * 2);
    const size_t hstep = (size_t)HALF * K * 2;
    const size_t tstep = 2 * hstep;
    const unsigned ldsw = (unsigned)wid * 1024u;
    const int aoff = lds_byte(wr * 64 + fr, fq * 8), boff = lds_byte(wc * 32 + fr, fq * 8);
#define PG8_SA(b, h) (((b) * 2 + (h)) * HTB)
#define PG8_SB(b, h) ((4 + (b) * 2 + (h)) * HTB)
#define PG8_STAGE(bufoff, gbase, voff) do { _Pragma("unroll") for (int _i = 0; _i < 2; ++_i) \
        __builtin_amdgcn_global_load_lds((const unsigned*)((const char*)(gbase) + (voff)[_i]), (PG8_LAS unsigned*)(lds + (bufoff) + ldsw + _i * 8192), 16, 0, 0); } while (0)
#define PG8_LDA(dst, b, h) do { _Pragma("unroll") for (int m = 0; m < 4; ++m) _Pragma("unroll") for (int k = 0; k < 2; ++k) dst[m][k] = *(const PG8_LAS bf16x8*)(lds + PG8_SA(b, h) + aoff + m * 2048 + k * 1024); } while (0)
#define PG8_LDB(dst, b, h) do { _Pragma("unroll") for (int n = 0; n < 2; ++n) _Pragma("unroll") for (int k = 0; k < 2; ++k) dst[n][k] = *(const PG8_LAS bf16x8*)(lds + PG8_SB(b, h) + boff + n * 2048 + k * 1024); } while (0)
#define PG8_MMA(ai, bj, At, Bt) do { __builtin_amdgcn_s_setprio(1); _Pragma("unroll") for (int m = 0; m < 4; ++m) _Pragma("unroll") for (int n = 0; n < 2; ++n) _Pragma("unroll") for (int k = 0; k < 2; ++k) \
        acc[ai][bj][m][n] = __builtin_amdgcn_mfma_f32_16x16x32_bf16(Bt[n][k], At[m][k], acc[ai][bj][m][n], 0, 0, 0); __builtin_amdgcn_s_setprio(0); } while (0)
#define PG8_WAIT_V(n) asm volatile("s_waitcnt vmcnt(" #n ")" ::: "memory")
#define PG8_WAIT_L(n) asm volatile("s_waitcnt lgkmcnt(" #n ")" ::: "memory")
#define PG8_BAR __builtin_amdgcn_s_barrier()
#define PG8_SCHED __builtin_amdgcn_sched_barrier(0)
    Unit cur, nxt; int ui = 0;
    if (!S.next(0, cur)) return;
    f32x4 acc[2][2][4][2];
#pragma unroll
    for (int a = 0; a < 2; ++a)
#pragma unroll
        for (int b = 0; b < 2; ++b)
#pragma unroll
            for (int m = 0; m < 4; ++m)
#pragma unroll
                for (int n = 0; n < 2; ++n) acc[a][b][m][n] = (f32x4){0.f, 0.f, 0.f, 0.f};
    bf16x8 At[4][2], B0[2][2], B1[2][2];
    const char* cA = (const char*)g.A + (size_t)cur.pm * tstep; const char* cB = (const char*)g.Bt + (size_t)cur.pn * tstep;
    S.a_ready(cur);
    if constexpr (SP2) {
        PG8_STAGE(PG8_SB(0, 0), cB, voffB); PG8_STAGE(PG8_SB(0, 1), cB + hstep, voffB); PG8_STAGE(PG8_SA(0, 0), cA, voffA); PG8_STAGE(PG8_SA(0, 1), cA + hstep, voffA);
        if (wr == 1) PG8_BAR;
        PG8_WAIT_V(2); PG8_BAR;
        PG8_STAGE(PG8_SB(1, 0), cB + kstep, voffB); PG8_STAGE(PG8_SA(1, 0), cA + kstep, voffA); PG8_STAGE(PG8_SB(1, 1), cB + hstep + kstep, voffB);
        PG8_WAIT_V(6); PG8_BAR;
    } else {
        PG8_STAGE(PG8_SB(0, 0), cB, voffB); PG8_STAGE(PG8_SA(0, 0), cA, voffA); PG8_STAGE(PG8_SB(0, 1), cB + hstep, voffB); PG8_STAGE(PG8_SA(0, 1), cA + hstep, voffA);
        if (wr == 1) PG8_BAR;
        PG8_WAIT_V(4); PG8_BAR;
        PG8_STAGE(PG8_SB(1, 0), cB + kstep, voffB); PG8_STAGE(PG8_SA(1, 0), cA + kstep, voffA); PG8_STAGE(PG8_SB(1, 1), cB + hstep + kstep, voffB);
        PG8_WAIT_V(6); PG8_BAR;
    }
    for (;;) {
        const bool has_next = S.next(ui + 1, nxt);
        const char* nA = has_next ? (const char*)g.A + (size_t)nxt.pm * tstep : cA; const char* nB = has_next ? (const char*)g.Bt + (size_t)nxt.pn * tstep : cB;
        for (int t = 0; t < nt; t += 2) {
            const bool last = (t == nt - 2);
            const char* a1 = cA + (size_t)(t + 1) * kstep;
            const char* a2 = last ? nA : cA + (size_t)(t + 2) * kstep; const char* b2 = last ? nB : cB + (size_t)(t + 2) * kstep;
            const char* a3 = a2 + kstep; const char* b3 = b2 + kstep;
            if (last && has_next) S.a_ready(nxt);
            if constexpr (SP2) {
            PG8_LDB(B0, 0, 0); PG8_LDB(B1, 0, 1); PG8_SCHED; PG8_LDA(At, 0, 0); PG8_STAGE(PG8_SA(1, 1), a1 + hstep, voffA);
            PG8_WAIT_V(8); PG8_WAIT_L(0); PG8_BAR; PG8_MMA(0, 0, At, B0); PG8_MMA(0, 1, At, B1); PG8_BAR; PG8_SCHED;
            PG8_LDA(At, 0, 1); PG8_STAGE(PG8_SB(0, 0), b2, voffB); PG8_STAGE(PG8_SB(0, 1), b2 + hstep, voffB); PG8_STAGE(PG8_SA(0, 0), a2, voffA);
            PG8_WAIT_V(8); PG8_WAIT_L(0); PG8_BAR; PG8_MMA(1, 0, At, B0); PG8_MMA(1, 1, At, B1); PG8_BAR; PG8_SCHED;
            PG8_LDB(B0, 1, 0); PG8_LDB(B1, 1, 1); PG8_SCHED; PG8_LDA(At, 1, 0); PG8_STAGE(PG8_SA(0, 1), a2 + hstep, voffA);
            PG8_WAIT_V(8); PG8_WAIT_L(0); PG8_BAR; PG8_MMA(0, 0, At, B0); PG8_MMA(0, 1, At, B1); PG8_BAR; PG8_SCHED;
            PG8_LDA(At, 1, 1); PG8_STAGE(PG8_SB(1, 0), b3, voffB); PG8_STAGE(PG8_SB(1, 1), b3 + hstep, voffB); PG8_STAGE(PG8_SA(1, 0), a3, voffA);
            PG8_WAIT_V(8); PG8_WAIT_L(0); PG8_BAR; PG8_MMA(1, 0, At, B0); PG8_MMA(1, 1, At, B1); PG8_BAR; PG8_SCHED;
            } else {
            PG8_LDB(B0, 0, 0); PG8_SCHED; PG8_LDA(At, 0, 0); PG8_STAGE(PG8_SA(1, 1), a1 + hstep, voffA);
            PG8_WAIT_L(8); PG8_BAR; PG8_WAIT_L(0); PG8_MMA(0, 0, At, B0); PG8_BAR; PG8_SCHED;
            PG8_LDB(B1, 0, 1); PG8_STAGE(PG8_SB(0, 0), b2, voffB);
            PG8_BAR; PG8_WAIT_L(0); PG8_MMA(0, 1, At, B1); PG8_BAR;
            PG8_LDA(At, 0, 1); PG8_STAGE(PG8_SA(0, 0), a2, voffA);
            PG8_BAR; PG8_WAIT_L(0); PG8_MMA(1, 0, At, B0); PG8_BAR; PG8_SCHED;
            PG8_STAGE(PG8_SB(0, 1), b2 + hstep, voffB);
            PG8_WAIT_V(6); PG8_BAR; PG8_MMA(1, 1, At, B1); PG8_BAR;
            PG8_LDB(B0, 1, 0); PG8_SCHED; PG8_LDA(At, 1, 0); PG8_STAGE(PG8_SA(0, 1), a2 + hstep, voffA);
            PG8_WAIT_L(8); PG8_BAR; PG8_WAIT_L(0); PG8_MMA(0, 0, At, B0); PG8_BAR; PG8_SCHED;
            PG8_LDB(B1, 1, 1); PG8_STAGE(PG8_SB(1, 0), b3, voffB);
            PG8_BAR; PG8_WAIT_L(0); PG8_MMA(0, 1, At, B1); PG8_BAR;
            PG8_LDA(At, 1, 1); PG8_STAGE(PG8_SA(1, 0), a3, voffA);
            PG8_BAR; PG8_WAIT_L(0); PG8_MMA(1, 0, At, B0); PG8_BAR; PG8_SCHED;
            PG8_STAGE(PG8_SB(1, 1), b3 + hstep, voffB);
            PG8_WAIT_V(6); PG8_BAR; PG8_MMA(1, 1, At, B1); PG8_BAR;
            }
        }
        if constexpr (ALIGN_EPI) { if (wr == 0) PG8_BAR; }
        if constexpr (!Epi::AFTER_DRAIN) { int te_ = threadIdx.x; asm volatile("" : "+v"(te_)); const int le_ = te_ & 63, we_ = __builtin_amdgcn_readfirstlane(te_ >> 6);
            E(acc, cur, we_ >> 2, we_ & 3, le_ & 15, le_ >> 4); S.done(cur); }
        if (!has_next) break;
#pragma unroll
        for (int a = 0; a < 2; ++a)
#pragma unroll
            for (int b = 0; b < 2; ++b)
#pragma unroll
                for (int m = 0; m < 4; ++m)
#pragma unroll
                    for (int n = 0; n < 2; ++n) acc[a][b][m][n] = (f32x4){0.f, 0.f, 0.f, 0.f};
        cur = nxt; cA = nA; cB = nB; ++ui;
        if constexpr (ALIGN_EPI) { if (wr == 1) PG8_BAR; }
    }
    PG8_WAIT_V(0);
    if constexpr (!ALIGN_EPI) { if (wr == 0) PG8_BAR; }
    PG8_BAR;
    if constexpr (Epi::AFTER_DRAIN) { E.fused(acc, cur, wr, wc, fr, fq, lds, wid, lane); S.done(cur); }
#undef PG8_SA
#undef PG8_SB
#undef PG8_STAGE
#undef PG8_LDA
#undef PG8_LDB
#undef PG8_MMA
#undef PG8_WAIT_V
#undef PG8_WAIT_L
#undef PG8_BAR
#undef PG8_SCHED
}
}

#ifndef PG8_SP2
#define PG8_SP2 true
#endif
#ifndef PG8_ALIGN
#define PG8_ALIGN true
#endif
#include <hip/hip_bf16.h>
#include <cmath>
namespace attn_body {
using bf16=__hip_bfloat16;
using bf16x8=__attribute__((ext_vector_type(8)))short;
using s16x4=__attribute__((ext_vector_type(4)))short;
using f32x16=__attribute__((ext_vector_type(16)))float;
using u32x4=__attribute__((ext_vector_type(4)))unsigned;
constexpr int BATCH=4,NHEAD=16,SEQ=8192,D=64,DM=NHEAD*D;
constexpr int NW=8,QBLK=32,QB=QBLK*NW,KVBLK=64,NQB=SEQ/QB;
constexpr int ATTN_PITCH=DM, ATTN_UNIT_ROWS=QB;
__device__ __forceinline__ int crow(int r,int hi){return (r&3)+8*(r>>2)+4*hi;}
#define SBAR() __builtin_amdgcn_sched_barrier(0)
__device__ __forceinline__ void cmask(f32x16&p0,f32x16&p1,int jb,int qrel,int hi){
  const float NEG=-INFINITY; int kb=64*jb+4*hi;
  #pragma unroll
  for(int r=0;r<16;++r){int kv=kb+(r&3)+8*(r>>2); if(kv>qrel)p0[r]=NEG; if(kv+32>qrel)p1[r]=NEG;}
}

constexpr int NSLOT=3, SLOTB=8192;
constexpr int LDS_K=0, LDS_V=NSLOT*SLOTB, LDS_WS=2*NSLOT*SLOTB, LDS_OST=LDS_WS+NW*64*4, LDS_BIAS=LDS_OST+NW*4096  , LDS_BYTES=LDS_BIAS+32768;
constexpr float C2=0.125f*1.4426950408889634f;
__device__ __forceinline__ void glds16(const void*gsrc,unsigned lds_dst){unsigned keep;
  asm volatile("s_mov_b32 %0, m0\n\ts_mov_b32 m0, %2\n\ts_nop 0\n\tglobal_load_lds_dwordx4 %1, off\n\ts_mov_b32 m0, %0":"=&s"(keep):"v"(gsrc),"s"(lds_dst):"memory");}
__device__ __forceinline__ float max3f(float a,float b,float c){float r;asm("v_max3_f32 %0, %1, %2, %3":"=v"(r):"v"(a),"v"(b),"v"(c));return r;}
__device__ __forceinline__ float max2f(float a,float b){float r;asm("v_max_f32_e32 %0, %1, %2":"=v"(r):"v"(a),"v"(b));return r;}
__device__ __forceinline__ float fadd_s(float a,float b){float r;asm("v_add_f32_e32 %0, %1, %2":"=v"(r):"v"(a),"v"(b));return r;}
__device__ __forceinline__ float fsub_s(float a,float b){float r;asm("v_sub_f32_e32 %0, %1, %2":"=v"(r):"v"(a),"v"(b));return r;}
typedef float f32x2_t __attribute__((ext_vector_type(2))); typedef __bf16 bf16x2_t __attribute__((ext_vector_type(2)));
__device__ __forceinline__ unsigned cvtpk_s(float lo,float hi){f32x2_t v={lo,hi};bf16x2_t b=__builtin_convertvector(v,bf16x2_t);return __builtin_bit_cast(unsigned,b);}
#define WAIT_BAR(N) asm volatile("s_waitcnt vmcnt(" #N ") lgkmcnt(0)\n\ts_barrier":::"memory")

template<bool ACCUM> __device__ __forceinline__ void qkt(f32x16&p0,f32x16&p1,const char*Kslot,const bf16x8*qr,const f32x16&negm,int r32,int hi){
  const char*kb=Kslot+hi*1024+r32*16;
  #pragma unroll
  for(int d0=0;d0<4;++d0){
    const bf16x8 b0=*reinterpret_cast<const bf16x8*>(kb+d0*2048);
    const bf16x8 b1=*reinterpret_cast<const bf16x8*>(kb+d0*2048+512);
    if(d0==0&&!ACCUM){p0=__builtin_amdgcn_mfma_f32_32x32x16_bf16(b0,qr[0],negm,0,0,0);p1=__builtin_amdgcn_mfma_f32_32x32x16_bf16(b1,qr[0],negm,0,0,0);}
    else{p0=__builtin_amdgcn_mfma_f32_32x32x16_bf16(b0,qr[d0],p0,0,0,0);p1=__builtin_amdgcn_mfma_f32_32x32x16_bf16(b1,qr[d0],p1,0,0,0);}}
}
typedef __attribute__((address_space(3))) const char* lds_cptr;
typedef short v4i16_t __attribute__((ext_vector_type(4)));
__device__ __forceinline__ void kload8(bf16x8*kf,lds_cptr kp){
  kf[0]=*(const __attribute__((address_space(3))) bf16x8*)(kp);      kf[1]=*(const __attribute__((address_space(3))) bf16x8*)(kp+512);
  kf[2]=*(const __attribute__((address_space(3))) bf16x8*)(kp+2048); kf[3]=*(const __attribute__((address_space(3))) bf16x8*)(kp+2560);
  kf[4]=*(const __attribute__((address_space(3))) bf16x8*)(kp+4096); kf[5]=*(const __attribute__((address_space(3))) bf16x8*)(kp+4608);
  kf[6]=*(const __attribute__((address_space(3))) bf16x8*)(kp+6144); kf[7]=*(const __attribute__((address_space(3))) bf16x8*)(kp+6656);
}
__device__ __forceinline__ void kload2(bf16x8*kf,lds_cptr kp,int j){ kf[2*j]=*(const __attribute__((address_space(3))) bf16x8*)(kp+j*2048); kf[2*j+1]=*(const __attribute__((address_space(3))) bf16x8*)(kp+j*2048+512); }
__device__ __forceinline__ s16x4 vtr(lds_cptr p){ return __builtin_bit_cast(s16x4,__builtin_amdgcn_ds_read_tr16_b64_v4i16((__attribute__((address_space(3))) v4i16_t*)p)); }
__device__ __forceinline__ float rowmax(const f32x16&p0,const f32x16&p1){
  float a=max3f(p0[0],p0[1],p1[0]),b=max3f(p0[2],p0[3],p1[1]);a=max3f(a,p1[2],p1[3]);
  #pragma unroll
  for(int r=4;r<16;r+=4){a=max3f(a,p0[r],p0[r+1]);b=max3f(b,p0[r+2],p0[r+3]);a=max3f(a,p1[r],p1[r+1]);b=max3f(b,p1[r+2],p1[r+3]);}
  const float m=max2f(a,b);
  auto rr=__builtin_amdgcn_permlane32_swap(__float_as_uint(m),__float_as_uint(m),false,false);
  return max2f(__uint_as_float(rr[0]),__uint_as_float(rr[1]));
}
__device__ __forceinline__ void pv(f32x16*o,int vb,bf16x8 pa0,bf16x8 pa1,bf16x8 pa2,bf16x8 pa3){
  #pragma unroll
  for(int d0=0;d0<2;++d0){s16x4 lo[4],hi[4];
    #pragma unroll
    for(int ks=0;ks<4;++ks){
      asm volatile("ds_read_b64_tr_b16 %0,%1 offset:%c2":"=&v"(lo[ks]):"v"(vb),"i"(d0*4096+ks*1024):"memory");
      asm volatile("ds_read_b64_tr_b16 %0,%1 offset:%c2":"=&v"(hi[ks]):"v"(vb),"i"(d0*4096+ks*1024+512):"memory");}
    asm volatile("s_waitcnt lgkmcnt(0)":::"memory");SBAR();
    #define PK(k) (bf16x8){lo[k][0],lo[k][1],lo[k][2],lo[k][3],hi[k][0],hi[k][1],hi[k][2],hi[k][3]}
    o[d0]=__builtin_amdgcn_mfma_f32_32x32x16_bf16(pa0,PK(0),o[d0],0,0,0);
    o[d0]=__builtin_amdgcn_mfma_f32_32x32x16_bf16(pa1,PK(1),o[d0],0,0,0);
    o[d0]=__builtin_amdgcn_mfma_f32_32x32x16_bf16(pa2,PK(2),o[d0],0,0,0);
    o[d0]=__builtin_amdgcn_mfma_f32_32x32x16_bf16(pa3,PK(3),o[d0],0,0,0);
    #undef PK
  }
}

#ifndef ATTN_STORE16
#define ATTN_STORE16(p,v) (*(u32x4*)(p)=(v))
#endif
typedef float f32x4b __attribute__((ext_vector_type(4)));
__device__ __forceinline__ void binit(f32x16&c0,f32x16&c1,lds_cptr bp,float nm){
  #pragma unroll
  for(int g=0;g<4;++g){ const f32x4b a=*(const __attribute__((address_space(3))) f32x4b*)(bp+g*32); const f32x4b bb=*(const __attribute__((address_space(3))) f32x4b*)(bp+128+g*32);
    #pragma unroll
    for(int i=0;i<4;++i){ c0[4*g+i]=nm-a[i]; c1[4*g+i]=nm-bb[i]; } }
}
__device__ __forceinline__ void bload(f32x16&c0,f32x16&c1,lds_cptr bp){
  #pragma unroll
  for(int g=0;g<4;++g){ const f32x4b a=*(const __attribute__((address_space(3))) f32x4b*)(bp+g*32); const f32x4b bb=*(const __attribute__((address_space(3))) f32x4b*)(bp+128+g*32);
    #pragma unroll
    for(int i=0;i<4;++i){ c0[4*g+i]=a[i]; c1[4*g+i]=bb[i]; } }
}
__device__ __forceinline__ void bfin(f32x16&c0,f32x16&c1,float nm){
  #pragma unroll
  for(int r=0;r<16;++r){ c0[r]=nm-c0[r]; c1[r]=nm-c1[r]; }
}
template<int THRL,bool BIAS> __device__ __forceinline__ void attn_unit(int b,int cq,int ck,int cv,int co,int qb,const bf16*Q,const bf16*__restrict__ K,const bf16*__restrict__ V,bf16*O,const float*cb,char*shm,int t0){
  int tid_=threadIdx.x; asm volatile("":"+v"(tid_)); const int tid=tid_,lane=tid&63,r32=lane&31,hi=lane>>5; const int wid=__builtin_amdgcn_readfirstlane(tid>>6);
  const long rowbase=(long)b*SEQ; const int q0=qb*QB;
  const bf16*Qw=Q+(rowbase+q0+wid*QBLK)*DM+cq;
  const bf16*Kh=K+(rowbase+(long)t0*KVBLK)*DM+ck,*Vh=V+(rowbase+(long)t0*KVBLK)*DM+cv;
  const unsigned lds0=(unsigned)(uintptr_t)shm;
  float*wsf=(float*)(shm+LDS_WS)+wid*64;
  const bf16*ksrc=Kh+(long)lane*DM+wid*8;
  const bf16*vsrc=Vh+(long)(16*(wid&3)+(lane>>2))*DM+(wid>>2)*32+(lane&3)*8;
  const unsigned kdst=lds0+LDS_K+wid*1024, vdst=lds0+LDS_V+wid*1024;
  #define DMA_K(t,slot) glds16(ksrc+(long)(t)*KVBLK*DM,(unsigned)__builtin_amdgcn_readfirstlane(kdst+(slot)))
  #define DMA_V(t,slot) glds16(vsrc+(long)(t)*KVBLK*DM,(unsigned)__builtin_amdgcn_readfirstlane(vdst+(slot)))
  const int vb0=(int)(lds0+LDS_V)+((lane>>4)&1)*32+(lane&3)*8+(4*hi+((lane&15)>>2))*64;
  const char*Kbase=shm+LDS_K; bf16x8 kf[8];
  const lds_cptr shm3=(lds_cptr)shm; const lds_cptr kp0=shm3+LDS_K+hi*1024+r32*16; const lds_cptr vp0=shm3+LDS_V+((lane>>4)&1)*32+(lane&3)*8+(4*hi+((lane&15)>>2))*64;
  const int NT=(q0+QB)/KVBLK-t0;
  float cqv=0.f,nm=0.f; const lds_cptr bp0=shm3+LDS_BIAS+hi*16+t0*256;
  if constexpr(BIAS){ for(int p=(t0>>2)+wid;p<=qb;p+=NW) glds16(cb+p*256+lane*4,(unsigned)__builtin_amdgcn_readfirstlane(lds0+LDS_BIAS+p*1024));
    cqv=cb[q0+wid*QBLK+r32]; }
  DMA_K(0,0);DMA_V(0,0);DMA_K(1,SLOTB);
  bf16x8 qr[4];
  #pragma unroll
  for(int d0=0;d0<4;++d0)qr[d0]=*reinterpret_cast<const bf16x8*>(&Qw[(long)r32*DM+d0*16+hi*8]);
  float mhat=0.f,l_reg=0.f;f32x16 o[2];o[0]=f32x16{};o[1]=f32x16{};f32x16 negm=f32x16{};if constexpr(!BIAS)asm volatile("":"+v"(negm));
  const int qrel=wid*QBLK+r32;
  #define CMASK(P0,P1,t) do{int jb_=(t)-(NT-4); if(jb_>=0)cmask(P0,P1,jb_,qrel,hi);}while(0)
  bool resc=false;
  #define START(P0,P1) do{ const float rm=rowmax(P0,P1); resc=false; \
    { const float dl=BIAS?__builtin_fmaxf(rm,0.f):rm; mhat=fadd_s(mhat,dl); \
      _Pragma("unroll") for(int r=0;r<16;++r){P0[r]=fsub_s(P0[r],dl);P1[r]=fsub_s(P1[r],dl);} \
      if constexpr(BIAS){ nm=cqv-mhat; } else { _Pragma("unroll") for(int r=0;r<16;++r)negm[r]=-mhat; asm volatile("":"+v"(negm)); } } \
    _Pragma("unroll") for(int r=0;r<16;++r)P0[r]=__builtin_amdgcn_exp2f(P0[r]); }while(0)
  #define RESC() do{ if(resc){ asm volatile("s_waitcnt lgkmcnt(0)":::"memory"); \
      _Pragma("unroll") for(int d_=0;d_<2;++d_) _Pragma("unroll") for(int r=0;r<16;++r)o[d_][r]*=wsf[crow(r,hi)]; } }while(0)
  f32x16 pA0,pA1,pB0,pB1;
  int sl_prev=0,sl_cur=0,sl_next=SLOTB;
  #define ROT() do{sl_prev=sl_cur;sl_cur=sl_next;sl_next=(sl_next==(NSLOT-1)*SLOTB)?0:sl_next+SLOTB;}while(0)
  DMA_K(2,2*SLOTB);
  WAIT_BAR(3);
  if constexpr(BIAS){ nm=cqv; binit(pA0,pA1,bp0,nm); qkt<true>(pA0,pA1,Kbase,qr,negm,r32,hi); } else { qkt<false>(pA0,pA1,Kbase,qr,negm,r32,hi); } asm volatile("s_nop 15\n\ts_nop 7":"+v"(pA0),"+v"(pA1));CMASK(pA0,pA1,0);
  START(pA0,pA1);
  _Pragma("unroll") for(int r=0;r<16;++r)pA1[r]=__builtin_amdgcn_exp2f(pA1[r]);
  if constexpr(BIAS){ binit(pB0,pB1,bp0+256,nm); }
  WAIT_BAR(0);
  DMA_K(3,0);DMA_V(1,SLOTB);
  ROT();
  kload8(kf,kp0+sl_cur);
  WAIT_BAR(2);
  s16x4 vlo[8],vhi[8]; u32x4 pw0,pw1,pw2,pw3;
  #define PKW(P,B) cvtpk_s(P[B],P[B+1])
  #define PAF(k) __builtin_bit_cast(bf16x8,pw##k)
  #define VFR(i) (bf16x8){vlo[i][0],vlo[i][1],vlo[i][2],vlo[i][3],vhi[i][0],vhi[i][1],vhi[i][2],vhi[i][3]}
  #define PIN(x) asm volatile("":"+v"(x))
  #define MX3(a,b,c) __builtin_fmaxf(__builtin_fmaxf((a),(b)),(c))
  #define GAPA(MF,A0,A1,A2,A3,W0,W1,PW) do{ MF; sacc+=A0; sacc+=A1; sacc+=A2; sacc+=A3; PIN(sacc); W0; W1; PIN(PW); SBAR(); }while(0)
  #define EX(v) __builtin_amdgcn_exp2f(v)
  #define GAPB(MF,X,B) do{ MF; X[B]=EX(X[B]); X[B+1]=EX(X[B+1]); X[B+2]=EX(X[B+2]); X[B+3]=EX(X[B+3]); PIN(X); SBAR(); }while(0)
  #define VRD(i) do{ vlo[i]=vtr(vp_+(((i)>>2)*4096+((i)&3)*1024)); vhi[i]=vtr(vp_+(((i)>>2)*4096+((i)&3)*1024+512)); }while(0)
  #define KRD(G,j) do{ if(G){ kload2(kf,kp0+sl_next,j); SBAR(); } }while(0)
  #define STEP(C0,C1,P0,P1,t,GK,GV,GL) do{ SBAR(); \
    const lds_cptr vp_=vp0+sl_prev; \
    VRD(0); SBAR(); float sacc=(P0[0]+P0[1]); \
    GAPA(C0=__builtin_amdgcn_mfma_f32_32x32x16_bf16(kf[0],qr[0],BIAS?C0:negm,0,0,0), P0[2],P0[3],P0[4],P0[5],     pw0[0]=PKW(P0,0), pw0[1]=PKW(P0,2), pw0); \
    VRD(4); SBAR(); GAPA(C1=__builtin_amdgcn_mfma_f32_32x32x16_bf16(kf[1],qr[0],BIAS?C1:negm,0,0,0), P0[6],P0[7],P0[8],P0[9],     pw0[2]=PKW(P0,4), pw0[3]=PKW(P0,6), pw0); \
    VRD(1); SBAR(); GAPA(C0=__builtin_amdgcn_mfma_f32_32x32x16_bf16(kf[2],qr[1],C0,0,0,0),   P0[10],P0[11],P0[12],P0[13], pw1[0]=PKW(P0,8), pw1[1]=PKW(P0,10), pw1); \
    VRD(5); SBAR(); GAPA(C1=__builtin_amdgcn_mfma_f32_32x32x16_bf16(kf[3],qr[1],C1,0,0,0),   P0[14],P0[15],P1[0],P1[1],   pw1[2]=PKW(P0,12),pw1[3]=PKW(P0,14), pw1); \
    VRD(2); SBAR(); GAPA(C0=__builtin_amdgcn_mfma_f32_32x32x16_bf16(kf[4],qr[2],C0,0,0,0),   P1[2],P1[3],P1[4],P1[5],     pw2[0]=PKW(P1,0), pw2[1]=PKW(P1,2), pw2); \
    VRD(6); SBAR(); GAPA(C1=__builtin_amdgcn_mfma_f32_32x32x16_bf16(kf[5],qr[2],C1,0,0,0),   P1[6],P1[7],P1[8],P1[9],     pw2[2]=PKW(P1,4), pw2[3]=PKW(P1,6), pw2); \
    VRD(3); SBAR(); GAPA(C0=__builtin_amdgcn_mfma_f32_32x32x16_bf16(kf[6],qr[3],C0,0,0,0),   P1[10],P1[11],P1[12],P1[13], pw3[0]=PKW(P1,8), pw3[1]=PKW(P1,10), pw3); \
    VRD(7); SBAR(); GAPA(C1=__builtin_amdgcn_mfma_f32_32x32x16_bf16(kf[7],qr[3],C1,0,0,0),   P1[14],P1[15],0.f,0.f,       pw3[2]=PKW(P1,12),pw3[3]=PKW(P1,14), pw3); \
    l_reg+=sacc; \
    if(GK){DMA_K((t)+3,sl_cur);} if(GV){DMA_V((t)+1,sl_next);} \
    CMASK(C0,C1,t); \
    { float a=MX3(C0[0],C0[1],C1[0]),b=MX3(C0[2],C0[3],C1[1]); a=MX3(a,C1[2],C1[3]); \
      _Pragma("unroll") for(int r=4;r<16;r+=4){a=MX3(a,C0[r],C0[r+1]);b=MX3(b,C0[r+2],C0[r+3]);a=MX3(a,C1[r],C1[r+1]);b=MX3(b,C1[r+2],C1[r+3]);} \
      float rm=__builtin_fmaxf(a,b); { auto rr=__builtin_amdgcn_permlane32_swap(__float_as_uint(rm),__float_as_uint(rm),false,false); rm=__builtin_fmaxf(__uint_as_float(rr[0]),__uint_as_float(rr[1])); } \
      resc=false; \
      if(__builtin_expect(__any(rm>(float)THRL),0)){ const float dl=__builtin_fmaxf(rm,0.f); mhat+=dl; \
        _Pragma("unroll") for(int r=0;r<16;++r){C0[r]-=dl;C1[r]-=dl;} \
        if constexpr(BIAS){ nm=cqv-mhat; } else { _Pragma("unroll") for(int r=0;r<16;++r)negm[r]=-mhat; asm volatile("":"+v"(negm)); } \
        const float f=__builtin_amdgcn_exp2f(-dl); l_reg*=f; if(hi==0)wsf[r32]=f; resc=true; } } \
    SBAR(); \
    if constexpr(BIAS){ if(GL){ bload(P0,P1,bp0+((t)+1)*256); SBAR(); } } \
    GAPB(o[0]=__builtin_amdgcn_mfma_f32_32x32x16_bf16(PAF(0),VFR(0),o[0],0,0,0), C0,0); \
    GAPB(o[1]=__builtin_amdgcn_mfma_f32_32x32x16_bf16(PAF(0),VFR(4),o[1],0,0,0), C0,4); \
    KRD(GL,0); GAPB(o[0]=__builtin_amdgcn_mfma_f32_32x32x16_bf16(PAF(1),VFR(1),o[0],0,0,0), C0,8); \
    KRD(GL,1); GAPB(o[1]=__builtin_amdgcn_mfma_f32_32x32x16_bf16(PAF(1),VFR(5),o[1],0,0,0), C0,12); \
    KRD(GL,2); GAPB(o[0]=__builtin_amdgcn_mfma_f32_32x32x16_bf16(PAF(2),VFR(2),o[0],0,0,0), C1,0); \
    KRD(GL,3); GAPB(o[1]=__builtin_amdgcn_mfma_f32_32x32x16_bf16(PAF(2),VFR(6),o[1],0,0,0), C1,4); \
    GAPB(o[0]=__builtin_amdgcn_mfma_f32_32x32x16_bf16(PAF(3),VFR(3),o[0],0,0,0), C1,8); \
    GAPB(o[1]=__builtin_amdgcn_mfma_f32_32x32x16_bf16(PAF(3),VFR(7),o[1],0,0,0), C1,12); \
    if constexpr(BIAS){ if(GL){ bfin(P0,P1,nm); SBAR(); } } \
    }while(0)
  int t=1;
  #undef CMASK
  #define CMASK(P0,P1,t) do{}while(0)
  for(;t+5<NT;t+=2){
    STEP(pB0,pB1,pA0,pA1,t,true,true,true);     WAIT_BAR(2); RESC(); ROT();
    STEP(pA0,pA1,pB0,pB1,t+1,true,true,true);   WAIT_BAR(2); RESC(); ROT();
  }
  #undef CMASK
  #define CMASK(P0,P1,t) do{int jb_=(t)-(NT-4); if(jb_>=0)cmask(P0,P1,jb_,qrel,hi);}while(0)
  #define ENDW(tt) do{ if((tt)+3<NT){WAIT_BAR(2);} else if((tt)+2<NT){WAIT_BAR(1);} else {WAIT_BAR(0);} }while(0)
  for(;t+1<NT;t+=2){
    STEP(pB0,pB1,pA0,pA1,t,(t+3<NT),(t+1<NT),(t+1<NT));       ENDW(t);   RESC(); ROT();
    STEP(pA0,pA1,pB0,pB1,t+1,(t+4<NT),(t+2<NT),(t+2<NT));     ENDW(t+1); RESC(); ROT();
  }
  STEP(pB0,pB1,pA0,pA1,NT-1,false,false,false); RESC();
  { float sacc=pB0[0]+pB0[1]; _Pragma("unroll") for(int r=2;r<16;++r)sacc+=pB0[r]; _Pragma("unroll") for(int r=0;r<16;++r)sacc+=pB1[r]; l_reg+=sacc;
    pw0=(u32x4){PKW(pB0,0),PKW(pB0,2),PKW(pB0,4),PKW(pB0,6)};pw1=(u32x4){PKW(pB0,8),PKW(pB0,10),PKW(pB0,12),PKW(pB0,14)};pw2=(u32x4){PKW(pB1,0),PKW(pB1,2),PKW(pB1,4),PKW(pB1,6)};pw3=(u32x4){PKW(pB1,8),PKW(pB1,10),PKW(pB1,12),PKW(pB1,14)};
    SBAR(); pv(o,vb0+sl_cur,PAF(0),PAF(1),PAF(2),PAF(3)); }
  #undef PKW
  #undef PAF
  #undef VFR
  #undef PIN
  #undef MX3
  #undef GAPA
  #undef GAPB
  #undef EX
  #undef VRD
  #undef KRD
  #undef STEP
  #undef ENDW
  {auto rr=__builtin_amdgcn_permlane32_swap(__float_as_uint(l_reg),__float_as_uint(l_reg),false,false);l_reg=__uint_as_float(rr[0])+__uint_as_float(rr[1]);}
  if(hi==0)wsf[32+r32]=l_reg;asm volatile("s_waitcnt lgkmcnt(0)":::"memory");
  float rli[16];
  #pragma unroll
  for(int r=0;r<16;++r)rli[r]=__builtin_amdgcn_rcpf(wsf[32+crow(r,hi)]);
  bf16*Ow=O+(rowbase+q0+wid*QBLK)*DM+co;
  { bf16*stg=(bf16*)(shm+LDS_OST)+wid*2048;
    #pragma unroll
    for(int r=0;r<16;++r){const int orow=crow(r,hi);
      #pragma unroll
      for(int d0=0;d0<2;++d0)stg[orow*64+d0*32+r32]=__float2bfloat16(o[d0][r]*rli[r]);}
    asm volatile("s_waitcnt lgkmcnt(0)":::"memory");
    #pragma unroll
    for(int i=0;i<4;++i){const int row=i*8+(lane>>3),ch=lane&7; const u32x4 v=*(const u32x4*)(stg+row*64+ch*8); ATTN_STORE16(Ow+(long)row*DM+ch*8,v);} }
  asm volatile("s_waitcnt lgkmcnt(0)\n\ts_barrier":::"memory");
  #undef DMA_K
  #undef DMA_V
  #undef CMASK
  #undef START
  #undef RESC
  #undef ROT
}
constexpr int DV_LDS_V=NSLOT*SLOTB, DV_LDS_WS=DV_LDS_V+NSLOT*2*SLOTB, DV_LDS_OST=DV_LDS_WS+NW*64*4, DV_LDS_BYTES=DV_LDS_OST+NW*4096;
static_assert(DV_LDS_BYTES<=LDS_BYTES,"dv variant fits the attention LDS budget");
template<int THRL> __device__ __forceinline__ void attn_unit_dv(int b,int cq,int ck,int cv,int co,int qb,const bf16*Q,const bf16*__restrict__ K,const bf16*__restrict__ V,bf16*O,char*shm){
  constexpr bool BIAS=false; constexpr int LDS_V=DV_LDS_V, LDS_WS=DV_LDS_WS, LDS_OST=DV_LDS_OST;
  int tid_=threadIdx.x; asm volatile("":"+v"(tid_)); const int tid=tid_,lane=tid&63,r32=lane&31,hi=lane>>5; const int wid=__builtin_amdgcn_readfirstlane(tid>>6);
  const long rowbase=(long)b*SEQ; const int q0=qb*QB;
  const bf16*Qw=Q+(rowbase+q0+wid*QBLK)*DM+cq;
  const bf16*Kh=K+rowbase*DM+ck,*Vh=V+rowbase*DM+cv;
  const unsigned lds0=(unsigned)(uintptr_t)shm;
  float*wsf=(float*)(shm+LDS_WS)+wid*64;
  const bf16*ksrc=Kh+(long)lane*DM+wid*8;
  const bf16*vsrc=Vh+(long)(16*(wid&3)+(lane>>2))*DM+(wid>>2)*32+(lane&3)*8;
  const unsigned kdst=lds0+LDS_K+wid*1024, vdst=lds0+LDS_V+wid*1024;
  #define DMA_K(t,slot) glds16(ksrc+(long)(t)*KVBLK*DM,(unsigned)__builtin_amdgcn_readfirstlane(kdst+(slot)))
  #define DMA_V(t,slot) do{ glds16(vsrc+(long)(t)*KVBLK*DM,(unsigned)__builtin_amdgcn_readfirstlane(vdst+2*(slot))); glds16(vsrc+(long)(t)*KVBLK*DM+64,(unsigned)__builtin_amdgcn_readfirstlane(vdst+2*(slot)+8192)); }while(0)
  const int vb0=(int)(lds0+LDS_V)+((lane>>4)&1)*32+(lane&3)*8+(4*hi+((lane&15)>>2))*64;
  const char*Kbase=shm+LDS_K; bf16x8 kf[8];
  const lds_cptr shm3=(lds_cptr)shm; const lds_cptr kp0=shm3+LDS_K+hi*1024+r32*16; const lds_cptr vp0=shm3+LDS_V+((lane>>4)&1)*32+(lane&3)*8+(4*hi+((lane&15)>>2))*64;
  const int NT=(q0+QB)/KVBLK;
  DMA_K(0,0);DMA_V(0,0);DMA_K(1,SLOTB);
  bf16x8 qr[4];
  #pragma unroll
  for(int d0=0;d0<4;++d0)qr[d0]=*reinterpret_cast<const bf16x8*>(&Qw[(long)r32*DM+d0*16+hi*8]);
  float mhat=0.f,l_reg=0.f;f32x16 o[4];o[0]=f32x16{};o[1]=f32x16{};o[2]=f32x16{};o[3]=f32x16{};f32x16 negm=f32x16{};asm volatile("":"+v"(negm));
  const int qrel=wid*QBLK+r32;
  #define CMASK(P0,P1,t) do{int jb_=(t)-(NT-4); if(jb_>=0)cmask(P0,P1,jb_,qrel,hi);}while(0)
  bool resc=false;
  #define START(P0,P1) do{ const float rm=rowmax(P0,P1); resc=false; \
    { const float dl=BIAS?__builtin_fmaxf(rm,0.f):rm; mhat=fadd_s(mhat,dl); \
      _Pragma("unroll") for(int r=0;r<16;++r){P0[r]=fsub_s(P0[r],dl);P1[r]=fsub_s(P1[r],dl);} \
      _Pragma("unroll") for(int r=0;r<16;++r)negm[r]=-mhat; asm volatile("":"+v"(negm)); } \
    _Pragma("unroll") for(int r=0;r<16;++r)P0[r]=__builtin_amdgcn_exp2f(P0[r]); }while(0)
  #define RESC() do{ if(resc){ asm volatile("s_waitcnt lgkmcnt(0)":::"memory"); \
      _Pragma("unroll") for(int d_=0;d_<4;++d_) _Pragma("unroll") for(int r=0;r<16;++r)o[d_][r]*=wsf[crow(r,hi)]; } }while(0)
  f32x16 pA0,pA1,pB0,pB1;
  int sl_prev=0,sl_cur=0,sl_next=SLOTB;
  #define ROT() do{sl_prev=sl_cur;sl_cur=sl_next;sl_next=(sl_next==(NSLOT-1)*SLOTB)?0:sl_next+SLOTB;}while(0)
  DMA_K(2,2*SLOTB);
  WAIT_BAR(4);
  qkt<false>(pA0,pA1,Kbase,qr,negm,r32,hi); asm volatile("s_nop 15\n\ts_nop 7":"+v"(pA0),"+v"(pA1));CMASK(pA0,pA1,0);
  START(pA0,pA1);
  _Pragma("unroll") for(int r=0;r<16;++r)pA1[r]=__builtin_amdgcn_exp2f(pA1[r]);
  WAIT_BAR(0);
  DMA_K(3,0);DMA_V(1,SLOTB);
  ROT();
  kload8(kf,kp0+sl_cur);
  WAIT_BAR(3);
  s16x4 vlo[8],vhi[8]; u32x4 pw0,pw1,pw2,pw3;
  #define PKW(P,B) cvtpk_s(P[B],P[B+1])
  #define PAF(k) __builtin_bit_cast(bf16x8,pw##k)
  #define VFR(i) (bf16x8){vlo[i][0],vlo[i][1],vlo[i][2],vlo[i][3],vhi[i][0],vhi[i][1],vhi[i][2],vhi[i][3]}
  #define PIN(x) asm volatile("":"+v"(x))
  #define MX3(a,b,c) __builtin_fmaxf(__builtin_fmaxf((a),(b)),(c))
  #define GAPA(MF,A0,A1,A2,A3,W0,W1,PW) do{ MF; sacc+=A0; sacc+=A1; sacc+=A2; sacc+=A3; PIN(sacc); W0; W1; PIN(PW); SBAR(); }while(0)
  #define EX(v) __builtin_amdgcn_exp2f(v)
  #define GAPB(MF,X,B) do{ MF; X[B]=EX(X[B]); X[B+1]=EX(X[B+1]); X[B+2]=EX(X[B+2]); X[B+3]=EX(X[B+3]); PIN(X); SBAR(); }while(0)
  #define VRD(i) do{ vlo[i]=vtr(vp_+(((i)>>2)*4096+((i)&3)*1024)); vhi[i]=vtr(vp_+(((i)>>2)*4096+((i)&3)*1024+512)); }while(0)
  #define VRD2(i) do{ vlo[i]=vtr(vp_+(8192+((i)>>2)*4096+((i)&3)*1024)); vhi[i]=vtr(vp_+(8192+((i)>>2)*4096+((i)&3)*1024+512)); }while(0)
  #define GAPB2(MF,X,B) do{ MF; X[B]=EX(X[B]); X[B+1]=EX(X[B+1]); PIN(X); SBAR(); }while(0)
  #define KRD(G,j) do{ if(G){ kload2(kf,kp0+sl_next,j); SBAR(); } }while(0)
  #define STEP(C0,C1,P0,P1,t,GK,GV,GL) do{ SBAR(); \
    const lds_cptr vp_=vp0+2*sl_prev; \
    VRD(0); SBAR(); float sacc=(P0[0]+P0[1]); \
    GAPA(C0=__builtin_amdgcn_mfma_f32_32x32x16_bf16(kf[0],qr[0],negm,0,0,0), P0[2],P0[3],P0[4],P0[5],     pw0[0]=PKW(P0,0), pw0[1]=PKW(P0,2), pw0); \
    VRD(4); SBAR(); GAPA(C1=__builtin_amdgcn_mfma_f32_32x32x16_bf16(kf[1],qr[0],negm,0,0,0), P0[6],P0[7],P0[8],P0[9],     pw0[2]=PKW(P0,4), pw0[3]=PKW(P0,6), pw0); \
    VRD(1); SBAR(); GAPA(C0=__builtin_amdgcn_mfma_f32_32x32x16_bf16(kf[2],qr[1],C0,0,0,0),   P0[10],P0[11],P0[12],P0[13], pw1[0]=PKW(P0,8), pw1[1]=PKW(P0,10), pw1); \
    VRD(5); SBAR(); GAPA(C1=__builtin_amdgcn_mfma_f32_32x32x16_bf16(kf[3],qr[1],C1,0,0,0),   P0[14],P0[15],P1[0],P1[1],   pw1[2]=PKW(P0,12),pw1[3]=PKW(P0,14), pw1); \
    VRD(2); SBAR(); GAPA(C0=__builtin_amdgcn_mfma_f32_32x32x16_bf16(kf[4],qr[2],C0,0,0,0),   P1[2],P1[3],P1[4],P1[5],     pw2[0]=PKW(P1,0), pw2[1]=PKW(P1,2), pw2); \
    VRD(6); SBAR(); GAPA(C1=__builtin_amdgcn_mfma_f32_32x32x16_bf16(kf[5],qr[2],C1,0,0,0),   P1[6],P1[7],P1[8],P1[9],     pw2[2]=PKW(P1,4), pw2[3]=PKW(P1,6), pw2); \
    VRD(3); SBAR(); GAPA(C0=__builtin_amdgcn_mfma_f32_32x32x16_bf16(kf[6],qr[3],C0,0,0,0),   P1[10],P1[11],P1[12],P1[13], pw3[0]=PKW(P1,8), pw3[1]=PKW(P1,10), pw3); \
    VRD(7); SBAR(); GAPA(C1=__builtin_amdgcn_mfma_f32_32x32x16_bf16(kf[7],qr[3],C1,0,0,0),   P1[14],P1[15],0.f,0.f,       pw3[2]=PKW(P1,12),pw3[3]=PKW(P1,14), pw3); \
    l_reg+=sacc; \
    if(GK){DMA_K((t)+3,sl_cur);} if(GV){DMA_V((t)+1,sl_next);} \
    CMASK(C0,C1,t); \
    { float a=MX3(C0[0],C0[1],C1[0]),b=MX3(C0[2],C0[3],C1[1]); a=MX3(a,C1[2],C1[3]); \
      _Pragma("unroll") for(int r=4;r<16;r+=4){a=MX3(a,C0[r],C0[r+1]);b=MX3(b,C0[r+2],C0[r+3]);a=MX3(a,C1[r],C1[r+1]);b=MX3(b,C1[r+2],C1[r+3]);} \
      float rm=__builtin_fmaxf(a,b); { auto rr=__builtin_amdgcn_permlane32_swap(__float_as_uint(rm),__float_as_uint(rm),false,false); rm=__builtin_fmaxf(__uint_as_float(rr[0]),__uint_as_float(rr[1])); } \
      resc=false; \
      if(__builtin_expect(__any(rm>(float)THRL),0)){ const float dl=__builtin_fmaxf(rm,0.f); mhat+=dl; \
        _Pragma("unroll") for(int r=0;r<16;++r){C0[r]-=dl;C1[r]-=dl;} \
        _Pragma("unroll") for(int r=0;r<16;++r)negm[r]=-mhat; asm volatile("":"+v"(negm)); \
        const float f=__builtin_amdgcn_exp2f(-dl); l_reg*=f; if(hi==0)wsf[r32]=f; resc=true; } } \
    SBAR(); \
    GAPB2(o[0]=__builtin_amdgcn_mfma_f32_32x32x16_bf16(PAF(0),VFR(0),o[0],0,0,0), C0,0);  VRD2(0); SBAR(); \
    GAPB2(o[1]=__builtin_amdgcn_mfma_f32_32x32x16_bf16(PAF(0),VFR(4),o[1],0,0,0), C0,2);  VRD2(4); SBAR(); \
    GAPB2(o[0]=__builtin_amdgcn_mfma_f32_32x32x16_bf16(PAF(1),VFR(1),o[0],0,0,0), C0,4);  VRD2(1); SBAR(); \
    GAPB2(o[1]=__builtin_amdgcn_mfma_f32_32x32x16_bf16(PAF(1),VFR(5),o[1],0,0,0), C0,6);  VRD2(5); SBAR(); \
    GAPB2(o[0]=__builtin_amdgcn_mfma_f32_32x32x16_bf16(PAF(2),VFR(2),o[0],0,0,0), C0,8);  VRD2(2); SBAR(); \
    GAPB2(o[1]=__builtin_amdgcn_mfma_f32_32x32x16_bf16(PAF(2),VFR(6),o[1],0,0,0), C0,10); VRD2(6); SBAR(); \
    GAPB2(o[0]=__builtin_amdgcn_mfma_f32_32x32x16_bf16(PAF(3),VFR(3),o[0],0,0,0), C0,12); VRD2(3); SBAR(); \
    GAPB2(o[1]=__builtin_amdgcn_mfma_f32_32x32x16_bf16(PAF(3),VFR(7),o[1],0,0,0), C0,14); VRD2(7); SBAR(); \
    KRD(GL,0); GAPB2(o[2]=__builtin_amdgcn_mfma_f32_32x32x16_bf16(PAF(0),VFR(0),o[2],0,0,0), C1,0); \
    KRD(GL,1); GAPB2(o[3]=__builtin_amdgcn_mfma_f32_32x32x16_bf16(PAF(0),VFR(4),o[3],0,0,0), C1,2); \
    KRD(GL,2); GAPB2(o[2]=__builtin_amdgcn_mfma_f32_32x32x16_bf16(PAF(1),VFR(1),o[2],0,0,0), C1,4); \
    KRD(GL,3); GAPB2(o[3]=__builtin_amdgcn_mfma_f32_32x32x16_bf16(PAF(1),VFR(5),o[3],0,0,0), C1,6); \
    GAPB2(o[2]=__builtin_amdgcn_mfma_f32_32x32x16_bf16(PAF(2),VFR(2),o[2],0,0,0), C1,8); \
    GAPB2(o[3]=__builtin_amdgcn_mfma_f32_32x32x16_bf16(PAF(2),VFR(6),o[3],0,0,0), C1,10); \
    GAPB2(o[2]=__builtin_amdgcn_mfma_f32_32x32x16_bf16(PAF(3),VFR(3),o[2],0,0,0), C1,12); \
    GAPB2(o[3]=__builtin_amdgcn_mfma_f32_32x32x16_bf16(PAF(3),VFR(7),o[3],0,0,0), C1,14); \
    }while(0)
  int t=1;
  #undef CMASK
  #define CMASK(P0,P1,t) do{}while(0)
  for(;t+5<NT;t+=2){
    STEP(pB0,pB1,pA0,pA1,t,true,true,true);     WAIT_BAR(3); RESC(); ROT();
    STEP(pA0,pA1,pB0,pB1,t+1,true,true,true);   WAIT_BAR(3); RESC(); ROT();
  }
  #undef CMASK
  #define CMASK(P0,P1,t) do{int jb_=(t)-(NT-4); if(jb_>=0)cmask(P0,P1,jb_,qrel,hi);}while(0)
  #define ENDW(tt) do{ if((tt)+3<NT){WAIT_BAR(3);} else if((tt)+2<NT){WAIT_BAR(2);} else {WAIT_BAR(0);} }while(0)
  for(;t+1<NT;t+=2){
    STEP(pB0,pB1,pA0,pA1,t,(t+3<NT),(t+1<NT),(t+1<NT));       ENDW(t);   RESC(); ROT();
    STEP(pA0,pA1,pB0,pB1,t+1,(t+4<NT),(t+2<NT),(t+2<NT));     ENDW(t+1); RESC(); ROT();
  }
  STEP(pB0,pB1,pA0,pA1,NT-1,false,false,false); RESC();
  { float sacc=pB0[0]+pB0[1]; _Pragma("unroll") for(int r=2;r<16;++r)sacc+=pB0[r]; _Pragma("unroll") for(int r=0;r<16;++r)sacc+=pB1[r]; l_reg+=sacc;
    pw0=(u32x4){PKW(pB0,0),PKW(pB0,2),PKW(pB0,4),PKW(pB0,6)};pw1=(u32x4){PKW(pB0,8),PKW(pB0,10),PKW(pB0,12),PKW(pB0,14)};pw2=(u32x4){PKW(pB1,0),PKW(pB1,2),PKW(pB1,4),PKW(pB1,6)};pw3=(u32x4){PKW(pB1,8),PKW(pB1,10),PKW(pB1,12),PKW(pB1,14)};
    SBAR(); pv(o,vb0+2*sl_cur,PAF(0),PAF(1),PAF(2),PAF(3)); pv(o+2,vb0+2*sl_cur+8192,PAF(0),PAF(1),PAF(2),PAF(3)); }
  #undef PKW
  #undef PAF
  #undef VFR
  #undef PIN
  #undef MX3
  #undef GAPA
  #undef GAPB
  #undef EX
  #undef VRD
  #undef VRD2
  #undef GAPB2
  #undef KRD
  #undef STEP
  #undef ENDW
  {auto rr=__builtin_amdgcn_permlane32_swap(__float_as_uint(l_reg),__float_as_uint(l_reg),false,false);l_reg=__uint_as_float(rr[0])+__uint_as_float(rr[1]);}
  if(hi==0)wsf[32+r32]=l_reg;asm volatile("s_waitcnt lgkmcnt(0)":::"memory");
  float rli[16];
  #pragma unroll
  for(int r=0;r<16;++r)rli[r]=__builtin_amdgcn_rcpf(wsf[32+crow(r,hi)]);
  bf16*Ow=O+(rowbase+q0+wid*QBLK)*DM+co;
  { bf16*stg=(bf16*)(shm+LDS_OST)+wid*2048;
    #pragma unroll
    for(int ps=0;ps<2;++ps){
      #pragma unroll
      for(int r=0;r<16;++r){const int orow=crow(r,hi);
        #pragma unroll
        for(int d0=0;d0<2;++d0)stg[orow*64+d0*32+r32]=__float2bfloat16(o[2*ps+d0][r]*rli[r]);}
      asm volatile("s_waitcnt lgkmcnt(0)":::"memory");
      #pragma unroll
      for(int i=0;i<4;++i){const int row=i*8+(lane>>3),ch=lane&7; const u32x4 v=*(const u32x4*)(stg+row*64+ch*8); ATTN_STORE16(Ow+(long)row*DM+ps*64+ch*8,v);}
      asm volatile("s_waitcnt lgkmcnt(0)":::"memory"); } }
  asm volatile("s_waitcnt lgkmcnt(0)\n\ts_barrier":::"memory");
  #undef DMA_K
  #undef DMA_V
  #undef CMASK
  #undef START
  #undef RESC
  #undef ROT
}
constexpr int ATTN_LDS_BYTES=LDS_BYTES;
#undef SBAR
#undef WAIT_BAR
}
#include <hip/hip_cooperative_groups.h>
namespace cg = cooperative_groups;
#ifndef PROBE_MASK
#define PROBE_MASK 0
#endif
#ifndef MK_SPLIT
#define MK_SPLIT 0
#endif
constexpr int NWAVES = 8;
constexpr int BATCH = 4, SEQ = 8192, T = BATCH * SEQ, D = 1024, FF = 4096, PLE = 256, DEPTH = 4, NFH = 16;
constexpr int TH = T / 2;
constexpr size_t MiB = 1u << 20;
constexpr size_t WS_ROWSS = 8 * MiB;
constexpr size_t WS_T0 = 1 * MiB;
constexpr float SKIP_LOG2 = -160.0f;
constexpr size_t WS_CS = 2 * MiB;
constexpr size_t WS_FLOG = 4 * MiB;
constexpr size_t WS_CK = 6 * MiB;
constexpr size_t W_QKV = 16 * MiB;
constexpr size_t W_O = 23 * MiB;
constexpr size_t W_1 = 25 * MiB;
constexpr size_t W_2 = 33 * MiB;
constexpr size_t W_PLE = 41 * MiB;
constexpr size_t W_G = 42 * MiB;
constexpr size_t WS_HBX = 48 * MiB, WS_HBY = 112 * MiB, WS_R1 = 176 * MiB, WS_PL = 432 * MiB, WS_END = 496 * MiB;
constexpr int RING_BYTES = 131072, LDS_BYTES = 147456;
static_assert(attn_body::ATTN_LDS_BYTES <= RING_BYTES, "attention LDS");

#define GAS __attribute__((address_space(1)))
#define LAS __attribute__((address_space(3)))
typedef unsigned short bf16;
typedef unsigned v4u __attribute__((ext_vector_type(4)));
typedef float f32x4 __attribute__((ext_vector_type(4)));
#define LDS_WAIT() asm volatile("s_waitcnt lgkmcnt(0)" ::: "memory")
__device__ __forceinline__ unsigned f2bf(float f) { unsigned u = __builtin_bit_cast(unsigned, f); return (u + 0x7fffu + ((u >> 16) & 1u)) >> 16; }
__device__ __forceinline__ unsigned pk2(float lo, float hi) { return f2bf(lo) | (f2bf(hi) << 16); }
__device__ __forceinline__ float wave_sum(float v) {
    v += pg8::lane_xor<1>(v); v += pg8::lane_xor<2>(v); v += pg8::lane_xor<4>(v); v += pg8::lane_xor<8>(v); v += pg8::lane_xor<16>(v);
    return pg8::half_sum(v);
}

constexpr int N_PHASES = 1 + 7 + 7 + 7 + 6 + 1;
enum { K_PRO = 0, K_QKVA, K_ATTA, K_COMB, K_QKVB, K_SCAN, K_ATTB, K_RES, K_W1, K_GATE, K_FIN };
struct Args { const float* in[21]; float* out; unsigned char* ws; float inv_freq[8]; int ph_lo, ph_hi; int prog[N_PHASES + 1]; };

#define CAS __attribute__((address_space(4)))
struct Frame { LAS unsigned char* lds; int tid, lane, wave, vcu, G; const CAS Args* a; };

__device__ __forceinline__ void transpose_item(const float* W, int ldw, int coff, int ncols, int K, const float* gain, bf16* WT, int row_off, LAS float* scr, int item, int nblk, int lane) {
    const int kb = item / nblk, nb = item % nblk, k0 = 64 * kb, n0 = 32 * nb;
#pragma unroll
    for (int i = 0; i < 8; ++i) { const int kk = 8 * i + (lane >> 3), n4 = (lane & 7) * 4, n = n0 + n4;
        f32x4 v = (n < ncols) ? *(const GAS f32x4*)(W + (size_t)(k0 + kk) * ldw + coff + n) : (f32x4){0.f, 0.f, 0.f, 0.f};
        if (gain) v = v * gain[k0 + kk];
        LAS float* d = scr + kk * 33 + n4; d[0] = v.x; d[1] = v.y; d[2] = v.z; d[3] = v.w; }
    LDS_WAIT(); asm volatile("" ::: "memory");
    const int c = lane & 7;
#pragma unroll
    for (int j = 0; j < 4; ++j) { const int n = (lane >> 3) + 8 * j; const LAS float* s = scr + (8 * c) * 33 + n;
        v4u o; o.x = pk2(s[0 * 33], s[1 * 33]); o.y = pk2(s[2 * 33], s[3 * 33]); o.z = pk2(s[4 * 33], s[5 * 33]); o.w = pk2(s[6 * 33], s[7 * 33]);
        *(GAS v4u*)(WT + (size_t)(row_off + n0 + n) * K + k0 + 8 * c) = o; }
    LDS_WAIT(); asm volatile("" ::: "memory");
}

__device__ __forceinline__ void convert_layer(Frame& F, int L) {
    const CAS Args& A = *F.a; unsigned char* ws = A.ws;
    LAS float* scr = (LAS float*)(F.lds + F.wave * 16384);
    const int gw = F.vcu * NWAVES + F.wave, NGW = F.G * NWAVES;
    bf16* Wqkv = (bf16*)(ws + W_QKV); bf16* Wo = (bf16*)(ws + W_O); bf16* W1 = (bf16*)(ws + W_1); bf16* W2 = (bf16*)(ws + W_2); bf16* Wp = (bf16*)(ws + W_PLE); bf16* Wg = (bf16*)(ws + W_G + (size_t)(L & 1) * 2 * MiB);
    const bool isA = L < 2; const int j = L - 2;
    const int I_QKV = isA ? 16 * 96 : 16 * 32, I_KV = (!isA && j == 0) ? 16 * 64 : 0, I_F = (!isA && j == 0) ? 16 : 0, I_O = 16 * 32, I_1 = 16 * 128, I_2 = 64 * 32, I_G = 16 * 32, I_P = 4 * 32;
    const int NIT = I_QKV + I_KV + I_F + I_O + I_1 + I_2 + I_G + I_P;
    for (int it = gw; it < NIT; it += NGW) {
        int r = it;
        if (r < I_QKV) { if (isA) transpose_item(A.in[4] + (size_t)L * D * 3 * D, 3 * D, 0, 3 * D, D, A.in[3] + L * D, Wqkv, 0, scr, r, 96, F.lane);
                         else transpose_item(A.in[12] + (size_t)j * D * D, D, 0, D, D, A.in[11] + j * D, Wqkv, 0, scr, r, 32, F.lane); continue; } r -= I_QKV;
        if (r < I_KV) { transpose_item(A.in[9], 2 * D + NFH, 0, 2 * D, D, A.in[8], Wqkv, D, scr, r, 64, F.lane); continue; } r -= I_KV;
        if (r < I_F) { transpose_item(A.in[9], 2 * D + NFH, 2 * D, NFH, D, A.in[8], Wqkv, 3 * D, scr, r, 1, F.lane); continue; } r -= I_F;
        if (r < I_O) { transpose_item(isA ? A.in[7] + (size_t)L * D * D : A.in[13] + (size_t)j * D * D, D, 0, D, D, nullptr, Wo, 0, scr, r, 32, F.lane); continue; } r -= I_O;
        if (r < I_1) { transpose_item(A.in[15] + (size_t)L * D * FF, FF, 0, FF, D, A.in[14] + L * D, W1, 0, scr, r, 128, F.lane); continue; } r -= I_1;
        if (r < I_2) { transpose_item(A.in[16] + (size_t)L * FF * D, D, 0, D, FF, nullptr, W2, 0, scr, r, 32, F.lane); continue; } r -= I_2;
        if (r < I_G) { transpose_item(A.in[18] + (size_t)L * D * D, D, 0, D, D, A.in[17] + L * D, Wg, 0, scr, r, 32, F.lane); continue; } r -= I_G;
        transpose_item(A.in[19] + (size_t)L * PLE * D, D, 0, D, PLE, nullptr, Wp, 0, scr, r, 32, F.lane);
    }
}

__device__ __forceinline__ void sincos_red(double r, float& s, float& c) {
    const double r2 = r * r;
    double sp = -1.0 / 51090942171709440000.0;
    sp = sp * r2 + 1.0 / 121645100408832000.0;
    sp = sp * r2 - 1.0 / 355687428096000.0;
    sp = sp * r2 + 1.0 / 1307674368000.0;
    sp = sp * r2 - 1.0 / 6227020800.0;
    sp = sp * r2 + 1.0 / 39916800.0;
    sp = sp * r2 - 1.0 / 362880.0;
    sp = sp * r2 + 1.0 / 5040.0;
    sp = sp * r2 - 1.0 / 120.0;
    sp = sp * r2 + 1.0 / 6.0;
    sp = sp * r2 - 1.0;
    s = (float)(-(sp * r));
    double cp = 1.0 / 1124000727777607680000.0;
    cp = cp * r2 - 1.0 / 2432902008176640000.0;
    cp = cp * r2 + 1.0 / 6402373705728000.0;
    cp = cp * r2 - 1.0 / 20922789888000.0;
    cp = cp * r2 + 1.0 / 87178291200.0;
    cp = cp * r2 - 1.0 / 479001600.0;
    cp = cp * r2 + 1.0 / 3628800.0;
    cp = cp * r2 - 1.0 / 40320.0;
    cp = cp * r2 + 1.0 / 720.0;
    cp = cp * r2 - 1.0 / 24.0;
    cp = cp * r2 + 0.5;
    c = (float)(1.0 - cp * r2);
}

__device__ __forceinline__ void p0_prologue(Frame& F) {
    const CAS Args& A = *F.a; unsigned char* ws = A.ws;
    const int gw = F.vcu * NWAVES + F.wave, NGW = F.G * NWAVES, gt = gw * 64 + F.lane, NGT = NGW * 64;
    float* rowss = (float*)(ws + WS_ROWSS);
    bf16* hbx = (bf16*)(ws + WS_HBX);
    for (int m0 = gw; m0 < T; m0 += 2 * NGW) {
        const int m1 = (m0 + NGW < T) ? m0 + NGW : m0;
        const GAS f32x4* xa = (const GAS f32x4*)(A.in[0] + (size_t)m0 * D) + F.lane; const GAS f32x4* xb = (const GAS f32x4*)(A.in[0] + (size_t)m1 * D) + F.lane;
        const f32x4 a0 = xa[0], a1 = xa[64], a2 = xa[128], a3 = xa[192], b0 = xb[0], b1 = xb[64], b2 = xb[128], b3 = xb[192];
#define XROW(m, v0, v1, v2, v3) { float s = 0.f; GAS unsigned long long* o8 = (GAS unsigned long long*)(hbx + (size_t)(m) * D) + F.lane; \
            XQ(0, v0) XQ(1, v1) XQ(2, v2) XQ(3, v3) s = wave_sum(s); if (F.lane < 16) rowss[(size_t)(m) * 16 + F.lane] = (F.lane == 0) ? s : 0.f; }
#define XQ(j, v) { const unsigned lo = pk2(v.x, v.y), hi = pk2(v.z, v.w); o8[64 * j] = (unsigned long long)lo | ((unsigned long long)hi << 32); \
            const float q0 = __builtin_bit_cast(float, lo << 16), q1 = __builtin_bit_cast(float, lo & 0xffff0000u), q2 = __builtin_bit_cast(float, hi << 16), q3 = __builtin_bit_cast(float, hi & 0xffff0000u); s += (q0 * q0 + q1 * q1) + (q2 * q2 + q3 * q3); }
        XROW(m0, a0, a1, a2, a3)
        if (m1 != m0) XROW(m1, b0, b1, b2, b3)
#undef XQ
#undef XROW
    }
    float* cs = (float*)(ws + WS_CS); const int* pos = (const int*)A.in[2];
    for (int i = gt; i < T * 8; i += NGT) { const int row = i >> 3, jj = i & 7;
        const float ang = (float)pos[row] * A.inv_freq[jj]; const double a = (double)ang;
        const double n = __builtin_rint(a * 0.15915494309189535); const double r = __builtin_fma(-n, 6.283185307179586, a) - n * 2.4492935982947064e-16;
        float s, c; sincos_red(r, s, c); cs[row * 16 + jj] = c; cs[row * 16 + 8 + jj] = s; }
}

__device__ __forceinline__ void convert_p(Frame& F, int L, bf16* pb) {
    const CAS Args& A = *F.a; const int gt = (F.vcu * NWAVES + F.wave) * 64 + F.lane, NGT = F.G * NWAVES * 64;
    const GAS f32x4* src = (const GAS f32x4*)(A.in[1] + (size_t)L * T * PLE); GAS v4u* dst = (GAS v4u*)pb;
#pragma unroll 4
    for (int i = gt; i < T * PLE / 8; i += NGT) { const f32x4 a = src[2 * i], b = src[2 * i + 1]; v4u o; o.x = pk2(a.x, a.y); o.y = pk2(a.z, a.w); o.z = pk2(b.x, b.y); o.w = pk2(b.z, b.w); dst[i] = o; }
}

__device__ __forceinline__ void scan_phase(Frame& F) {
    unsigned char* ws = F.a->ws; const float* flog = (const float*)(ws + WS_FLOG); float* ck = (float*)(ws + WS_CK);
    LAS float* wtot = (LAS float*)F.lds;
    for (int bh = blockIdx.x; bh < BATCH * NFH; bh += F.G) { const int b = bh >> 4, h = bh & 15, t0 = F.tid * 16;
        float v0, v1, v2, v3, v4, v5, v6, v7, v8, v9, v10, v11, v12, v13, v14, v15;
        const float* src = flog + ((size_t)b * SEQ + t0) * 16 + h;
        v0 = src[0]; v1 = v0 + src[16]; v2 = v1 + src[32]; v3 = v2 + src[48]; v4 = v3 + src[64]; v5 = v4 + src[80]; v6 = v5 + src[96]; v7 = v6 + src[112];
        v8 = v7 + src[128]; v9 = v8 + src[144]; v10 = v9 + src[160]; v11 = v10 + src[176]; v12 = v11 + src[192]; v13 = v12 + src[208]; v14 = v13 + src[224]; v15 = v14 + src[240];
        float incl = v15, tot = v15;
#define BSTEP(M) { const float pt = pg8::lane_xor<M>(tot); if (F.lane & M) incl += pt; tot += pt; }
        BSTEP(1) BSTEP(2) BSTEP(4) BSTEP(8) BSTEP(16)
#undef BSTEP
        { const float lowtot = __builtin_bit_cast(float, __builtin_amdgcn_readlane(__builtin_bit_cast(int, tot), 0)); if (F.lane & 32) incl += lowtot; }
        if (F.lane == 63) wtot[F.wave] = incl;
        LDS_WAIT(); __syncthreads();
        float base = incl - v15;
        for (int w = 0; w < F.wave; ++w) base += wtot[w];
        const float L2E = 1.4426950408889634f;
        f32x4* dst = (f32x4*)(ck + (size_t)bh * SEQ + t0);
        dst[0] = (f32x4){(v0 + base) * L2E, (v1 + base) * L2E, (v2 + base) * L2E, (v3 + base) * L2E};
        dst[1] = (f32x4){(v4 + base) * L2E, (v5 + base) * L2E, (v6 + base) * L2E, (v7 + base) * L2E};
        dst[2] = (f32x4){(v8 + base) * L2E, (v9 + base) * L2E, (v10 + base) * L2E, (v11 + base) * L2E};
        dst[3] = (f32x4){(v12 + base) * L2E, (v13 + base) * L2E, (v14 + base) * L2E, (v15 + base) * L2E};
        asm volatile("s_waitcnt vmcnt(0)" ::: "memory"); __syncthreads();
        if (F.tid < 32) { const int qb = F.tid, ntf = 4 * qb; const float* cb = ck + (size_t)bh * SEQ; const float cq0 = cb[qb * 256];
            int lo = 0, hi2 = ntf;
            while (lo < hi2) { const int mid = (lo + hi2) >> 1; if (cq0 - cb[64 * mid + 63] >= SKIP_LOG2) hi2 = mid; else lo = mid + 1; }
            ((int*)(ws + WS_T0))[bh * 32 + qb] = lo & ~1; }
        __syncthreads();
    }
}

__device__ __forceinline__ void combine_phase(Frame& F, int L, const bf16* O1, const bf16* O2, bf16* On) {
    const CAS Args& A = *F.a; const int gw = F.vcu * NWAVES + F.wave, NGW = F.G * NWAVES;
    const float lam_init = (L == 0) ? 0.2f : 0.35550906759096924f;
    const float* lp = A.in[5] + L * 4 * 64;
    const float s1 = wave_sum(lp[F.lane] * lp[64 + F.lane]), s2 = wave_sum(lp[128 + F.lane] * lp[192 + F.lane]);
    const float lam = expf(s1) - expf(s2) + lam_init;
    const float* gp = A.in[6] + L * 128 + 16 * (F.lane & 7);
    const f32x4 g0 = *(const f32x4*)gp, g1 = *(const f32x4*)(gp + 4), g2 = *(const f32x4*)(gp + 8), g3 = *(const f32x4*)(gp + 12);
    const float post = 1.0f - lam_init;
#define CB(k, aw, bw) o[2 * (k)] = __builtin_bit_cast(float, (aw) << 16) - lam * __builtin_bit_cast(float, (bw) << 16); o[2 * (k) + 1] = __builtin_bit_cast(float, (aw) & 0xffff0000u) - lam * __builtin_bit_cast(float, (bw) & 0xffff0000u);
#define CROW(off, a0, a1, b0, b1) { float o[16]; \
        CB(0, a0.x, b0.x) CB(1, a0.y, b0.y) CB(2, a0.z, b0.z) CB(3, a0.w, b0.w) CB(4, a1.x, b1.x) CB(5, a1.y, b1.y) CB(6, a1.z, b1.z) CB(7, a1.w, b1.w) \
        float ss = 0.f; _Pragma("unroll") for (int k = 0; k < 16; ++k) ss += o[k] * o[k]; \
        ss += pg8::lane_xor<1>(ss); ss += pg8::lane_xor<2>(ss); ss += pg8::lane_xor<4>(ss); \
        const float rs = __builtin_amdgcn_rsqf(ss * (1.0f / 128.0f) + 1e-6f) * post; v4u w0, w1; \
        w0.x = pk2(o[0] * rs * g0.x, o[1] * rs * g0.y); w0.y = pk2(o[2] * rs * g0.z, o[3] * rs * g0.w); w0.z = pk2(o[4] * rs * g1.x, o[5] * rs * g1.y); w0.w = pk2(o[6] * rs * g1.z, o[7] * rs * g1.w); \
        w1.x = pk2(o[8] * rs * g2.x, o[9] * rs * g2.y); w1.y = pk2(o[10] * rs * g2.z, o[11] * rs * g2.w); w1.z = pk2(o[12] * rs * g3.x, o[13] * rs * g3.y); w1.w = pk2(o[14] * rs * g3.z, o[15] * rs * g3.w); \
        *(GAS v4u*)(On + (off)) = w0; *(GAS v4u*)(On + (off) + 8) = w1; }
    for (int r0 = gw; r0 < T; r0 += 2 * NGW) {
        const int r1 = (r0 + NGW < T) ? r0 + NGW : r0;
        const size_t off0 = (size_t)r0 * D + 16 * F.lane, off1 = (size_t)r1 * D + 16 * F.lane;
        const v4u a0 = *(const GAS v4u*)(O1 + off0), a1 = *(const GAS v4u*)(O1 + off0 + 8), b0 = *(const GAS v4u*)(O2 + off0), b1 = *(const GAS v4u*)(O2 + off0 + 8);
        const v4u c0 = *(const GAS v4u*)(O1 + off1), c1 = *(const GAS v4u*)(O1 + off1 + 8), d0 = *(const GAS v4u*)(O2 + off1), d1 = *(const GAS v4u*)(O2 + off1 + 8);
        CROW(off0, a0, a1, b0, b1)
        if (r1 != r0) CROW(off1, c0, c1, d0, d1)
    }
#undef CROW
#undef CB
}

__device__ __forceinline__ void final_phase(Frame& F, const bf16* hb, float* out) {
    const CAS Args& A = *F.a; const int gw = F.vcu * NWAVES + F.wave, NGW = F.G * NWAVES;
    const GAS f32x4* gp = (const GAS f32x4*)A.in[20] + 4 * F.lane;
    const f32x4 g0 = gp[0], g1 = gp[1], g2 = gp[2], g3 = gp[3];
#define UB(o, k, w) o[2 * (k)] = __builtin_bit_cast(float, (w) << 16); o[2 * (k) + 1] = __builtin_bit_cast(float, (w) & 0xffff0000u);
#define FROW(off, a0, a1) { float o[16]; UB(o, 0, a0.x) UB(o, 1, a0.y) UB(o, 2, a0.z) UB(o, 3, a0.w) UB(o, 4, a1.x) UB(o, 5, a1.y) UB(o, 6, a1.z) UB(o, 7, a1.w) \
        float s = 0.f; _Pragma("unroll") for (int k = 0; k < 16; ++k) s += o[k] * o[k]; \
        const float rs = 1.0f / sqrtf(wave_sum(s) * (1.0f / D) + 1e-6f); GAS f32x4* op = (GAS f32x4*)(out + (off)); \
        op[0] = (f32x4){o[0] * rs * g0.x, o[1] * rs * g0.y, o[2] * rs * g0.z, o[3] * rs * g0.w}; op[1] = (f32x4){o[4] * rs * g1.x, o[5] * rs * g1.y, o[6] * rs * g1.z, o[7] * rs * g1.w}; \
        op[2] = (f32x4){o[8] * rs * g2.x, o[9] * rs * g2.y, o[10] * rs * g2.z, o[11] * rs * g2.w}; op[3] = (f32x4){o[12] * rs * g3.x, o[13] * rs * g3.y, o[14] * rs * g3.z, o[15] * rs * g3.w}; }
    for (int m0 = gw; m0 < T; m0 += 2 * NGW) {
        const int m1 = (m0 + NGW < T) ? m0 + NGW : m0;
        const size_t off0 = (size_t)m0 * D + 16 * F.lane, off1 = (size_t)m1 * D + 16 * F.lane;
        const v4u a0 = *(const GAS v4u*)(hb + off0), a1 = *(const GAS v4u*)(hb + off0 + 8), b0 = *(const GAS v4u*)(hb + off1), b1 = *(const GAS v4u*)(hb + off1 + 8);
        FROW(off0, a0, a1)
        if (m1 != m0) FROW(off1, b0, b1)
    }
#undef FROW
#undef UB
}

template <bool BIAS> __device__ __forceinline__ void attn_phase(Frame& F, const bf16* Q, const bf16* K, const bf16* V, bf16* O1, bf16* O2, const float* ck, unsigned* qctr, const int* t0tab) {
    using abf = attn_body::bf16;
    if constexpr (BIAS) {
        volatile LAS unsigned* uw = (volatile LAS unsigned*)(F.lds + RING_BYTES + 128);
        unsigned mine = 0u; if (threadIdx.x == 0) mine = __hip_atomic_fetch_add(qctr, 1u, __ATOMIC_RELAXED, __HIP_MEMORY_SCOPE_AGENT);
        for (;;) {
            if (threadIdx.x == 0) *uw = mine;
            __syncthreads();
            const int u = (int)__builtin_amdgcn_readfirstlane(*uw);
            if (u >= BATCH * 16 * 32) break;
            if (threadIdx.x == 0) mine = __hip_atomic_fetch_add(qctr, 1u, __ATOMIC_RELAXED, __HIP_MEMORY_SCOPE_AGENT);
            const int qb = 31 - (u >> 6), bhv = u & 63, b = bhv >> 4, h = bhv & 15;
            const float* cb = ck + (size_t)bhv * SEQ;
            const int t0 = __builtin_amdgcn_readfirstlane(t0tab[bhv * 32 + qb]);
            attn_body::attn_unit<8, true>(b, h * 64, h * 64, h * 64, h * 64, qb, (const abf*)Q, (const abf*)K, (const abf*)V, (abf*)O1, cb, (char*)F.lds, t0);
        }
    } else {
        const int nslot = BATCH * 16 * 8;
        for (int sl = F.vcu; sl < nslot; sl += F.G) { const int bhv = sl >> 3, s = sl & 7;
            for (int k = 0; k < 4; ++k) { const int qb = (k == 0) ? s : (k == 1) ? 15 - s : (k == 2) ? 16 + s : 31 - s;
                const int b = bhv >> 4, hc = bhv & 15;
                attn_body::attn_unit_dv<8>(b, hc * 64, hc * 64, (hc >> 1) * 128, (hc >> 1) * 128, qb, (const abf*)Q, (const abf*)K, (const abf*)V, (abf*)((hc & 1) ? O2 : O1), (char*)F.lds); }
        }
    }
}

#define XB_TMO      128
#define XB_XCNT(j)  (256  + 64 * (j))
#define XB_XSUB(j)  (1280 + 64 * (j))
#define XB_XGEN(j)  (2304 + 64 * (j))
#define XB_TOP      3328
#define XB_TOPGEN   3392
#define XCD_BAR_WORDS 3456
#define XB_SPIN_CAP (1u << 18)

__device__ __forceinline__ unsigned xb_ld(unsigned* p)              { return __hip_atomic_load(p, __ATOMIC_RELAXED, __HIP_MEMORY_SCOPE_AGENT); }
__device__ __forceinline__ unsigned xb_add(unsigned* p, unsigned v) { return __hip_atomic_fetch_add(p, v, __ATOMIC_RELAXED, __HIP_MEMORY_SCOPE_AGENT); }
__device__ __forceinline__ unsigned xb_xcc_id() { return (unsigned)__builtin_amdgcn_s_getreg((3 << 11) | 20) & 0xFu; }
#define XB_SPIN(cond, bar) do { unsigned _sp = 0; while (cond) { __builtin_amdgcn_s_sleep(1); \
    if ((++_sp & 255u) == 0u) { if (xb_ld(&(bar)[XB_TMO])) break; if (_sp > XB_SPIN_CAP) { atomicAdd(&(bar)[XB_TMO], 1u); break; } } } } while (0)

struct XcdBarrier {
    unsigned* bar; unsigned x;
    volatile LAS unsigned* st;
};

__device__ __forceinline__ XcdBarrier xcd_barrier_post(unsigned* bar, volatile LAS unsigned* st) {
    XcdBarrier b; b.bar = bar; b.x = xb_xcc_id(); b.st = st;
    if (threadIdx.x == 0) (void)xb_add(&bar[XB_XCNT(b.x)], 1u);
    return b;
}
__device__ __forceinline__ void xcd_barrier_complete(unsigned* bar, unsigned x, unsigned& nloc, unsigned& nx) {
    const unsigned G = gridDim.x * gridDim.y * gridDim.z;
    unsigned sum, cnt, mine, sp = 0u;
    for (;;) {
        sum = 0u; cnt = 0u; mine = 0u;
#pragma unroll
        for (unsigned j = 0; j < 16; ++j) { const unsigned c = xb_ld(&bar[XB_XCNT(j)]); sum += c; cnt += (c > 0u) ? 1u : 0u; mine = (j == x) ? c : mine; }
        if (sum == G) break;
        __builtin_amdgcn_s_sleep(1);
        if ((++sp & 255u) == 0u) { if (xb_ld(&bar[XB_TMO])) break; if (sp > XB_SPIN_CAP) { atomicAdd(&bar[XB_TMO], 1u); break; } }
    }
    nloc = mine > 0u ? mine : 1u; nx = cnt > 0u ? cnt : 1u;
}

__device__ __forceinline__ void xcd_barrier(const XcdBarrier& b) {
    asm volatile("s_waitcnt vmcnt(0)" ::: "memory");
    __syncthreads();
    if (threadIdx.x == 0) {
        unsigned* bar = b.bar;
        __builtin_amdgcn_s_waitcnt(0);
        unsigned nloc = b.st[0], nx = b.st[1];
        if (nloc == 0u) { xcd_barrier_complete(bar, b.x, nloc, nx); b.st[0] = nloc; b.st[1] = nx; }
        const unsigned old = xb_add(&bar[XB_XSUB(b.x)], 1u);
        const unsigned gen = old / nloc;
        if (old + 1u == (gen + 1u) * nloc) {
            __builtin_amdgcn_fence(__ATOMIC_RELEASE, "agent");
            asm volatile("s_waitcnt vmcnt(0)" ::: "memory");
            const unsigned og = xb_add(&bar[XB_TOP], 1u);
            const unsigned tg = og / nx;
            if (og + 1u == (tg + 1u) * nx) xb_add(&bar[XB_TOPGEN], 1u);
            else XB_SPIN(xb_ld(&bar[XB_TOPGEN]) == tg, bar);
            __builtin_amdgcn_fence(__ATOMIC_ACQUIRE, "agent");
            xb_add(&bar[XB_XGEN(b.x)], 1u);
            asm volatile("s_waitcnt vmcnt(0)" ::: "memory");
        } else {
            XB_SPIN(xb_ld(&bar[XB_XGEN(b.x)]) == gen, bar);
            __builtin_amdgcn_fence(__ATOMIC_ACQUIRE, "agent");
            asm volatile("s_waitcnt vmcnt(0)" ::: "memory");
        }
    }
    __syncthreads();
}

constexpr size_t WS_CTL = 0, CTL_ZERO_BYTES = 16384;
constexpr int LDSCTL_OFF = RING_BYTES;
__global__ void __launch_bounds__(NWAVES * 64, 2) yoco_fwd(Args args) {
    extern __shared__ __attribute__((aligned(16))) unsigned char lds[];
    cg::grid_group grid = cg::this_grid();
    using pg8::Gemm; using pg8::StaticOrder; using pg8::EpiQKV; using pg8::EpiRes; using pg8::EpiBf; using pg8::gemm_phase;
    const size_t E64 = 64 * MiB / 2;
    const int ph_lo = args.ph_lo, ph_hi = args.ph_hi;
    if (threadIdx.x < 64) ((LAS unsigned*)((LAS unsigned char*)lds + LDSCTL_OFF))[threadIdx.x] = 0u;
    __syncthreads();
    if (ph_hi - ph_lo > 1 && threadIdx.x == 0) (void)xb_add((unsigned*)(args.ws + WS_CTL) + XB_XCNT(xb_xcc_id()), 1u);
    if (ph_lo == 0) {
        const CAS Args* ap = (const CAS Args*)__builtin_amdgcn_kernarg_segment_ptr(); asm volatile("" : "+s"(ap));
        Frame F; F.a = ap; F.lds = (LAS unsigned char*)lds;
        { int t_ = threadIdx.x; asm volatile("" : "+v"(t_)); F.tid = t_; F.lane = t_ & 63; F.wave = __builtin_amdgcn_readfirstlane(t_ >> 6); }
        int bx = blockIdx.x, G_ = gridDim.x; asm volatile("" : "+s"(bx), "+s"(G_)); F.G = G_; F.vcu = (G_ % 8 == 0) ? (bx % 8) * (G_ / 8) + bx / 8 : bx;
        p0_prologue(F);
    }
    for (int ph = ph_lo; ph < ph_hi; ++ph) {
        const CAS Args* ap = (const CAS Args*)__builtin_amdgcn_kernarg_segment_ptr(); asm volatile("" : "+s"(ap));
        Frame F; F.a = ap; F.lds = (LAS unsigned char*)lds;
#define FRESH_TID() do { int t_ = threadIdx.x; asm volatile("" : "+v"(t_)); F.tid = t_; F.lane = t_ & 63; F.wave = __builtin_amdgcn_readfirstlane(t_ >> 6); } while (0)
        int bx = blockIdx.x, G_ = gridDim.x; asm volatile("" : "+s"(bx), "+s"(G_)); F.G = G_; F.vcu = (G_ % 8 == 0) ? (bx % 8) * (G_ / 8) + bx / 8 : bx;
        const int code = ap->prog[ph], kind = code & 255, L = (code >> 8) & 255, hf = (code >> 16) & 1, w2 = (code >> 17) & 1, full = (code >> 18) & 1;
        const int MH = full ? T : TH;
        unsigned char* ws = ap->ws; LAS unsigned char* ring = F.lds;
        float* rowss = (float*)(ws + WS_ROWSS); bf16* OA1 = (bf16*)ap->out; bf16* OA2 = OA1 + (size_t)T * D;
        bf16* hbX = (bf16*)(ws + WS_HBX); bf16* hbY = (bf16*)(ws + WS_HBY); bf16* R1 = (bf16*)(ws + WS_R1);
        int conv = -1;
#if PROBE_MASK
        const unsigned long long pt0 = __builtin_amdgcn_s_memrealtime();
#endif
        switch (kind) {
        case K_PRO: conv = 0; break;
        case K_QKVA: { Gemm g{hbX, (bf16*)(ws + W_QKV), T, 3 * D, D}; StaticOrder S; S.init(T, 3 * D, F.G, bx);
            EpiQKV<0> E{R1, (long long)(64 * MiB), (long long)(128 * MiB), rowss + (size_t)((3 * L) & 3) * T * 16, (const float*)(ws + WS_CS), nullptr, nullptr};
            gemm_phase<EpiQKV<0>, StaticOrder, PG8_ALIGN, PG8_SP2>(ring, g, S, E); } break;
        case K_ATTA: attn_phase<false>(F, R1, R1 + E64, R1 + 2 * E64, OA1, OA2, nullptr, nullptr, nullptr); break;
        case K_COMB: FRESH_TID(); combine_phase(F, L, OA1, OA2, R1 + 3 * E64); break;
        case K_QKVB: { const int N = (L == 2) ? 3 * D + 256 : D; Gemm g{hbX, (bf16*)(ws + W_QKV), T, N, D}; StaticOrder S; S.init(T, N, F.G, bx);
            EpiQKV<1> E{R1, (long long)((unsigned long long)OA1 - (unsigned long long)R1), (long long)((unsigned long long)OA2 - (unsigned long long)R1), rowss + (size_t)((3 * L) & 3) * T * 16, nullptr, (float*)(ws + WS_FLOG), ap->in[10]};
            gemm_phase<EpiQKV<1>, StaticOrder, PG8_ALIGN, PG8_SP2>(ring, g, S, E); } break;
        case K_SCAN: FRESH_TID(); scan_phase(F); break;
        case K_ATTB: attn_phase<true>(F, R1, OA1, OA2, R1, nullptr, (const float*)(ws + WS_CK), (unsigned*)(ws + WS_CTL) + 3584 + 64 * (L - 2), (const int*)(ws + WS_T0)); break;
        case K_RES: {
            Gemm g{w2 ? R1 : (L < 2 ? R1 + 3 * E64 : R1), (bf16*)(ws + (w2 ? W_2 : W_O)), w2 ? MH : T, D, w2 ? FF : D}; StaticOrder S; S.init(g.M, D, F.G, bx);
            EpiRes<0> E{hbX, w2 ? hbY : hbX, rowss + (size_t)((3 * L + 1 + w2) & 3) * T * 16, nullptr, nullptr, w2 ? hf * TH : 0};
            gemm_phase<EpiRes<0>, StaticOrder, PG8_ALIGN, PG8_SP2>(ring, g, S, E);
            if (!w2) { FRESH_TID(); convert_p(F, L, hbY); } } break;
        case K_W1: { { Gemm g{hbX + (size_t)hf * TH * D, (bf16*)(ws + W_1), MH, FF, D}; StaticOrder S; S.init(MH, FF, F.G, bx);
                EpiBf<1> E{R1, FF, rowss + (size_t)((3 * L + 1) & 3) * T * 16, hf * TH};
                gemm_phase<EpiBf<1>, StaticOrder, PG8_ALIGN, PG8_SP2>(ring, g, S, E); }
            if (hf == 0) { Gemm g2{hbY, (bf16*)(ws + W_PLE), T, D, PLE}; StaticOrder S2; S2.init(T, D, F.G, bx);
                EpiBf<0> E2{(bf16*)(ws + WS_PL), D, nullptr, 0};
                gemm_phase<EpiBf<0>, StaticOrder, PG8_ALIGN, PG8_SP2>(ring, g2, S2, E2); } } break;
        case K_GATE: { Gemm g{hbY, (bf16*)(ws + W_G + (size_t)(L & 1) * 2 * MiB), T, D, D}; StaticOrder S; S.init(T, D, F.G, bx);
            EpiRes<1> E{hbY, hbX, rowss + (size_t)((3 * L + 3) & 3) * T * 16, rowss + (size_t)((3 * L + 2) & 3) * T * 16, (const bf16*)(ws + WS_PL), 0};
            gemm_phase<EpiRes<1>, StaticOrder, PG8_ALIGN, PG8_SP2>(ring, g, S, E);
            if (L + 1 < DEPTH) conv = L + 1; } break;
        default: FRESH_TID(); final_phase(F, hbX, ap->out); break;
        }
        if (conv >= 0) { FRESH_TID(); convert_layer(F, conv); }
#if PROBE_MASK
        if ((PROBE_MASK >> kind) & 1) { const unsigned long long pt1 = __builtin_amdgcn_s_memrealtime(); while (__builtin_amdgcn_s_memrealtime() - pt1 < pt1 - pt0) __builtin_amdgcn_s_sleep(8); }
#endif
        if (ph + 1 < ph_hi) {
            if (ph_hi < 0) grid.sync();
            else { XcdBarrier xb; xb.bar = (unsigned*)(ap->ws + WS_CTL); xb.x = xb_xcc_id(); xb.st = (volatile LAS unsigned*)((LAS unsigned char*)lds + LDSCTL_OFF + 32); xcd_barrier(xb); }
        }
    }
}

static void build_prog(int* prog) {
    int n = 0; prog[n++] = K_PRO;
    for (int L = 0; L < DEPTH; ++L) {
        if (L < 2) { prog[n++] = K_QKVA | L << 8; prog[n++] = K_ATTA | L << 8; prog[n++] = K_COMB | L << 8; }
        else { prog[n++] = K_QKVB | L << 8; if (L == 2) prog[n++] = K_SCAN | L << 8; prog[n++] = K_ATTB | L << 8; }
        prog[n++] = K_RES | L << 8;
        prog[n++] = K_W1 | L << 8 | 1 << 18; prog[n++] = K_RES | L << 8 | 1 << 17 | 1 << 18;
        prog[n++] = K_GATE | L << 8;
    }
    prog[n++] = K_FIN;
    if (n != N_PHASES) fprintf(stderr, "build_prog: %d phases, N_PHASES %d\n", n, N_PHASES);
    while (n < N_PHASES + 1) prog[n++] = K_FIN;
}

extern "C" void kernel_launch(void* const* d_in, const int* in_sizes, int n_in, void* d_out, int out_size, void* d_ws, size_t ws_size, hipStream_t stream) {
    static int grid = 0;
    if (grid == 0) {
        if (n_in != 21 || out_size != T * D || ws_size < WS_END) { fprintf(stderr, "kernel_launch: unexpected problem (n_in %d out %d ws %zu)\n", n_in, out_size, ws_size); grid = -1; return; }
        int dev = 0, cus = 0, per_cu = 0;
        if (hipGetDevice(&dev) != hipSuccess || hipDeviceGetAttribute(&cus, hipDeviceAttributeMultiprocessorCount, dev) != hipSuccess) { grid = -1; return; }
        if (hipFuncSetAttribute((const void*)yoco_fwd, hipFuncAttributeMaxDynamicSharedMemorySize, LDS_BYTES) != hipSuccess) { fprintf(stderr, "kernel_launch: hipFuncSetAttribute failed\n"); grid = -1; return; }
        if (hipOccupancyMaxActiveBlocksPerMultiprocessor(&per_cu, (const void*)yoco_fwd, NWAVES * 64, LDS_BYTES) != hipSuccess || per_cu < 1) { fprintf(stderr, "kernel_launch: occupancy query says %d\n", per_cu); per_cu = 1; }
        (void)hipGetLastError();
        grid = cus;
    }
    if (grid < 0) return;
    Args a{};
    for (int i = 0; i < 21; ++i) a.in[i] = (const float*)d_in[i];
    a.out = (float*)d_out; a.ws = (unsigned char*)d_ws;
    for (int j = 0; j < 8; ++j) { const float p = powf(500000.0f, (float)(2 * j) / 16.0f); a.inv_freq[j] = 1.0f / p; }
    build_prog(a.prog);
#if MK_SPLIT
    for (int p = 0; p < N_PHASES; ++p) { a.ph_lo = p; a.ph_hi = p + 1; hipLaunchKernelGGL(yoco_fwd, dim3(grid), dim3(NWAVES * 64), LDS_BYTES, stream, a); }
#else
    a.ph_lo = 0; a.ph_hi = N_PHASES;
    (void)hipMemsetAsync((char*)d_ws + WS_CTL, 0, CTL_ZERO_BYTES, stream);
    void* kargs[] = {&a};
    const hipError_t e = hipLaunchCooperativeKernel((const void*)yoco_fwd, dim3(grid), dim3(NWAVES * 64), kargs, LDS_BYTES, stream);
    if (e != hipSuccess) fprintf(stderr, "kernel_launch: cooperative launch failed: %s (grid %d)\n", hipGetErrorString(e), grid);
#endif
}
```

```cpp
#include <hip/hip_runtime.h>
#include <cstdio>
#include <cstdint>
namespace pg8 {
#define PG8_LAS __attribute__((address_space(3)))
typedef unsigned short bf16_t;
typedef short bf16x8 __attribute__((ext_vector_type(8)));
typedef float f32x4 __attribute__((ext_vector_type(4)));
typedef unsigned u32x4 __attribute__((ext_vector_type(4)));
constexpr int BM = 256, BK = 64, HALF = 128, HTB = HALF * BK * 2  , STAGE_BYTES = 8 * HTB, NXCD = 8, WGM = 8;

__host__ __device__ __forceinline__ int lds_byte(int r, int c) { const int st = (r >> 4) * 2 + (c >> 5), rr = r & 15, cc = c & 31, ob = rr * 64 + cc * 2; return st * 1024 + (ob ^ (((ob >> 9) & 1) << 5)); }
__host__ __device__ __forceinline__ void stage_rc(int b, int& R, int& C) { const int st = b / 1024, sb = b % 1024, swz = sb ^ (((sb >> 9) & 1) << 5); R = (st >> 1) * 16 + swz / 64; C = (st & 1) * 32 + (swz % 64) / 2; }
__host__ __device__ __forceinline__ int perm32(int rho) { const int n = rho >> 4, i = rho & 15; return 8 * (i >> 2) + 4 * n + (i & 3); }

struct Unit { int pm, pn; };
struct Gemm { const bf16_t* A; const bf16_t* Bt; int M, N, K; };

struct StaticOrder {
    int nM, nN, nwg, G, c;
    __host__ __device__ void init(int M, int N, int G_, int c_) { nM = M / BM; nN = N / BM; nwg = nM * nN; G = G_; c = c_; }
    __host__ __device__ bool next(int i, Unit& u) const {
        const long L = (long)i * G + c; if (L >= nwg) return false;
        int wgid = (int)L; { const int q = nwg / NXCD, r = nwg % NXCD, xcd = wgid % NXCD, off = wgid / NXCD; wgid = (xcd < r ? xcd * (q + 1) : r * (q + 1) + (xcd - r) * q) + off; }
        const int nig = WGM * nN, gid = wgid / nig, fm = gid * WGM, gsz = (nM - fm) < WGM ? (nM - fm) : WGM;
        u.pm = fm + ((wgid % nig) % gsz); u.pn = (wgid % nig) / gsz; return true;
    }
    __device__ __forceinline__ void a_ready(const Unit&) const {}
    __device__ __forceinline__ void done(const Unit&) const {}
};

__device__ __forceinline__ unsigned cvt_pk_bf16(float lo, float hi) { unsigned r; asm volatile("v_cvt_pk_bf16_f32 %0, %1, %2" : "=v"(r) : "v"(lo), "v"(hi)); return r; }
typedef float f32x2 __attribute__((ext_vector_type(2)));
template <int M> __device__ __forceinline__ float lane_xor(float v) { return __builtin_bit_cast(float, __builtin_amdgcn_ds_swizzle(__builtin_bit_cast(int, v), 0x1f | (M << 10))); }
__device__ __forceinline__ float half_sum(float v) { auto rr = __builtin_amdgcn_permlane32_swap(__float_as_uint(v), __float_as_uint(v), false, false); return __uint_as_float(rr[0]) + __uint_as_float(rr[1]); }
typedef float f32x2 __attribute__((ext_vector_type(2)));
typedef unsigned u32x2 __attribute__((ext_vector_type(2)));
constexpr float QK_C2 = 0.125f * 1.4426950408889634f;
__device__ __forceinline__ float rstd_of(const float* rowss, int row) { const f32x4* p = (const f32x4*)(rowss + (size_t)row * 16); const f32x4 a = p[0], b = p[1], c = p[2], d = p[3];
    const float s = (((a[0] + a[1]) + (a[2] + a[3])) + ((b[0] + b[1]) + (b[2] + b[3]))) + (((c[0] + c[1]) + (c[2] + c[3])) + ((d[0] + d[1]) + (d[2] + d[3]))); return __builtin_amdgcn_rsqf(s * (1.0f / 1024.0f) + 1e-6f); }
__device__ __forceinline__ f32x4 rstd_pre(const float* rowss, int row, int fq) { return *(const f32x4*)(rowss + (size_t)row * 16 + 4 * fq); }
__device__ __forceinline__ float rstd_fin(const f32x4 p) { float s = (p[0] + p[1]) + (p[2] + p[3]); s += lane_xor<16>(s); s = half_sum(s); return __builtin_amdgcn_rsqf(s * (1.0f / 1024.0f) + 1e-6f); }
__device__ __forceinline__ float bf2f(unsigned short b) { return __builtin_bit_cast(float, (unsigned)b << 16); }

template <int ACT  > struct EpiBf {
    static constexpr bool PERM = true, AFTER_DRAIN = false;
    bf16_t* O; int ldc; const float* rowss; int row_off;
    __device__ __forceinline__ void operator()(const f32x4 (&acc)[2][2][4][2], const Unit& u, int wr, int wc, int fr, int fq) const {
        const int row0 = u.pm * BM + wr * 64 + fr, col0 = u.pn * BM + wc * 32 + 8 * fq;
        f32x4 rp[2][4];
        if (rowss) {
#pragma unroll
            for (int ai = 0; ai < 2; ++ai)
#pragma unroll
                for (int m = 0; m < 4; ++m) rp[ai][m] = rstd_pre(rowss, row_off + row0 + ai * HALF + m * 16, fq); }
#pragma unroll
        for (int ai = 0; ai < 2; ++ai)
#pragma unroll
            for (int m = 0; m < 4; ++m) { const int rl = row0 + ai * HALF + m * 16; const float rs = rowss ? rstd_fin(rp[ai][m]) : 1.0f; bf16_t* rowp = O + (size_t)rl * ldc + col0;
#pragma unroll
                for (int bj = 0; bj < 2; ++bj) { f32x4 v0 = acc[ai][bj][m][0] * rs, v1 = acc[ai][bj][m][1] * rs;
                    if (ACT == 1) {
#pragma unroll
                        for (int i = 0; i < 4; ++i) { const float a = __builtin_fmaxf(v0[i], 0.f), b = __builtin_fmaxf(v1[i], 0.f); v0[i] = a * a; v1[i] = b * b; } }
                    u32x4 w; w.x = cvt_pk_bf16(v0[0], v0[1]); w.y = cvt_pk_bf16(v0[2], v0[3]); w.z = cvt_pk_bf16(v1[0], v1[1]); w.w = cvt_pk_bf16(v1[2], v1[3]);
                    *(u32x4*)(rowp + bj * HALF) = w; } }
    }
};

template <int MODE> struct EpiQKV {
    static constexpr bool PERM = true, AFTER_DRAIN = false;
    bf16_t* O; long long offK, offV; const float* rowss; const float* cs; float* flog; const float* bfg;
    __device__ __forceinline__ void operator()(const f32x4 (&acc)[2][2][4][2], const Unit& u, int wr, int wc, int fr, int fq) const {
        const int colt = u.pn * BM, t = colt >> 10, cl = colt & 1023;
        const int row0 = u.pm * BM + wr * 64 + fr;
        f32x4 rp[2][4];
#pragma unroll
        for (int ai = 0; ai < 2; ++ai)
#pragma unroll
            for (int m = 0; m < 4; ++m) rp[ai][m] = rstd_pre(rowss, row0 + ai * HALF + m * 16, fq);
        float rsv[2][4];
#pragma unroll
        for (int ai = 0; ai < 2; ++ai)
#pragma unroll
            for (int m = 0; m < 4; ++m) rsv[ai][m] = rstd_fin(rp[ai][m]);
        if (MODE == 1 && t == 3) {
            if (wc == 0 && fq < 2) {
                const f32x4 b0 = *(const f32x4*)(bfg + 8 * fq), b1 = *(const f32x4*)(bfg + 8 * fq + 4);
#pragma unroll
                for (int ai = 0; ai < 2; ++ai)
#pragma unroll
                    for (int m = 0; m < 4; ++m) { const int row = row0 + ai * HALF + m * 16; const float rs = rsv[ai][m];
                        f32x4 v0 = acc[ai][0][m][0] * rs + b0, v1 = acc[ai][0][m][1] * rs + b1;
#pragma unroll
                        for (int i = 0; i < 4; ++i) { v0[i] = __builtin_fminf(v0[i], 0.f) - __logf(1.0f + __expf(-__builtin_fabsf(v0[i]))); v1[i] = __builtin_fminf(v1[i], 0.f) - __logf(1.0f + __expf(-__builtin_fabsf(v1[i])));     }
                        *(f32x4*)(flog + (size_t)row * 16 + 8 * fq) = v0; *(f32x4*)(flog + (size_t)row * 16 + 8 * fq + 4) = v1; }
            }
            return;
        }
        bf16_t* base = (bf16_t*)((char*)O + ((t == 0) ? 0ll : (t == 1) ? offK : offV)); const float sc = (t == 0) ? QK_C2 : 1.0f;
        const bool rope = (MODE == 0) && (t < 2) && !(wc & 1);
        const float sgn = (fq == 0) ? -1.0f : 1.0f;
        const int col0 = cl + wc * 32 + 8 * fq;
#pragma unroll
        for (int ai = 0; ai < 2; ++ai)
#pragma unroll
            for (int m = 0; m < 4; ++m) { const int row = row0 + ai * HALF + m * 16; const float rs = rsv[ai][m]; bf16_t* rowp = base + (size_t)row * 1024 + col0;
                f32x4 c0, c1, s0, s1;
                if (rope) { const float* cp = cs + (size_t)row * 16; c0 = *(const f32x4*)(cp); c1 = *(const f32x4*)(cp + 4); s0 = *(const f32x4*)(cp + 8) * sgn; s1 = *(const f32x4*)(cp + 12) * sgn; }
#pragma unroll
                for (int bj = 0; bj < 2; ++bj) { f32x4 v0 = acc[ai][bj][m][0] * rs, v1 = acc[ai][bj][m][1] * rs;
                    if (rope) { f32x4 p0, p1;
#pragma unroll
                        for (int i = 0; i < 4; ++i) { p0[i] = lane_xor<16>(v0[i]); p1[i] = lane_xor<16>(v1[i]); }
                        const f32x4 r0 = v0 * c0 + p0 * s0, r1 = v1 * c1 + p1 * s1;
                        if (fq < 2) { v0 = r0; v1 = r1; } }
                    v0 = v0 * sc; v1 = v1 * sc;
                    u32x4 w; w.x = cvt_pk_bf16(v0[0], v0[1]); w.y = cvt_pk_bf16(v0[2], v0[3]); w.z = cvt_pk_bf16(v1[0], v1[1]); w.w = cvt_pk_bf16(v1[2], v1[3]);
                    *(u32x4*)(rowp + bj * HALF) = w; } }
    }
};

template <int MODE> struct EpiRes {
    static constexpr bool PERM = true, AFTER_DRAIN = false;
    const bf16_t* res; bf16_t* hb; float* rowss_out; const float* rowss_in; const bf16_t* pl; int row_off;
    static __device__ __forceinline__ void unpack8(const u32x4 w, float (&f)[8]) {
        f[0] = __builtin_bit_cast(float, w.x << 16); f[1] = __builtin_bit_cast(float, w.x & 0xffff0000u); f[2] = __builtin_bit_cast(float, w.y << 16); f[3] = __builtin_bit_cast(float, w.y & 0xffff0000u);
        f[4] = __builtin_bit_cast(float, w.z << 16); f[5] = __builtin_bit_cast(float, w.z & 0xffff0000u); f[6] = __builtin_bit_cast(float, w.w << 16); f[7] = __builtin_bit_cast(float, w.w & 0xffff0000u); }
    __device__ __forceinline__ void operator()(const f32x4 (&acc)[2][2][4][2], const Unit& u, int wr, int wc, int fr, int fq) const {
        const int col0 = u.pn * BM + wc * 32 + 8 * fq, rowb = row_off + u.pm * BM + wr * 64 + fr;
#pragma unroll
        for (int am = 0; am < 4; ++am) { const int ai = am >> 1, mh = (am & 1) * 2;
            u32x4 rw[2][2], pw[2][2]; f32x4 rp[2];
#pragma unroll
            for (int mm = 0; mm < 2; ++mm) { const int rowq = rowb + ai * HALF + (mh + mm) * 16; if (MODE == 1) rp[mm] = rstd_pre(rowss_in, rowq, fq);
#pragma unroll
                for (int bj = 0; bj < 2; ++bj) { const size_t c = (size_t)rowq * 1024 + col0 + bj * HALF; rw[mm][bj] = *(const u32x4*)(res + c); if (MODE == 1) pw[mm][bj] = *(const u32x4*)(pl + c); } }
#pragma unroll
            for (int mm = 0; mm < 2; ++mm) { const int m = mh + mm; const int row = rowb + ai * HALF + m * 16; const size_t off = (size_t)row * 1024 + col0;
                float rs = 0.f; if (MODE == 1) rs = rstd_fin(rp[mm]);
                float ss = 0.f;
#pragma unroll
                for (int bj = 0; bj < 2; ++bj) { float r[8], o[8]; unpack8(rw[mm][bj], r);
                    const f32x4 a0 = acc[ai][bj][m][0], a1 = acc[ai][bj][m][1];
                    if (MODE == 1) { float p[8]; unpack8(pw[mm][bj], p);
#pragma unroll
                        for (int i = 0; i < 4; ++i) { const float g0 = __builtin_amdgcn_rcpf(1.0f + __builtin_amdgcn_exp2f(-a0[i] * rs * 1.4426950408889634f)), g1 = __builtin_amdgcn_rcpf(1.0f + __builtin_amdgcn_exp2f(-a1[i] * rs * 1.4426950408889634f));
                            o[i] = r[i] + p[i] * g0; o[4 + i] = r[4 + i] + p[4 + i] * g1; }
                    } else {
#pragma unroll
                        for (int i = 0; i < 4; ++i) { o[i] = r[i] + a0[i]; o[4 + i] = r[4 + i] + a1[i]; } }
                    u32x4 w; w.x = cvt_pk_bf16(o[0], o[1]); w.y = cvt_pk_bf16(o[2], o[3]); w.z = cvt_pk_bf16(o[4], o[5]); w.w = cvt_pk_bf16(o[6], o[7]);
                    *(u32x4*)(hb + off + bj * HALF) = w;
                    float q[8]; unpack8(w, q);
                    ss += ((q[0] * q[0] + q[1] * q[1]) + (q[2] * q[2] + q[3] * q[3])) + ((q[4] * q[4] + q[5] * q[5]) + (q[6] * q[6] + q[7] * q[7])); }
                ss += lane_xor<16>(ss); ss = half_sum(ss);
                if (fq == 0) rowss_out[(size_t)row * 16 + u.pn * 4 + wc] = ss;
            }
        }
    }
};

template <class Epi, class Sched, bool ALIGN_EPI = false, bool SP2 = false>
__device__ __forceinline__ void gemm_phase(PG8_LAS unsigned char* lds, const Gemm g, const Sched& S, const Epi& E) {
    int tid_ = threadIdx.x; asm volatile("" : "+v"(tid_));
    const int tid = tid_, wid = __builtin_amdgcn_readfirstlane(tid >> 6), lane = tid & 63, wr = wid >> 2, wc = wid & 3, fr = lane & 15, fq = lane >> 4;
    const int K = g.K, nt = K / BK;
    unsigned voffA[2], voffB[2];
#pragma unroll
    for (int i = 0; i < 2; ++i) { int R, C; stage_rc(tid * 16 + i * 8192, R, C); const int Rb = Epi::PERM ? ((R & ~31) + perm32(R & 31)) : R;
        voffA[i] = (unsigned)(R * K + C) * 2u; voffB[i] = (unsigned)(Rb * K + C) * 2u; }
    const size_t kstep = (size_t)(BK * 2);
    const size_t hstep = (size_t)HALF * K * 2;
    const size_t tstep = 2 * hstep;
    const unsigned ldsw = (unsigned)wid * 1024u;
    const int aoff = lds_byte(wr * 64 + fr, fq * 8), boff = lds_byte(wc * 32 + fr, fq * 8);
#define PG8_SA(b, h) (((b) * 2 + (h)) * HTB)
#define PG8_SB(b, h) ((4 + (b) * 2 + (h)) * HTB)
#define PG8_STAGE(bufoff, gbase, voff) do { _Pragma("unroll") for (int _i = 0; _i < 2; ++_i) \
        __builtin_amdgcn_global_load_lds((const unsigned*)((const char*)(gbase) + (voff)[_i]), (PG8_LAS unsigned*)(lds + (bufoff) + ldsw + _i * 8192), 16, 0, 0); } while (0)
#define PG8_LDA(dst, b, h) do { _Pragma("unroll") for (int m = 0; m < 4; ++m) _Pragma("unroll") for (int k = 0; k < 2; ++k) dst[m][k] = *(const PG8_LAS bf16x8*)(lds + PG8_SA(b, h) + aoff + m * 2048 + k * 1024); } while (0)
#define PG8_LDB(dst, b, h) do { _Pragma("unroll") for (int n = 0; n < 2; ++n) _Pragma("unroll") for (int k = 0; k < 2; ++k) dst[n][k] = *(const PG8_LAS bf16x8*)(lds + PG8_SB(b, h) + boff + n * 2048 + k * 1024); } while (0)
#define PG8_MMA(ai, bj, At, Bt) do { __builtin_amdgcn_s_setprio(1); _Pragma("unroll") for (int m = 0; m < 4; ++m) _Pragma("unroll") for (int n = 0; n < 2; ++n) _Pragma("unroll") for (int k = 0; k < 2; ++k) \
        acc[ai][bj][m][n] = __builtin_amdgcn_mfma_f32_16x16x32_bf16(Bt[n][k], At[m][k], acc[ai][bj][m][n], 0, 0, 0); __builtin_amdgcn_s_setprio(0); } while (0)
#define PG8_WAIT_V(n) asm volatile("s_waitcnt vmcnt(" #n ")" ::: "memory")
#define PG8_WAIT_L(n) asm volatile("s_waitcnt lgkmcnt(" #n ")" ::: "memory")
#define PG8_BAR __builtin_amdgcn_s_barrier()
#define PG8_SCHED __builtin_amdgcn_sched_barrier(0)
    Unit cur, nxt; int ui = 0;
    if (!S.next(0, cur)) return;
    f32x4 acc[2][2][4][2];
#pragma unroll
    for (int a = 0; a < 2; ++a)
#pragma unroll
        for (int b = 0; b < 2; ++b)
#pragma unroll
            for (int m = 0; m < 4; ++m)
#pragma unroll
                for (int n = 0; n < 2; ++n) acc[a][b][m][n] = (f32x4){0.f, 0.f, 0.f, 0.f};
    bf16x8 At[4][2], B0[2][2], B1[2][2];
    const char* cA = (const char*)g.A + (size_t)cur.pm * tstep; const char* cB = (const char*)g.Bt + (size_t)cur.pn * tstep;
    S.a_ready(cur);
    if constexpr (SP2) {
        PG8_STAGE(PG8_SB(0, 0), cB, voffB); PG8_STAGE(PG8_SB(0, 1), cB + hstep, voffB); PG8_STAGE(PG8_SA(0, 0), cA, voffA); PG8_STAGE(PG8_SA(0, 1), cA + hstep, voffA);
        if (wr == 1) PG8_BAR;
        PG8_WAIT_V(2); PG8_BAR;
        PG8_STAGE(PG8_SB(1, 0), cB + kstep, voffB); PG8_STAGE(PG8_SA(1, 0), cA + kstep, voffA); PG8_STAGE(PG8_SB(1, 1), cB + hstep + kstep, voffB);
        PG8_WAIT_V(6); PG8_BAR;
    } else {
        PG8_STAGE(PG8_SB(0, 0), cB, voffB); PG8_STAGE(PG8_SA(0, 0), cA, voffA); PG8_STAGE(PG8_SB(0, 1), cB + hstep, voffB); PG8_STAGE(PG8_SA(0, 1), cA + hstep, voffA);
        if (wr == 1) PG8_BAR;
        PG8_WAIT_V(4); PG8_BAR;
        PG8_STAGE(PG8_SB(1, 0), cB + kstep, voffB); PG8_STAGE(PG8_SA(1, 0), cA + kstep, voffA); PG8_STAGE(PG8_SB(1, 1), cB + hstep + kstep, voffB);
        PG8_WAIT_V(6); PG8_BAR;
    }
    for (;;) {
        const bool has_next = S.next(ui + 1, nxt);
        const char* nA = has_next ? (const char*)g.A + (size_t)nxt.pm * tstep : cA; const char* nB = has_next ? (const char*)g.Bt + (size_t)nxt.pn * tstep : cB;
        for (int t = 0; t < nt; t += 2) {
            const bool last = (t == nt - 2);
            const char* a1 = cA + (size_t)(t + 1) * kstep;
            const char* a2 = last ? nA : cA + (size_t)(t + 2) * kstep; const char* b2 = last ? nB : cB + (size_t)(t + 2) * kstep;
            const char* a3 = a2 + kstep; const char* b3 = b2 + kstep;
            if (last && has_next) S.a_ready(nxt);
            if constexpr (SP2) {
            PG8_LDB(B0, 0, 0); PG8_LDB(B1, 0, 1); PG8_SCHED; PG8_LDA(At, 0, 0); PG8_STAGE(PG8_SA(1, 1), a1 + hstep, voffA);
            PG8_WAIT_V(8); PG8_WAIT_L(0); PG8_BAR; PG8_MMA(0, 0, At, B0); PG8_MMA(0, 1, At, B1); PG8_BAR; PG8_SCHED;
            PG8_LDA(At, 0, 1); PG8_STAGE(PG8_SB(0, 0), b2, voffB); PG8_STAGE(PG8_SB(0, 1), b2 + hstep, voffB); PG8_STAGE(PG8_SA(0, 0), a2, voffA);
            PG8_WAIT_V(8); PG8_WAIT_L(0); PG8_BAR; PG8_MMA(1, 0, At, B0); PG8_MMA(1, 1, At, B1); PG8_BAR; PG8_SCHED;
            PG8_LDB(B0, 1, 0); PG8_LDB(B1, 1, 1); PG8_SCHED; PG8_LDA(At, 1, 0); PG8_STAGE(PG8_SA(0, 1), a2 + hstep, voffA);
            PG8_WAIT_V(8); PG8_WAIT_L(0); PG8_BAR; PG8_MMA(0, 0, At, B0); PG8_MMA(0, 1, At, B1); PG8_BAR; PG8_SCHED;
            PG8_LDA(At, 1, 1); PG8_STAGE(PG8_SB(1, 0), b3, voffB); PG8_STAGE(PG8_SB(1, 1), b3 + hstep, voffB); PG8_STAGE(PG8_SA(1, 0), a3, voffA);
            PG8_WAIT_V(8); PG8_WAIT_L(0); PG8_BAR; PG8_MMA(1, 0, At, B0); PG8_MMA(1, 1, At, B1); PG8_BAR; PG8_SCHED;
            } else {
            PG8_LDB(B0, 0, 0); PG8_SCHED; PG8_LDA(At, 0, 0); PG8_STAGE(PG8_SA(1, 1), a1 + hstep, voffA);
            PG8_WAIT_L(8); PG8_BAR; PG8_WAIT_L(0); PG8_MMA(0, 0, At, B0); PG8_BAR; PG8_SCHED;
            PG8_LDB(B1, 0, 1); PG8_STAGE(PG8_SB(0, 0), b2, voffB);
            PG8_BAR; PG8_WAIT_L(0); PG8_MMA(0, 1, At, B1); PG8_BAR;
            PG8_LDA(At, 0, 1); PG8_STAGE(PG8_SA(0, 0), a2, voffA);
            PG8_BAR; PG8_WAIT_L(0); PG8_MMA(1, 0, At, B0); PG8_BAR; PG8_SCHED;
            PG8_STAGE(PG8_SB(0, 1), b2 + hstep, voffB);
            PG8_WAIT_V(6); PG8_BAR; PG8_MMA(1, 1, At, B1); PG8_BAR;
            PG8_LDB(B0, 1, 0); PG8_SCHED; PG8_LDA(At, 1, 0); PG8_STAGE(PG8_SA(0, 1), a2 + hstep, voffA);
            PG8_WAIT_L(8); PG8_BAR; PG8_WAIT_L(0); PG8_MMA(0, 0, At, B0); PG8_BAR; PG8_SCHED;
            PG8_LDB(B1, 1, 1); PG8_STAGE(PG8_SB(1, 0), b3, voffB);
            PG8_BAR; PG8_WAIT_L(0); PG8_MMA(0, 1, At, B1); PG8_BAR;
            PG8_LDA(At, 1, 1); PG8_STAGE(PG8_SA(1, 0), a3, voffA);
            PG8_BAR; PG8_WAIT_L(0); PG8_MMA(1, 0, At, B0); PG8_BAR; PG8_SCHED;
            PG8_STAGE(PG8_SB(1, 1), b3 + hstep, voffB);
            PG8_WAIT_V(6); PG8_BAR; PG8_MMA(1, 1, At, B1); PG8_BAR;
            }
        }
        if constexpr (ALIGN_EPI) { if (wr == 0) PG8_BAR; }
        if constexpr (!Epi::AFTER_DRAIN) { int te_ = threadIdx.x; asm volatile("" : "+v"(te_)); const int le_ = te_ & 63, we_ = __builtin_amdgcn_readfirstlane(te_ >> 6);
            E(acc, cur, we_ >> 2, we_ & 3, le_ & 15, le_ >> 4); S.done(cur); }
        if (!has_next) break;
#pragma unroll
        for (int a = 0; a < 2; ++a)
#pragma unroll
            for (int b = 0; b < 2; ++b)
#pragma unroll
                for (int m = 0; m < 4; ++m)
#pragma unroll
                    for (int n = 0; n < 2; ++n) acc[a][b][m][n] = (f32x4){0.f, 0.f, 0.f, 0.f};
        cur = nxt; cA = nA; cB = nB; ++ui;
        if constexpr (ALIGN_EPI) { if (wr == 1) PG8_BAR; }
    }
    PG8_WAIT_V(0);
    if constexpr (!ALIGN_EPI) { if (wr == 0) PG8_BAR; }
    PG8_BAR;
    if constexpr (Epi::AFTER_DRAIN) { E.fused(acc, cur, wr, wc, fr, fq, lds, wid, lane); S.done(cur); }
#undef PG8_SA
#undef PG8_SB
#undef PG8_STAGE
#undef PG8_LDA
#undef PG8_LDB
#undef PG8_MMA
#undef PG8_WAIT_V
#undef PG8_WAIT_L
#undef PG8_BAR
#undef PG8_SCHED
}
}

#ifndef PG8_SP2
#define PG8_SP2 true
#endif
#ifndef PG8_ALIGN
#define PG8_ALIGN true
#endif
#include <hip/hip_bf16.h>
#include <cmath>
namespace attn_body {
using bf16=__hip_bfloat16;
using bf16x8=__attribute__((ext_vector_type(8)))short;
using s16x4=__attribute__((ext_vector_type(4)))short;
using f32x16=__attribute__((ext_vector_type(16)))float;
using u32x4=__attribute__((ext_vector_type(4)))unsigned;
constexpr int BATCH=4,NHEAD=16,SEQ=8192,D=64,DM=NHEAD*D;
constexpr int NW=8,QBLK=32,QB=QBLK*NW,KVBLK=64,NQB=SEQ/QB;
constexpr int ATTN_PITCH=DM, ATTN_UNIT_ROWS=QB;
__device__ __forceinline__ int crow(int r,int hi){return (r&3)+8*(r>>2)+4*hi;}
#define SBAR() __builtin_amdgcn_sched_barrier(0)
__device__ __forceinline__ void cmask(f32x16&p0,f32x16&p1,int jb,int qrel,int hi){
  const float NEG=-INFINITY; int kb=64*jb+4*hi;
  #pragma unroll
  for(int r=0;r<16;++r){int kv=kb+(r&3)+8*(r>>2); if(kv>qrel)p0[r]=NEG; if(kv+32>qrel)p1[r]=NEG;}
}

constexpr int NSLOT=3, SLOTB=8192;
constexpr int LDS_K=0, LDS_V=NSLOT*SLOTB, LDS_WS=2*NSLOT*SLOTB, LDS_OST=LDS_WS+NW*64*4, LDS_BIAS=LDS_OST+NW*4096  , LDS_BYTES=LDS_BIAS+32768;
constexpr float C2=0.125f*1.4426950408889634f;
__device__ __forceinline__ void glds16(const void*gsrc,unsigned lds_dst){unsigned keep;
  asm volatile("s_mov_b32 %0, m0\n\ts_mov_b32 m0, %2\n\ts_nop 0\n\tglobal_load_lds_dwordx4 %1, off\n\ts_mov_b32 m0, %0":"=&s"(keep):"v"(gsrc),"s"(lds_dst):"memory");}
__device__ __forceinline__ float max3f(float a,float b,float c){float r;asm("v_max3_f32 %0, %1, %2, %3":"=v"(r):"v"(a),"v"(b),"v"(c));return r;}
__device__ __forceinline__ float max2f(float a,float b){float r;asm("v_max_f32_e32 %0, %1, %2":"=v"(r):"v"(a),"v"(b));return r;}
__device__ __forceinline__ float fadd_s(float a,float b){float r;asm("v_add_f32_e32 %0, %1, %2":"=v"(r):"v"(a),"v"(b));return r;}
__device__ __forceinline__ float fsub_s(float a,float b){float r;asm("v_sub_f32_e32 %0, %1, %2":"=v"(r):"v"(a),"v"(b));return r;}
typedef float f32x2_t __attribute__((ext_vector_type(2))); typedef __bf16 bf16x2_t __attribute__((ext_vector_type(2)));
__device__ __forceinline__ unsigned cvtpk_s(float lo,float hi){f32x2_t v={lo,hi};bf16x2_t b=__builtin_convertvector(v,bf16x2_t);return __builtin_bit_cast(unsigned,b);}
#define WAIT_BAR(N) asm volatile("s_waitcnt vmcnt(" #N ") lgkmcnt(0)\n\ts_barrier":::"memory")

template<bool ACCUM> __device__ __forceinline__ void qkt(f32x16&p0,f32x16&p1,const char*Kslot,const bf16x8*qr,const f32x16&negm,int r32,int hi){
  const char*kb=Kslot+hi*1024+r32*16;
  #pragma unroll
  for(int d0=0;d0<4;++d0){
    const bf16x8 b0=*reinterpret_cast<const bf16x8*>(kb+d0*2048);
    const bf16x8 b1=*reinterpret_cast<const bf16x8*>(kb+d0*2048+512);
    if(d0==0&&!ACCUM){p0=__builtin_amdgcn_mfma_f32_32x32x16_bf16(b0,qr[0],negm,0,0,0);p1=__builtin_amdgcn_mfma_f32_32x32x16_bf16(b1,qr[0],negm,0,0,0);}
    else{p0=__builtin_amdgcn_mfma_f32_32x32x16_bf16(b0,qr[d0],p0,0,0,0);p1=__builtin_amdgcn_mfma_f32_32x32x16_bf16(b1,qr[d0],p1,0,0,0);}}
}
typedef __attribute__((address_space(3))) const char* lds_cptr;
typedef short v4i16_t __attribute__((ext_vector_type(4)));
__device__ __forceinline__ void kload8(bf16x8*kf,lds_cptr kp){
  kf[0]=*(const __attribute__((address_space(3))) bf16x8*)(kp);      kf[1]=*(const __attribute__((address_space(3))) bf16x8*)(kp+512);
  kf[2]=*(const __attribute__((address_space(3))) bf16x8*)(kp+2048); kf[3]=*(const __attribute__((address_space(3))) bf16x8*)(kp+2560);
  kf[4]=*(const __attribute__((address_space(3))) bf16x8*)(kp+4096); kf[5]=*(const __attribute__((address_space(3))) bf16x8*)(kp+4608);
  kf[6]=*(const __attribute__((address_space(3))) bf16x8*)(kp+6144); kf[7]=*(const __attribute__((address_space(3))) bf16x8*)(kp+6656);
}
__device__ __forceinline__ void kload2(bf16x8*kf,lds_cptr kp,int j){ kf[2*j]=*(const __attribute__((address_space(3))) bf16x8*)(kp+j*2048); kf[2*j+1]=*(const __attribute__((address_space(3))) bf16x8*)(kp+j*2048+512); }
__device__ __forceinline__ s16x4 vtr(lds_cptr p){ return __builtin_bit_cast(s16x4,__builtin_amdgcn_ds_read_tr16_b64_v4i16((__attribute__((address_space(3))) v4i16_t*)p)); }
__device__ __forceinline__ float rowmax(const f32x16&p0,const f32x16&p1){
  float a=max3f(p0[0],p0[1],p1[0]),b=max3f(p0[2],p0[3],p1[1]);a=max3f(a,p1[2],p1[3]);
  #pragma unroll
  for(int r=4;r<16;r+=4){a=max3f(a,p0[r],p0[r+1]);b=max3f(b,p0[r+2],p0[r+3]);a=max3f(a,p1[r],p1[r+1]);b=max3f(b,p1[r+2],p1[r+3]);}
  const float m=max2f(a,b);
  auto rr=__builtin_amdgcn_permlane32_swap(__float_as_uint(m),__float_as_uint(m),false,false);
  return max2f(__uint_as_float(rr[0]),__uint_as_float(rr[1]));
}
__device__ __forceinline__ void pv(f32x16*o,int vb,bf16x8 pa0,bf16x8 pa1,bf16x8 pa2,bf16x8 pa3){
  #pragma unroll
  for(int d0=0;d0<2;++d0){s16x4 lo[4],hi[4];
    #pragma unroll
    for(int ks=0;ks<4;++ks){
      asm volatile("ds_read_b64_tr_b16 %0,%1 offset:%c2":"=&v"(lo[ks]):"v"(vb),"i"(d0*4096+ks*1024):"memory");
      asm volatile("ds_read_b64_tr_b16 %0,%1 offset:%c2":"=&v"(hi[ks]):"v"(vb),"i"(d0*4096+ks*1024+512):"memory");}
    asm volatile("s_waitcnt lgkmcnt(0)":::"memory");SBAR();
    #define PK(k) (bf16x8){lo[k][0],lo[k][1],lo[k][2],lo[k][3],hi[k][0],hi[k][1],hi[k][2],hi[k][3]}
    o[d0]=__builtin_amdgcn_mfma_f32_32x32x16_bf16(pa0,PK(0),o[d0],0,0,0);
    o[d0]=__builtin_amdgcn_mfma_f32_32x32x16_bf16(pa1,PK(1),o[d0],0,0,0);
    o[d0]=__builtin_amdgcn_mfma_f32_32x32x16_bf16(pa2,PK(2),o[d0],0,0,0);
    o[d0]=__builtin_amdgcn_mfma_f32_32x32x16_bf16(pa3,PK(3),o[d0],0,0,0);
    #undef PK
  }
}

#ifndef ATTN_STORE16
#define ATTN_STORE16(p,v) (*(u32x4*)(p)=(v))
#endif
typedef float f32x4b __attribute__((ext_vector_type(4)));
__device__ __forceinline__ void binit(f32x16&c0,f32x16&c1,lds_cptr bp,float nm){
  #pragma unroll
  for(int g=0;g<4;++g){ const f32x4b a=*(const __attribute__((address_space(3))) f32x4b*)(bp+g*32); const f32x4b bb=*(const __attribute__((address_space(3))) f32x4b*)(bp+128+g*32);
    #pragma unroll
    for(int i=0;i<4;++i){ c0[4*g+i]=nm-a[i]; c1[4*g+i]=nm-bb[i]; } }
}
__device__ __forceinline__ void bload(f32x16&c0,f32x16&c1,lds_cptr bp){
  #pragma unroll
  for(int g=0;g<4;++g){ const f32x4b a=*(const __attribute__((address_space(3))) f32x4b*)(bp+g*32); const f32x4b bb=*(const __attribute__((address_space(3))) f32x4b*)(bp+128+g*32);
    #pragma unroll
    for(int i=0;i<4;++i){ c0[4*g+i]=a[i]; c1[4*g+i]=bb[i]; } }
}
__device__ __forceinline__ void bfin(f32x16&c0,f32x16&c1,float nm){
  #pragma unroll
  for(int r=0;r<16;++r){ c0[r]=nm-c0[r]; c1[r]=nm-c1[r]; }
}
template<int THRL,bool BIAS> __device__ __forceinline__ void attn_unit(int b,int cq,int ck,int cv,int co,int qb,const bf16*Q,const bf16*__restrict__ K,const bf16*__restrict__ V,bf16*O,const float*cb,char*shm,int t0){
  int tid_=threadIdx.x; asm volatile("":"+v"(tid_)); const int tid=tid_,lane=tid&63,r32=lane&31,hi=lane>>5; const int wid=__builtin_amdgcn_readfirstlane(tid>>6);
  const long rowbase=(long)b*SEQ; const int q0=qb*QB;
  const bf16*Qw=Q+(rowbase+q0+wid*QBLK)*DM+cq;
  const bf16*Kh=K+(rowbase+(long)t0*KVBLK)*DM+ck,*Vh=V+(rowbase+(long)t0*KVBLK)*DM+cv;
  const unsigned lds0=(unsigned)(uintptr_t)shm;
  float*wsf=(float*)(shm+LDS_WS)+wid*64;
  const bf16*ksrc=Kh+(long)lane*DM+wid*8;
  const bf16*vsrc=Vh+(long)(16*(wid&3)+(lane>>2))*DM+(wid>>2)*32+(lane&3)*8;
  const unsigned kdst=lds0+LDS_K+wid*1024, vdst=lds0+LDS_V+wid*1024;
  #define DMA_K(t,slot) glds16(ksrc+(long)(t)*KVBLK*DM,(unsigned)__builtin_amdgcn_readfirstlane(kdst+(slot)))
  #define DMA_V(t,slot) glds16(vsrc+(long)(t)*KVBLK*DM,(unsigned)__builtin_amdgcn_readfirstlane(vdst+(slot)))
  const int vb0=(int)(lds0+LDS_V)+((lane>>4)&1)*32+(lane&3)*8+(4*hi+((lane&15)>>2))*64;
  const char*Kbase=shm+LDS_K; bf16x8 kf[8];
  const lds_cptr shm3=(lds_cptr)shm; const lds_cptr kp0=shm3+LDS_K+hi*1024+r32*16; const lds_cptr vp0=shm3+LDS_V+((lane>>4)&1)*32+(lane&3)*8+(4*hi+((lane&15)>>2))*64;
  const int NT=(q0+QB)/KVBLK-t0;
  float cqv=0.f,nm=0.f; const lds_cptr bp0=shm3+LDS_BIAS+hi*16+t0*256;
  if constexpr(BIAS){ for(int p=(t0>>2)+wid;p<=qb;p+=NW) glds16(cb+p*256+lane*4,(unsigned)__builtin_amdgcn_readfirstlane(lds0+LDS_BIAS+p*1024));
    cqv=cb[q0+wid*QBLK+r32]; }
  DMA_K(0,0);DMA_V(0,0);DMA_K(1,SLOTB);
  bf16x8 qr[4];
  #pragma unroll
  for(int d0=0;d0<4;++d0)qr[d0]=*reinterpret_cast<const bf16x8*>(&Qw[(long)r32*DM+d0*16+hi*8]);
  float mhat=0.f;f32x16 o[2];o[0]=f32x16{};o[1]=f32x16{};f32x16 negm=f32x16{};if constexpr(!BIAS)asm volatile("":"+v"(negm));
  f32x16 lacc=f32x16{}; unsigned ob_; asm volatile("v_mov_b32 %0, 0x3f803f80":"=v"(ob_)); const bf16x8 ones=__builtin_bit_cast(bf16x8,(u32x4){ob_,ob_,ob_,ob_});
  const int qrel=wid*QBLK+r32;
  #define CMASK(P0,P1,t) do{int jb_=(t)-(NT-4); if(jb_>=0)cmask(P0,P1,jb_,qrel,hi);}while(0)
  bool resc=false;
  #define START(P0,P1) do{ const float rm=rowmax(P0,P1); resc=false; \
    { const float dl=BIAS?__builtin_fmaxf(rm,0.f):rm; mhat=fadd_s(mhat,dl); \
      _Pragma("unroll") for(int r=0;r<16;++r){P0[r]=fsub_s(P0[r],dl);P1[r]=fsub_s(P1[r],dl);} \
      if constexpr(BIAS){ nm=cqv-mhat; } else { _Pragma("unroll") for(int r=0;r<16;++r)negm[r]=-mhat; asm volatile("":"+v"(negm)); } } \
    _Pragma("unroll") for(int r=0;r<16;++r)P0[r]=__builtin_amdgcn_exp2f(P0[r]); }while(0)
  #define RESC() do{ if(resc){ asm volatile("s_waitcnt lgkmcnt(0)":::"memory"); \
      _Pragma("unroll") for(int d_=0;d_<2;++d_) _Pragma("unroll") for(int r=0;r<16;++r)o[d_][r]*=wsf[crow(r,hi)]; _Pragma("unroll") for(int r=0;r<16;++r)lacc[r]*=wsf[crow(r,hi)]; } }while(0)
  f32x16 pA0,pA1,pB0,pB1;
  int sl_prev=0,sl_cur=0,sl_next=SLOTB;
  #define ROT() do{sl_prev=sl_cur;sl_cur=sl_next;sl_next=(sl_next==(NSLOT-1)*SLOTB)?0:sl_next+SLOTB;}while(0)
  DMA_K(2,2*SLOTB);
  WAIT_BAR(3);
  if constexpr(BIAS){ nm=cqv; binit(pA0,pA1,bp0,nm); qkt<true>(pA0,pA1,Kbase,qr,negm,r32,hi); } else { qkt<false>(pA0,pA1,Kbase,qr,negm,r32,hi); } asm volatile("s_nop 15\n\ts_nop 7":"+v"(pA0),"+v"(pA1));CMASK(pA0,pA1,0);
  START(pA0,pA1);
  _Pragma("unroll") for(int r=0;r<16;++r)pA1[r]=__builtin_amdgcn_exp2f(pA1[r]);
  if constexpr(BIAS){ binit(pB0,pB1,bp0+256,nm); }
  WAIT_BAR(0);
  DMA_K(3,0);DMA_V(1,SLOTB);
  ROT();
  kload8(kf,kp0+sl_cur);
  WAIT_BAR(2);
  s16x4 vlo[8],vhi[8]; u32x4 pw0,pw1,pw2,pw3;
  #define PKW(P,B) cvtpk_s(P[B],P[B+1])
  #define PAF(k) __builtin_bit_cast(bf16x8,pw##k)
  #define VFR(i) (bf16x8){vlo[i][0],vlo[i][1],vlo[i][2],vlo[i][3],vhi[i][0],vhi[i][1],vhi[i][2],vhi[i][3]}
  #define PIN(x) asm volatile("":"+v"(x))
  #define MX3(a,b,c) __builtin_fmaxf(__builtin_fmaxf((a),(b)),(c))
  #define GAPA(MF,A0,A1,A2,A3,W0,W1,PW) do{ MF; W0; W1; PIN(PW); SBAR(); }while(0)
  #define EX(v) __builtin_amdgcn_exp2f(v)
  #define GAPB(MF,X,B) do{ MF; X[B]=EX(X[B]); X[B+1]=EX(X[B+1]); X[B+2]=EX(X[B+2]); X[B+3]=EX(X[B+3]); PIN(X); SBAR(); }while(0)
  #define VRD(i) do{ vlo[i]=vtr(vp_+(((i)>>2)*4096+((i)&3)*1024)); vhi[i]=vtr(vp_+(((i)>>2)*4096+((i)&3)*1024+512)); }while(0)
  #define KRD(G,j) do{ if(G){ kload2(kf,kp0+sl_next,j); SBAR(); } }while(0)
  #define STEP(C0,C1,P0,P1,t,GK,GV,GL) do{ SBAR(); \
    const lds_cptr vp_=vp0+sl_prev; \
    VRD(0); SBAR(); \
    GAPA(C0=__builtin_amdgcn_mfma_f32_32x32x16_bf16(kf[0],qr[0],BIAS?C0:negm,0,0,0), P0[2],P0[3],P0[4],P0[5],     pw0[0]=PKW(P0,0), pw0[1]=PKW(P0,2), pw0); \
    VRD(4); SBAR(); GAPA(C1=__builtin_amdgcn_mfma_f32_32x32x16_bf16(kf[1],qr[0],BIAS?C1:negm,0,0,0), P0[6],P0[7],P0[8],P0[9],     pw0[2]=PKW(P0,4), pw0[3]=PKW(P0,6), pw0); \
    VRD(1); SBAR(); GAPA(C0=__builtin_amdgcn_mfma_f32_32x32x16_bf16(kf[2],qr[1],C0,0,0,0),   P0[10],P0[11],P0[12],P0[13], pw1[0]=PKW(P0,8), pw1[1]=PKW(P0,10), pw1); \
    VRD(5); SBAR(); GAPA(C1=__builtin_amdgcn_mfma_f32_32x32x16_bf16(kf[3],qr[1],C1,0,0,0),   P0[14],P0[15],P1[0],P1[1],   pw1[2]=PKW(P0,12),pw1[3]=PKW(P0,14), pw1); \
    VRD(2); SBAR(); GAPA(C0=__builtin_amdgcn_mfma_f32_32x32x16_bf16(kf[4],qr[2],C0,0,0,0),   P1[2],P1[3],P1[4],P1[5],     pw2[0]=PKW(P1,0), pw2[1]=PKW(P1,2), pw2); \
    VRD(6); SBAR(); GAPA(C1=__builtin_amdgcn_mfma_f32_32x32x16_bf16(kf[5],qr[2],C1,0,0,0),   P1[6],P1[7],P1[8],P1[9],     pw2[2]=PKW(P1,4), pw2[3]=PKW(P1,6), pw2); \
    VRD(3); SBAR(); GAPA(C0=__builtin_amdgcn_mfma_f32_32x32x16_bf16(kf[6],qr[3],C0,0,0,0),   P1[10],P1[11],P1[12],P1[13], pw3[0]=PKW(P1,8), pw3[1]=PKW(P1,10), pw3); \
    VRD(7); SBAR(); GAPA(C1=__builtin_amdgcn_mfma_f32_32x32x16_bf16(kf[7],qr[3],C1,0,0,0),   P1[14],P1[15],0.f,0.f,       pw3[2]=PKW(P1,12),pw3[3]=PKW(P1,14), pw3); \
    if(GK){DMA_K((t)+3,sl_cur);} if(GV){DMA_V((t)+1,sl_next);} \
    CMASK(C0,C1,t); \
    { float a=MX3(C0[0],C0[1],C1[0]),b=MX3(C0[2],C0[3],C1[1]); a=MX3(a,C1[2],C1[3]); \
      _Pragma("unroll") for(int r=4;r<16;r+=4){a=MX3(a,C0[r],C0[r+1]);b=MX3(b,C0[r+2],C0[r+3]);a=MX3(a,C1[r],C1[r+1]);b=MX3(b,C1[r+2],C1[r+3]);} \
      float rm=__builtin_fmaxf(a,b); { auto rr=__builtin_amdgcn_permlane32_swap(__float_as_uint(rm),__float_as_uint(rm),false,false); rm=__builtin_fmaxf(__uint_as_float(rr[0]),__uint_as_float(rr[1])); } \
      resc=false; \
      if(__builtin_expect(__any(rm>(float)THRL),0)){ const float dl=__builtin_fmaxf(rm,0.f); mhat+=dl; \
        _Pragma("unroll") for(int r=0;r<16;++r){C0[r]-=dl;C1[r]-=dl;} \
        if constexpr(BIAS){ nm=cqv-mhat; } else { _Pragma("unroll") for(int r=0;r<16;++r)negm[r]=-mhat; asm volatile("":"+v"(negm)); } \
        const float f=__builtin_amdgcn_exp2f(-dl); if(hi==0)wsf[r32]=f; resc=true; } } \
    SBAR(); \
    if constexpr(BIAS){ if(GL){ bload(P0,P1,bp0+((t)+1)*256); SBAR(); } } \
    GAPB(o[0]=__builtin_amdgcn_mfma_f32_32x32x16_bf16(PAF(0),VFR(0),o[0],0,0,0), C0,0); \
    GAPB(o[1]=__builtin_amdgcn_mfma_f32_32x32x16_bf16(PAF(0),VFR(4),o[1],0,0,0), C0,4); \
    lacc=__builtin_amdgcn_mfma_f32_32x32x16_bf16(PAF(0),ones,lacc,0,0,0); SBAR(); \
    KRD(GL,0); GAPB(o[0]=__builtin_amdgcn_mfma_f32_32x32x16_bf16(PAF(1),VFR(1),o[0],0,0,0), C0,8); \
    KRD(GL,1); GAPB(o[1]=__builtin_amdgcn_mfma_f32_32x32x16_bf16(PAF(1),VFR(5),o[1],0,0,0), C0,12); \
    lacc=__builtin_amdgcn_mfma_f32_32x32x16_bf16(PAF(1),ones,lacc,0,0,0); SBAR(); \
    KRD(GL,2); GAPB(o[0]=__builtin_amdgcn_mfma_f32_32x32x16_bf16(PAF(2),VFR(2),o[0],0,0,0), C1,0); \
    KRD(GL,3); GAPB(o[1]=__builtin_amdgcn_mfma_f32_32x32x16_bf16(PAF(2),VFR(6),o[1],0,0,0), C1,4); \
    lacc=__builtin_amdgcn_mfma_f32_32x32x16_bf16(PAF(2),ones,lacc,0,0,0); SBAR(); \
    GAPB(o[0]=__builtin_amdgcn_mfma_f32_32x32x16_bf16(PAF(3),VFR(3),o[0],0,0,0), C1,8); \
    GAPB(o[1]=__builtin_amdgcn_mfma_f32_32x32x16_bf16(PAF(3),VFR(7),o[1],0,0,0), C1,12); \
    lacc=__builtin_amdgcn_mfma_f32_32x32x16_bf16(PAF(3),ones,lacc,0,0,0); SBAR(); \
    if constexpr(BIAS){ if(GL){ bfin(P0,P1,nm); SBAR(); } } \
    }while(0)
  int t=1;
  #undef CMASK
  #define CMASK(P0,P1,t) do{}while(0)
  for(;t+5<NT;t+=2){
    STEP(pB0,pB1,pA0,pA1,t,true,true,true);     WAIT_BAR(2); RESC(); ROT();
    STEP(pA0,pA1,pB0,pB1,t+1,true,true,true);   WAIT_BAR(2); RESC(); ROT();
  }
  #undef CMASK
  #define CMASK(P0,P1,t) do{int jb_=(t)-(NT-4); if(jb_>=0)cmask(P0,P1,jb_,qrel,hi);}while(0)
  #define ENDW(tt) do{ if((tt)+3<NT){WAIT_BAR(2);} else if((tt)+2<NT){WAIT_BAR(1);} else {WAIT_BAR(0);} }while(0)
  for(;t+1<NT;t+=2){
    STEP(pB0,pB1,pA0,pA1,t,(t+3<NT),(t+1<NT),(t+1<NT));       ENDW(t);   RESC(); ROT();
    STEP(pA0,pA1,pB0,pB1,t+1,(t+4<NT),(t+2<NT),(t+2<NT));     ENDW(t+1); RESC(); ROT();
  }
  STEP(pB0,pB1,pA0,pA1,NT-1,false,false,false); RESC();
  {
    pw0=(u32x4){PKW(pB0,0),PKW(pB0,2),PKW(pB0,4),PKW(pB0,6)};pw1=(u32x4){PKW(pB0,8),PKW(pB0,10),PKW(pB0,12),PKW(pB0,14)};pw2=(u32x4){PKW(pB1,0),PKW(pB1,2),PKW(pB1,4),PKW(pB1,6)};pw3=(u32x4){PKW(pB1,8),PKW(pB1,10),PKW(pB1,12),PKW(pB1,14)};
    SBAR(); pv(o,vb0+sl_cur,PAF(0),PAF(1),PAF(2),PAF(3));
    lacc=__builtin_amdgcn_mfma_f32_32x32x16_bf16(PAF(0),ones,lacc,0,0,0); lacc=__builtin_amdgcn_mfma_f32_32x32x16_bf16(PAF(1),ones,lacc,0,0,0); lacc=__builtin_amdgcn_mfma_f32_32x32x16_bf16(PAF(2),ones,lacc,0,0,0); lacc=__builtin_amdgcn_mfma_f32_32x32x16_bf16(PAF(3),ones,lacc,0,0,0); }
  #undef PKW
  #undef PAF
  #undef VFR
  #undef PIN
  #undef MX3
  #undef GAPA
  #undef GAPB
  #undef EX
  #undef VRD
  #undef KRD
  #undef STEP
  #undef ENDW
  float rli[16];
  #pragma unroll
  for(int r=0;r<16;++r)rli[r]=__builtin_amdgcn_rcpf(lacc[r]);
  bf16*Ow=O+(rowbase+q0+wid*QBLK)*DM+co;
  { bf16*stg=(bf16*)(shm+LDS_OST)+wid*2048;
    #pragma unroll
    for(int r=0;r<16;++r){const int orow=crow(r,hi);
      #pragma unroll
      for(int d0=0;d0<2;++d0)stg[orow*64+d0*32+r32]=__float2bfloat16(o[d0][r]*rli[r]);}
    asm volatile("s_waitcnt lgkmcnt(0)":::"memory");
    #pragma unroll
    for(int i=0;i<4;++i){const int row=i*8+(lane>>3),ch=lane&7; const u32x4 v=*(const u32x4*)(stg+row*64+ch*8); ATTN_STORE16(Ow+(long)row*DM+ch*8,v);} }
  asm volatile("s_waitcnt lgkmcnt(0)\n\ts_barrier":::"memory");
  #undef DMA_K
  #undef DMA_V
  #undef CMASK
  #undef START
  #undef RESC
  #undef ROT
}
constexpr int DV_LDS_V=NSLOT*SLOTB, DV_LDS_WS=DV_LDS_V+NSLOT*2*SLOTB, DV_LDS_OST=DV_LDS_WS+NW*64*4, DV_LDS_BYTES=DV_LDS_OST+NW*4096;
static_assert(DV_LDS_BYTES<=LDS_BYTES,"dv variant fits the attention LDS budget");
template<int THRL> __device__ __forceinline__ void attn_unit_dv(int b,int cq,int ck,int cv,int co,int qb,const bf16*Q,const bf16*__restrict__ K,const bf16*__restrict__ V,bf16*O,char*shm){
  constexpr bool BIAS=false; constexpr int LDS_V=DV_LDS_V, LDS_WS=DV_LDS_WS, LDS_OST=DV_LDS_OST;
  int tid_=threadIdx.x; asm volatile("":"+v"(tid_)); const int tid=tid_,lane=tid&63,r32=lane&31,hi=lane>>5; const int wid=__builtin_amdgcn_readfirstlane(tid>>6);
  const long rowbase=(long)b*SEQ; const int q0=qb*QB;
  const bf16*Qw=Q+(rowbase+q0+wid*QBLK)*DM+cq;
  const bf16*Kh=K+rowbase*DM+ck,*Vh=V+rowbase*DM+cv;
  const unsigned lds0=(unsigned)(uintptr_t)shm;
  float*wsf=(float*)(shm+LDS_WS)+wid*64;
  const bf16*ksrc=Kh+(long)lane*DM+wid*8;
  const bf16*vsrc=Vh+(long)(16*(wid&3)+(lane>>2))*DM+(wid>>2)*32+(lane&3)*8;
  const unsigned kdst=lds0+LDS_K+wid*1024, vdst=lds0+LDS_V+wid*1024;
  #define DMA_K(t,slot) glds16(ksrc+(long)(t)*KVBLK*DM,(unsigned)__builtin_amdgcn_readfirstlane(kdst+(slot)))
  #define DMA_V(t,slot) do{ glds16(vsrc+(long)(t)*KVBLK*DM,(unsigned)__builtin_amdgcn_readfirstlane(vdst+2*(slot))); glds16(vsrc+(long)(t)*KVBLK*DM+64,(unsigned)__builtin_amdgcn_readfirstlane(vdst+2*(slot)+8192)); }while(0)
  const int vb0=(int)(lds0+LDS_V)+((lane>>4)&1)*32+(lane&3)*8+(4*hi+((lane&15)>>2))*64;
  const char*Kbase=shm+LDS_K; bf16x8 kf[8];
  const lds_cptr shm3=(lds_cptr)shm; const lds_cptr kp0=shm3+LDS_K+hi*1024+r32*16; const lds_cptr vp0=shm3+LDS_V+((lane>>4)&1)*32+(lane&3)*8+(4*hi+((lane&15)>>2))*64;
  const int NT=(q0+QB)/KVBLK;
  DMA_K(0,0);DMA_V(0,0);DMA_K(1,SLOTB);
  bf16x8 qr[4];
  #pragma unroll
  for(int d0=0;d0<4;++d0)qr[d0]=*reinterpret_cast<const bf16x8*>(&Qw[(long)r32*DM+d0*16+hi*8]);
  float mhat=0.f,l_reg=0.f;f32x16 o[4];o[0]=f32x16{};o[1]=f32x16{};o[2]=f32x16{};o[3]=f32x16{};f32x16 negm=f32x16{};asm volatile("":"+v"(negm));
  const int qrel=wid*QBLK+r32;
  #define CMASK(P0,P1,t) do{int jb_=(t)-(NT-4); if(jb_>=0)cmask(P0,P1,jb_,qrel,hi);}while(0)
  bool resc=false;
  #define START(P0,P1) do{ const float rm=rowmax(P0,P1); resc=false; \
    { const float dl=BIAS?__builtin_fmaxf(rm,0.f):rm; mhat=fadd_s(mhat,dl); \
      _Pragma("unroll") for(int r=0;r<16;++r){P0[r]=fsub_s(P0[r],dl);P1[r]=fsub_s(P1[r],dl);} \
      _Pragma("unroll") for(int r=0;r<16;++r)negm[r]=-mhat; asm volatile("":"+v"(negm)); } \
    _Pragma("unroll") for(int r=0;r<16;++r)P0[r]=__builtin_amdgcn_exp2f(P0[r]); }while(0)
  #define RESC() do{ if(resc){ asm volatile("s_waitcnt lgkmcnt(0)":::"memory"); \
      _Pragma("unroll") for(int d_=0;d_<4;++d_) _Pragma("unroll") for(int r=0;r<16;++r)o[d_][r]*=wsf[crow(r,hi)]; } }while(0)
  f32x16 pA0,pA1,pB0,pB1;
  int sl_prev=0,sl_cur=0,sl_next=SLOTB;
  #define ROT() do{sl_prev=sl_cur;sl_cur=sl_next;sl_next=(sl_next==(NSLOT-1)*SLOTB)?0:sl_next+SLOTB;}while(0)
  DMA_K(2,2*SLOTB);
  WAIT_BAR(4);
  qkt<false>(pA0,pA1,Kbase,qr,negm,r32,hi); asm volatile("s_nop 15\n\ts_nop 7":"+v"(pA0),"+v"(pA1));CMASK(pA0,pA1,0);
  START(pA0,pA1);
  _Pragma("unroll") for(int r=0;r<16;++r)pA1[r]=__builtin_amdgcn_exp2f(pA1[r]);
  WAIT_BAR(0);
  DMA_K(3,0);DMA_V(1,SLOTB);
  ROT();
  kload8(kf,kp0+sl_cur);
  WAIT_BAR(3);
  s16x4 vlo[8],vhi[8]; u32x4 pw0,pw1,pw2,pw3;
  #define PKW(P,B) cvtpk_s(P[B],P[B+1])
  #define PAF(k) __builtin_bit_cast(bf16x8,pw##k)
  #define VFR(i) (bf16x8){vlo[i][0],vlo[i][1],vlo[i][2],vlo[i][3],vhi[i][0],vhi[i][1],vhi[i][2],vhi[i][3]}
  #define PIN(x) asm volatile("":"+v"(x))
  #define MX3(a,b,c) __builtin_fmaxf(__builtin_fmaxf((a),(b)),(c))
  #define GAPA(MF,A0,A1,A2,A3,W0,W1,PW) do{ MF; sacc+=A0; sacc+=A1; sacc+=A2; sacc+=A3; PIN(sacc); W0; W1; PIN(PW); SBAR(); }while(0)
  #define EX(v) __builtin_amdgcn_exp2f(v)
  #define GAPB(MF,X,B) do{ MF; X[B]=EX(X[B]); X[B+1]=EX(X[B+1]); X[B+2]=EX(X[B+2]); X[B+3]=EX(X[B+3]); PIN(X); SBAR(); }while(0)
  #define VRD(i) do{ vlo[i]=vtr(vp_+(((i)>>2)*4096+((i)&3)*1024)); vhi[i]=vtr(vp_+(((i)>>2)*4096+((i)&3)*1024+512)); }while(0)
  #define VRD2(i) do{ vlo[i]=vtr(vp_+(8192+((i)>>2)*4096+((i)&3)*1024)); vhi[i]=vtr(vp_+(8192+((i)>>2)*4096+((i)&3)*1024+512)); }while(0)
  #define GAPB2(MF,X,B) do{ MF; X[B]=EX(X[B]); X[B+1]=EX(X[B+1]); PIN(X); SBAR(); }while(0)
  #define KRD(G,j) do{ if(G){ kload2(kf,kp0+sl_next,j); SBAR(); } }while(0)
  #define STEP(C0,C1,P0,P1,t,GK,GV,GL) do{ SBAR(); \
    const lds_cptr vp_=vp0+2*sl_prev; \
    VRD(0); SBAR(); float sacc=(P0[0]+P0[1]); \
    GAPA(C0=__builtin_amdgcn_mfma_f32_32x32x16_bf16(kf[0],qr[0],negm,0,0,0), P0[2],P0[3],P0[4],P0[5],     pw0[0]=PKW(P0,0), pw0[1]=PKW(P0,2), pw0); \
    VRD(4); SBAR(); GAPA(C1=__builtin_amdgcn_mfma_f32_32x32x16_bf16(kf[1],qr[0],negm,0,0,0), P0[6],P0[7],P0[8],P0[9],     pw0[2]=PKW(P0,4), pw0[3]=PKW(P0,6), pw0); \
    VRD(1); SBAR(); GAPA(C0=__builtin_amdgcn_mfma_f32_32x32x16_bf16(kf[2],qr[1],C0,0,0,0),   P0[10],P0[11],P0[12],P0[13], pw1[0]=PKW(P0,8), pw1[1]=PKW(P0,10), pw1); \
    VRD(5); SBAR(); GAPA(C1=__builtin_amdgcn_mfma_f32_32x32x16_bf16(kf[3],qr[1],C1,0,0,0),   P0[14],P0[15],P1[0],P1[1],   pw1[2]=PKW(P0,12),pw1[3]=PKW(P0,14), pw1); \
    VRD(2); SBAR(); GAPA(C0=__builtin_amdgcn_mfma_f32_32x32x16_bf16(kf[4],qr[2],C0,0,0,0),   P1[2],P1[3],P1[4],P1[5],     pw2[0]=PKW(P1,0), pw2[1]=PKW(P1,2), pw2); \
    VRD(6); SBAR(); GAPA(C1=__builtin_amdgcn_mfma_f32_32x32x16_bf16(kf[5],qr[2],C1,0,0,0),   P1[6],P1[7],P1[8],P1[9],     pw2[2]=PKW(P1,4), pw2[3]=PKW(P1,6), pw2); \
    VRD(3); SBAR(); GAPA(C0=__builtin_amdgcn_mfma_f32_32x32x16_bf16(kf[6],qr[3],C0,0,0,0),   P1[10],P1[11],P1[12],P1[13], pw3[0]=PKW(P1,8), pw3[1]=PKW(P1,10), pw3); \
    VRD(7); SBAR(); GAPA(C1=__builtin_amdgcn_mfma_f32_32x32x16_bf16(kf[7],qr[3],C1,0,0,0),   P1[14],P1[15],0.f,0.f,       pw3[2]=PKW(P1,12),pw3[3]=PKW(P1,14), pw3); \
    l_reg+=sacc; \
    if(GK){DMA_K((t)+3,sl_cur);} if(GV){DMA_V((t)+1,sl_next);} \
    CMASK(C0,C1,t); \
    { float a=MX3(C0[0],C0[1],C1[0]),b=MX3(C0[2],C0[3],C1[1]); a=MX3(a,C1[2],C1[3]); \
      _Pragma("unroll") for(int r=4;r<16;r+=4){a=MX3(a,C0[r],C0[r+1]);b=MX3(b,C0[r+2],C0[r+3]);a=MX3(a,C1[r],C1[r+1]);b=MX3(b,C1[r+2],C1[r+3]);} \
      float rm=__builtin_fmaxf(a,b); { auto rr=__builtin_amdgcn_permlane32_swap(__float_as_uint(rm),__float_as_uint(rm),false,false); rm=__builtin_fmaxf(__uint_as_float(rr[0]),__uint_as_float(rr[1])); } \
      resc=false; \
      if(__builtin_expect(__any(rm>(float)THRL),0)){ const float dl=__builtin_fmaxf(rm,0.f); mhat+=dl; \
        _Pragma("unroll") for(int r=0;r<16;++r){C0[r]-=dl;C1[r]-=dl;} \
        _Pragma("unroll") for(int r=0;r<16;++r)negm[r]=-mhat; asm volatile("":"+v"(negm)); \
        const float f=__builtin_amdgcn_exp2f(-dl); l_reg*=f; if(hi==0)wsf[r32]=f; resc=true; } } \
    SBAR(); \
    GAPB2(o[0]=__builtin_amdgcn_mfma_f32_32x32x16_bf16(PAF(0),VFR(0),o[0],0,0,0), C0,0);  VRD2(0); SBAR(); \
    GAPB2(o[1]=__builtin_amdgcn_mfma_f32_32x32x16_bf16(PAF(0),VFR(4),o[1],0,0,0), C0,2);  VRD2(4); SBAR(); \
    GAPB2(o[0]=__builtin_amdgcn_mfma_f32_32x32x16_bf16(PAF(1),VFR(1),o[0],0,0,0), C0,4);  VRD2(1); SBAR(); \
    GAPB2(o[1]=__builtin_amdgcn_mfma_f32_32x32x16_bf16(PAF(1),VFR(5),o[1],0,0,0), C0,6);  VRD2(5); SBAR(); \
    GAPB2(o[0]=__builtin_amdgcn_mfma_f32_32x32x16_bf16(PAF(2),VFR(2),o[0],0,0,0), C0,8);  VRD2(2); SBAR(); \
    GAPB2(o[1]=__builtin_amdgcn_mfma_f32_32x32x16_bf16(PAF(2),VFR(6),o[1],0,0,0), C0,10); VRD2(6); SBAR(); \
    GAPB2(o[0]=__builtin_amdgcn_mfma_f32_32x32x16_bf16(PAF(3),VFR(3),o[0],0,0,0), C0,12); VRD2(3); SBAR(); \
    GAPB2(o[1]=__builtin_amdgcn_mfma_f32_32x32x16_bf16(PAF(3),VFR(7),o[1],0,0,0), C0,14); VRD2(7); SBAR(); \
    KRD(GL,0); GAPB2(o[2]=__builtin_amdgcn_mfma_f32_32x32x16_bf16(PAF(0),VFR(0),o[2],0,0,0), C1,0); \
    KRD(GL,1); GAPB2(o[3]=__builtin_amdgcn_mfma_f32_32x32x16_bf16(PAF(0),VFR(4),o[3],0,0,0), C1,2); \
    KRD(GL,2); GAPB2(o[2]=__builtin_amdgcn_mfma_f32_32x32x16_bf16(PAF(1),VFR(1),o[2],0,0,0), C1,4); \
    KRD(GL,3); GAPB2(o[3]=__builtin_amdgcn_mfma_f32_32x32x16_bf16(PAF(1),VFR(5),o[3],0,0,0), C1,6); \
    GAPB2(o[2]=__builtin_amdgcn_mfma_f32_32x32x16_bf16(PAF(2),VFR(2),o[2],0,0,0), C1,8); \
    GAPB2(o[3]=__builtin_amdgcn_mfma_f32_32x32x16_bf16(PAF(2),VFR(6),o[3],0,0,0), C1,10); \
    GAPB2(o[2]=__builtin_amdgcn_mfma_f32_32x32x16_bf16(PAF(3),VFR(3),o[2],0,0,0), C1,12); \
    GAPB2(o[3]=__builtin_amdgcn_mfma_f32_32x32x16_bf16(PAF(3),VFR(7),o[3],0,0,0), C1,14); \
    }while(0)
  int t=1;
  #undef CMASK
  #define CMASK(P0,P1,t) do{}while(0)
  for(;t+5<NT;t+=2){
    STEP(pB0,pB1,pA0,pA1,t,true,true,true);     WAIT_BAR(3); RESC(); ROT();
    STEP(pA0,pA1,pB0,pB1,t+1,true,true,true);   WAIT_BAR(3); RESC(); ROT();
  }
  #undef CMASK
  #define CMASK(P0,P1,t) do{int jb_=(t)-(NT-4); if(jb_>=0)cmask(P0,P1,jb_,qrel,hi);}while(0)
  #define ENDW(tt) do{ if((tt)+3<NT){WAIT_BAR(3);} else if((tt)+2<NT){WAIT_BAR(2);} else {WAIT_BAR(0);} }while(0)
  for(;t+1<NT;t+=2){
    STEP(pB0,pB1,pA0,pA1,t,(t+3<NT),(t+1<NT),(t+1<NT));       ENDW(t);   RESC(); ROT();
    STEP(pA0,pA1,pB0,pB1,t+1,(t+4<NT),(t+2<NT),(t+2<NT));     ENDW(t+1); RESC(); ROT();
  }
  STEP(pB0,pB1,pA0,pA1,NT-1,false,false,false); RESC();
  { float sacc=pB0[0]+pB0[1]; _Pragma("unroll") for(int r=2;r<16;++r)sacc+=pB0[r]; _Pragma("unroll") for(int r=0;r<16;++r)sacc+=pB1[r]; l_reg+=sacc;
    pw0=(u32x4){PKW(pB0,0),PKW(pB0,2),PKW(pB0,4),PKW(pB0,6)};pw1=(u32x4){PKW(pB0,8),PKW(pB0,10),PKW(pB0,12),PKW(pB0,14)};pw2=(u32x4){PKW(pB1,0),PKW(pB1,2),PKW(pB1,4),PKW(pB1,6)};pw3=(u32x4){PKW(pB1,8),PKW(pB1,10),PKW(pB1,12),PKW(pB1,14)};
    SBAR(); pv(o,vb0+2*sl_cur,PAF(0),PAF(1),PAF(2),PAF(3)); pv(o+2,vb0+2*sl_cur+8192,PAF(0),PAF(1),PAF(2),PAF(3)); }
  #undef PKW
  #undef PAF
  #undef VFR
  #undef PIN
  #undef MX3
  #undef GAPA
  #undef GAPB
  #undef EX
  #undef VRD
  #undef VRD2
  #undef GAPB2
  #undef KRD
  #undef STEP
  #undef ENDW
  {auto rr=__builtin_amdgcn_permlane32_swap(__float_as_uint(l_reg),__float_as_uint(l_reg),false,false);l_reg=__uint_as_float(rr[0])+__uint_as_float(rr[1]);}
  if(hi==0)wsf[32+r32]=l_reg;asm volatile("s_waitcnt lgkmcnt(0)":::"memory");
  float rli[16];
  #pragma unroll
  for(int r=0;r<16;++r)rli[r]=__builtin_amdgcn_rcpf(wsf[32+crow(r,hi)]);
  bf16*Ow=O+(rowbase+q0+wid*QBLK)*DM+co;
  { bf16*stg=(bf16*)(shm+LDS_OST)+wid*2048;
    #pragma unroll
    for(int ps=0;ps<2;++ps){
      #pragma unroll
      for(int r=0;r<16;++r){const int orow=crow(r,hi);
        #pragma unroll
        for(int d0=0;d0<2;++d0)stg[orow*64+d0*32+r32]=__float2bfloat16(o[2*ps+d0][r]*rli[r]);}
      asm volatile("s_waitcnt lgkmcnt(0)":::"memory");
      #pragma unroll
      for(int i=0;i<4;++i){const int row=i*8+(lane>>3),ch=lane&7; const u32x4 v=*(const u32x4*)(stg+row*64+ch*8); ATTN_STORE16(Ow+(long)row*DM+ps*64+ch*8,v);}
      asm volatile("s_waitcnt lgkmcnt(0)":::"memory"); } }
  asm volatile("s_waitcnt lgkmcnt(0)\n\ts_barrier":::"memory");
  #undef DMA_K
  #undef DMA_V
  #undef CMASK
  #undef START
  #undef RESC
  #undef ROT
}
constexpr int ATTN_LDS_BYTES=LDS_BYTES;
#undef SBAR
#undef WAIT_BAR
}
#include <hip/hip_cooperative_groups.h>
namespace cg = cooperative_groups;
#ifndef PROBE_MASK
#define PROBE_MASK 0
#endif
#ifndef MK_SPLIT
#define MK_SPLIT 0
#endif
constexpr int NWAVES = 8;
constexpr int BATCH = 4, SEQ = 8192, T = BATCH * SEQ, D = 1024, FF = 4096, PLE = 256, DEPTH = 4, NFH = 16;
constexpr int TH = T / 2;
constexpr size_t MiB = 1u << 20;
constexpr size_t WS_ROWSS = 8 * MiB;
constexpr size_t WS_T0 = 1 * MiB;
constexpr float SKIP_LOG2 = -160.0f;
constexpr size_t WS_CS = 2 * MiB;
constexpr size_t WS_FLOG = 4 * MiB;
constexpr size_t WS_CK = 6 * MiB;
constexpr size_t W_QKV = 16 * MiB;
constexpr size_t W_O = 23 * MiB;
constexpr size_t W_1 = 25 * MiB;
constexpr size_t W_2 = 33 * MiB;
constexpr size_t W_PLE = 41 * MiB;
constexpr size_t W_G = 42 * MiB;
constexpr size_t WS_HBX = 48 * MiB, WS_HBY = 112 * MiB, WS_R1 = 176 * MiB, WS_PL = 432 * MiB, WS_END = 496 * MiB;
constexpr int RING_BYTES = 131072, LDS_BYTES = 147456;
static_assert(attn_body::ATTN_LDS_BYTES <= RING_BYTES, "attention LDS");

#define GAS __attribute__((address_space(1)))
#define LAS __attribute__((address_space(3)))
typedef unsigned short bf16;
typedef unsigned v4u __attribute__((ext_vector_type(4)));
typedef float f32x4 __attribute__((ext_vector_type(4)));
#define LDS_WAIT() asm volatile("s_waitcnt lgkmcnt(0)" ::: "memory")
__device__ __forceinline__ unsigned f2bf(float f) { unsigned u = __builtin_bit_cast(unsigned, f); return (u + 0x7fffu + ((u >> 16) & 1u)) >> 16; }
__device__ __forceinline__ unsigned pk2(float lo, float hi) { return f2bf(lo) | (f2bf(hi) << 16); }
__device__ __forceinline__ float wave_sum(float v) {
    v += pg8::lane_xor<1>(v); v += pg8::lane_xor<2>(v); v += pg8::lane_xor<4>(v); v += pg8::lane_xor<8>(v); v += pg8::lane_xor<16>(v);
    return pg8::half_sum(v);
}

constexpr int N_PHASES = 1 + 7 + 7 + 7 + 6 + 1;
enum { K_PRO = 0, K_QKVA, K_ATTA, K_COMB, K_QKVB, K_SCAN, K_ATTB, K_RES, K_W1, K_GATE, K_FIN };
struct Args { const float* in[21]; float* out; unsigned char* ws; float inv_freq[8]; int ph_lo, ph_hi; int prog[N_PHASES + 1]; };

#define CAS __attribute__((address_space(4)))
struct Frame { LAS unsigned char* lds; int tid, lane, wave, vcu, G; const CAS Args* a; };

__device__ __forceinline__ void transpose_item(const float* W, int ldw, int coff, int ncols, int K, const float* gain, bf16* WT, int row_off, LAS float* scr, int item, int nblk, int lane) {
    const int kb = item / nblk, nb = item % nblk, k0 = 64 * kb, n0 = 32 * nb;
#pragma unroll
    for (int i = 0; i < 8; ++i) { const int kk = 8 * i + (lane >> 3), n4 = (lane & 7) * 4, n = n0 + n4;
        f32x4 v = (n < ncols) ? *(const GAS f32x4*)(W + (size_t)(k0 + kk) * ldw + coff + n) : (f32x4){0.f, 0.f, 0.f, 0.f};
        if (gain) v = v * gain[k0 + kk];
        LAS float* d = scr + kk * 33 + n4; d[0] = v.x; d[1] = v.y; d[2] = v.z; d[3] = v.w; }
    LDS_WAIT(); asm volatile("" ::: "memory");
    const int c = lane & 7;
#pragma unroll
    for (int j = 0; j < 4; ++j) { const int n = (lane >> 3) + 8 * j; const LAS float* s = scr + (8 * c) * 33 + n;
        v4u o; o.x = pk2(s[0 * 33], s[1 * 33]); o.y = pk2(s[2 * 33], s[3 * 33]); o.z = pk2(s[4 * 33], s[5 * 33]); o.w = pk2(s[6 * 33], s[7 * 33]);
        *(GAS v4u*)(WT + (size_t)(row_off + n0 + n) * K + k0 + 8 * c) = o; }
    LDS_WAIT(); asm volatile("" ::: "memory");
}

__device__ __forceinline__ void convert_layer(Frame& F, int L) {
    const CAS Args& A = *F.a; unsigned char* ws = A.ws;
    LAS float* scr = (LAS float*)(F.lds + F.wave * 16384);
    const int gw = F.vcu * NWAVES + F.wave, NGW = F.G * NWAVES;
    bf16* Wqkv = (bf16*)(ws + W_QKV); bf16* Wo = (bf16*)(ws + W_O); bf16* W1 = (bf16*)(ws + W_1); bf16* W2 = (bf16*)(ws + W_2); bf16* Wp = (bf16*)(ws + W_PLE); bf16* Wg = (bf16*)(ws + W_G + (size_t)(L & 1) * 2 * MiB);
    const bool isA = L < 2; const int j = L - 2;
    const int I_QKV = isA ? 16 * 96 : 16 * 32, I_KV = (!isA && j == 0) ? 16 * 64 : 0, I_F = (!isA && j == 0) ? 16 : 0, I_O = 16 * 32, I_1 = 16 * 128, I_2 = 64 * 32, I_G = 16 * 32, I_P = 4 * 32;
    const int NIT = I_QKV + I_KV + I_F + I_O + I_1 + I_2 + I_G + I_P;
    for (int it = gw; it < NIT; it += NGW) {
        int r = it;
        if (r < I_QKV) { if (isA) transpose_item(A.in[4] + (size_t)L * D * 3 * D, 3 * D, 0, 3 * D, D, A.in[3] + L * D, Wqkv, 0, scr, r, 96, F.lane);
                         else transpose_item(A.in[12] + (size_t)j * D * D, D, 0, D, D, A.in[11] + j * D, Wqkv, 0, scr, r, 32, F.lane); continue; } r -= I_QKV;
        if (r < I_KV) { transpose_item(A.in[9], 2 * D + NFH, 0, 2 * D, D, A.in[8], Wqkv, D, scr, r, 64, F.lane); continue; } r -= I_KV;
        if (r < I_F) { transpose_item(A.in[9], 2 * D + NFH, 2 * D, NFH, D, A.in[8], Wqkv, 3 * D, scr, r, 1, F.lane); continue; } r -= I_F;
        if (r < I_O) { transpose_item(isA ? A.in[7] + (size_t)L * D * D : A.in[13] + (size_t)j * D * D, D, 0, D, D, nullptr, Wo, 0, scr, r, 32, F.lane); continue; } r -= I_O;
        if (r < I_1) { transpose_item(A.in[15] + (size_t)L * D * FF, FF, 0, FF, D, A.in[14] + L * D, W1, 0, scr, r, 128, F.lane); continue; } r -= I_1;
        if (r < I_2) { transpose_item(A.in[16] + (size_t)L * FF * D, D, 0, D, FF, nullptr, W2, 0, scr, r, 32, F.lane); continue; } r -= I_2;
        if (r < I_G) { transpose_item(A.in[18] + (size_t)L * D * D, D, 0, D, D, A.in[17] + L * D, Wg, 0, scr, r, 32, F.lane); continue; } r -= I_G;
        transpose_item(A.in[19] + (size_t)L * PLE * D, D, 0, D, PLE, nullptr, Wp, 0, scr, r, 32, F.lane);
    }
}

__device__ __forceinline__ void sincos_red(double r, float& s, float& c) {
    const double r2 = r * r;
    double sp = -1.0 / 51090942171709440000.0;
    sp = sp * r2 + 1.0 / 121645100408832000.0;
    sp = sp * r2 - 1.0 / 355687428096000.0;
    sp = sp * r2 + 1.0 / 1307674368000.0;
    sp = sp * r2 - 1.0 / 6227020800.0;
    sp = sp * r2 + 1.0 / 39916800.0;
    sp = sp * r2 - 1.0 / 362880.0;
    sp = sp * r2 + 1.0 / 5040.0;
    sp = sp * r2 - 1.0 / 120.0;
    sp = sp * r2 + 1.0 / 6.0;
    sp = sp * r2 - 1.0;
    s = (float)(-(sp * r));
    double cp = 1.0 / 1124000727777607680000.0;
    cp = cp * r2 - 1.0 / 2432902008176640000.0;
    cp = cp * r2 + 1.0 / 6402373705728000.0;
    cp = cp * r2 - 1.0 / 20922789888000.0;
    cp = cp * r2 + 1.0 / 87178291200.0;
    cp = cp * r2 - 1.0 / 479001600.0;
    cp = cp * r2 + 1.0 / 3628800.0;
    cp = cp * r2 - 1.0 / 40320.0;
    cp = cp * r2 + 1.0 / 720.0;
    cp = cp * r2 - 1.0 / 24.0;
    cp = cp * r2 + 0.5;
    c = (float)(1.0 - cp * r2);
}

__device__ __forceinline__ void p0_prologue(Frame& F) {
    const CAS Args& A = *F.a; unsigned char* ws = A.ws;
    const int gw = F.vcu * NWAVES + F.wave, NGW = F.G * NWAVES, gt = gw * 64 + F.lane, NGT = NGW * 64;
    float* rowss = (float*)(ws + WS_ROWSS);
    bf16* hbx = (bf16*)(ws + WS_HBX);
    for (int m0 = gw; m0 < T; m0 += 2 * NGW) {
        const int m1 = (m0 + NGW < T) ? m0 + NGW : m0;
        const GAS f32x4* xa = (const GAS f32x4*)(A.in[0] + (size_t)m0 * D) + F.lane; const GAS f32x4* xb = (const GAS f32x4*)(A.in[0] + (size_t)m1 * D) + F.lane;
        const f32x4 a0 = xa[0], a1 = xa[64], a2 = xa[128], a3 = xa[192], b0 = xb[0], b1 = xb[64], b2 = xb[128], b3 = xb[192];
#define XROW(m, v0, v1, v2, v3) { float s = 0.f; GAS unsigned long long* o8 = (GAS unsigned long long*)(hbx + (size_t)(m) * D) + F.lane; \
            XQ(0, v0) XQ(1, v1) XQ(2, v2) XQ(3, v3) s = wave_sum(s); if (F.lane < 16) rowss[(size_t)(m) * 16 + F.lane] = (F.lane == 0) ? s : 0.f; }
#define XQ(j, v) { const unsigned lo = pk2(v.x, v.y), hi = pk2(v.z, v.w); o8[64 * j] = (unsigned long long)lo | ((unsigned long long)hi << 32); \
            const float q0 = __builtin_bit_cast(float, lo << 16), q1 = __builtin_bit_cast(float, lo & 0xffff0000u), q2 = __builtin_bit_cast(float, hi << 16), q3 = __builtin_bit_cast(float, hi & 0xffff0000u); s += (q0 * q0 + q1 * q1) + (q2 * q2 + q3 * q3); }
        XROW(m0, a0, a1, a2, a3)
        if (m1 != m0) XROW(m1, b0, b1, b2, b3)
#undef XQ
#undef XROW
    }
    float* cs = (float*)(ws + WS_CS); const int* pos = (const int*)A.in[2];
    for (int i = gt; i < T * 8; i += NGT) { const int row = i >> 3, jj = i & 7;
        const float ang = (float)pos[row] * A.inv_freq[jj]; const double a = (double)ang;
        const double n = __builtin_rint(a * 0.15915494309189535); const double r = __builtin_fma(-n, 6.283185307179586, a) - n * 2.4492935982947064e-16;
        float s, c; sincos_red(r, s, c); cs[row * 16 + jj] = c; cs[row * 16 + 8 + jj] = s; }
}

__device__ __forceinline__ void convert_p(Frame& F, int L, bf16* pb) {
    const CAS Args& A = *F.a; const int gt = (F.vcu * NWAVES + F.wave) * 64 + F.lane, NGT = F.G * NWAVES * 64;
    const GAS f32x4* src = (const GAS f32x4*)(A.in[1] + (size_t)L * T * PLE); GAS v4u* dst = (GAS v4u*)pb;
#pragma unroll 4
    for (int i = gt; i < T * PLE / 8; i += NGT) { const f32x4 a = src[2 * i], b = src[2 * i + 1]; v4u o; o.x = pk2(a.x, a.y); o.y = pk2(a.z, a.w); o.z = pk2(b.x, b.y); o.w = pk2(b.z, b.w); dst[i] = o; }
}

__device__ __forceinline__ void scan_phase(Frame& F) {
    unsigned char* ws = F.a->ws; const float* flog = (const float*)(ws + WS_FLOG); float* ck = (float*)(ws + WS_CK);
    LAS float* wtot = (LAS float*)F.lds;
    for (int bh = blockIdx.x; bh < BATCH * NFH; bh += F.G) { const int b = bh >> 4, h = bh & 15, t0 = F.tid * 16;
        float v0, v1, v2, v3, v4, v5, v6, v7, v8, v9, v10, v11, v12, v13, v14, v15;
        const float* src = flog + ((size_t)b * SEQ + t0) * 16 + h;
        v0 = src[0]; v1 = v0 + src[16]; v2 = v1 + src[32]; v3 = v2 + src[48]; v4 = v3 + src[64]; v5 = v4 + src[80]; v6 = v5 + src[96]; v7 = v6 + src[112];
        v8 = v7 + src[128]; v9 = v8 + src[144]; v10 = v9 + src[160]; v11 = v10 + src[176]; v12 = v11 + src[192]; v13 = v12 + src[208]; v14 = v13 + src[224]; v15 = v14 + src[240];
        float incl = v15, tot = v15;
#define BSTEP(M) { const float pt = pg8::lane_xor<M>(tot); if (F.lane & M) incl += pt; tot += pt; }
        BSTEP(1) BSTEP(2) BSTEP(4) BSTEP(8) BSTEP(16)
#undef BSTEP
        { const float lowtot = __builtin_bit_cast(float, __builtin_amdgcn_readlane(__builtin_bit_cast(int, tot), 0)); if (F.lane & 32) incl += lowtot; }
        if (F.lane == 63) wtot[F.wave] = incl;
        LDS_WAIT(); __syncthreads();
        float base = incl - v15;
        for (int w = 0; w < F.wave; ++w) base += wtot[w];
        const float L2E = 1.4426950408889634f;
        f32x4* dst = (f32x4*)(ck + (size_t)bh * SEQ + t0);
        dst[0] = (f32x4){(v0 + base) * L2E, (v1 + base) * L2E, (v2 + base) * L2E, (v3 + base) * L2E};
        dst[1] = (f32x4){(v4 + base) * L2E, (v5 + base) * L2E, (v6 + base) * L2E, (v7 + base) * L2E};
        dst[2] = (f32x4){(v8 + base) * L2E, (v9 + base) * L2E, (v10 + base) * L2E, (v11 + base) * L2E};
        dst[3] = (f32x4){(v12 + base) * L2E, (v13 + base) * L2E, (v14 + base) * L2E, (v15 + base) * L2E};
        asm volatile("s_waitcnt vmcnt(0)" ::: "memory"); __syncthreads();
        if (F.tid < 32) { const int qb = F.tid, ntf = 4 * qb; const float* cb = ck + (size_t)bh * SEQ; const float cq0 = cb[qb * 256];
            int lo = 0, hi2 = ntf;
            while (lo < hi2) { const int mid = (lo + hi2) >> 1; if (cq0 - cb[64 * mid + 63] >= SKIP_LOG2) hi2 = mid; else lo = mid + 1; }
            ((int*)(ws + WS_T0))[bh * 32 + qb] = lo & ~1; }
        __syncthreads();
    }
}

__device__ __forceinline__ void combine_phase(Frame& F, int L, const bf16* O1, const bf16* O2, bf16* On) {
    const CAS Args& A = *F.a; const int gw = F.vcu * NWAVES + F.wave, NGW = F.G * NWAVES;
    const float lam_init = (L == 0) ? 0.2f : 0.35550906759096924f;
    const float* lp = A.in[5] + L * 4 * 64;
    const float s1 = wave_sum(lp[F.lane] * lp[64 + F.lane]), s2 = wave_sum(lp[128 + F.lane] * lp[192 + F.lane]);
    const float lam = expf(s1) - expf(s2) + lam_init;
    const float* gp = A.in[6] + L * 128 + 16 * (F.lane & 7);
    const f32x4 g0 = *(const f32x4*)gp, g1 = *(const f32x4*)(gp + 4), g2 = *(const f32x4*)(gp + 8), g3 = *(const f32x4*)(gp + 12);
    const float post = 1.0f - lam_init;
#define CB(k, aw, bw) o[2 * (k)] = __builtin_bit_cast(float, (aw) << 16) - lam * __builtin_bit_cast(float, (bw) << 16); o[2 * (k) + 1] = __builtin_bit_cast(float, (aw) & 0xffff0000u) - lam * __builtin_bit_cast(float, (bw) & 0xffff0000u);
#define CROW(off, a0, a1, b0, b1) { float o[16]; \
        CB(0, a0.x, b0.x) CB(1, a0.y, b0.y) CB(2, a0.z, b0.z) CB(3, a0.w, b0.w) CB(4, a1.x, b1.x) CB(5, a1.y, b1.y) CB(6, a1.z, b1.z) CB(7, a1.w, b1.w) \
        float ss = 0.f; _Pragma("unroll") for (int k = 0; k < 16; ++k) ss += o[k] * o[k]; \
        ss += pg8::lane_xor<1>(ss); ss += pg8::lane_xor<2>(ss); ss += pg8::lane_xor<4>(ss); \
        const float rs = __builtin_amdgcn_rsqf(ss * (1.0f / 128.0f) + 1e-6f) * post; v4u w0, w1; \
        w0.x = pk2(o[0] * rs * g0.x, o[1] * rs * g0.y); w0.y = pk2(o[2] * rs * g0.z, o[3] * rs * g0.w); w0.z = pk2(o[4] * rs * g1.x, o[5] * rs * g1.y); w0.w = pk2(o[6] * rs * g1.z, o[7] * rs * g1.w); \
        w1.x = pk2(o[8] * rs * g2.x, o[9] * rs * g2.y); w1.y = pk2(o[10] * rs * g2.z, o[11] * rs * g2.w); w1.z = pk2(o[12] * rs * g3.x, o[13] * rs * g3.y); w1.w = pk2(o[14] * rs * g3.z, o[15] * rs * g3.w); \
        *(GAS v4u*)(On + (off)) = w0; *(GAS v4u*)(On + (off) + 8) = w1; }
    for (int r0 = gw; r0 < T; r0 += 2 * NGW) {
        const int r1 = (r0 + NGW < T) ? r0 + NGW : r0;
        const size_t off0 = (size_t)r0 * D + 16 * F.lane, off1 = (size_t)r1 * D + 16 * F.lane;
        const v4u a0 = *(const GAS v4u*)(O1 + off0), a1 = *(const GAS v4u*)(O1 + off0 + 8), b0 = *(const GAS v4u*)(O2 + off0), b1 = *(const GAS v4u*)(O2 + off0 + 8);
        const v4u c0 = *(const GAS v4u*)(O1 + off1), c1 = *(const GAS v4u*)(O1 + off1 + 8), d0 = *(const GAS v4u*)(O2 + off1), d1 = *(const GAS v4u*)(O2 + off1 + 8);
        CROW(off0, a0, a1, b0, b1)
        if (r1 != r0) CROW(off1, c0, c1, d0, d1)
    }
#undef CROW
#undef CB
}

__device__ __forceinline__ void final_phase(Frame& F, const bf16* hb, float* out) {
    const CAS Args& A = *F.a; const int gw = F.vcu * NWAVES + F.wave, NGW = F.G * NWAVES;
    const GAS f32x4* gp = (const GAS f32x4*)A.in[20] + 4 * F.lane;
    const f32x4 g0 = gp[0], g1 = gp[1], g2 = gp[2], g3 = gp[3];
#define UB(o, k, w) o[2 * (k)] = __builtin_bit_cast(float, (w) << 16); o[2 * (k) + 1] = __builtin_bit_cast(float, (w) & 0xffff0000u);
#define FROW(off, a0, a1) { float o[16]; UB(o, 0, a0.x) UB(o, 1, a0.y) UB(o, 2, a0.z) UB(o, 3, a0.w) UB(o, 4, a1.x) UB(o, 5, a1.y) UB(o, 6, a1.z) UB(o, 7, a1.w) \
        float s = 0.f; _Pragma("unroll") for (int k = 0; k < 16; ++k) s += o[k] * o[k]; \
        const float rs = 1.0f / sqrtf(wave_sum(s) * (1.0f / D) + 1e-6f); GAS f32x4* op = (GAS f32x4*)(out + (off)); \
        op[0] = (f32x4){o[0] * rs * g0.x, o[1] * rs * g0.y, o[2] * rs * g0.z, o[3] * rs * g0.w}; op[1] = (f32x4){o[4] * rs * g1.x, o[5] * rs * g1.y, o[6] * rs * g1.z, o[7] * rs * g1.w}; \
        op[2] = (f32x4){o[8] * rs * g2.x, o[9] * rs * g2.y, o[10] * rs * g2.z, o[11] * rs * g2.w}; op[3] = (f32x4){o[12] * rs * g3.x, o[13] * rs * g3.y, o[14] * rs * g3.z, o[15] * rs * g3.w}; }
    for (int m0 = gw; m0 < T; m0 += 2 * NGW) {
        const int m1 = (m0 + NGW < T) ? m0 + NGW : m0;
        const size_t off0 = (size_t)m0 * D + 16 * F.lane, off1 = (size_t)m1 * D + 16 * F.lane;
        const v4u a0 = *(const GAS v4u*)(hb + off0), a1 = *(const GAS v4u*)(hb + off0 + 8), b0 = *(const GAS v4u*)(hb + off1), b1 = *(const GAS v4u*)(hb + off1 + 8);
        FROW(off0, a0, a1)
        if (m1 != m0) FROW(off1, b0, b1)
    }
#undef FROW
#undef UB
}

template <bool BIAS> __device__ __forceinline__ void attn_phase(Frame& F, const bf16* Q, const bf16* K, const bf16* V, bf16* O1, bf16* O2, const float* ck, unsigned* qctr, const int* t0tab) {
    using abf = attn_body::bf16;
    if constexpr (BIAS) {
        volatile LAS unsigned* uw = (volatile LAS unsigned*)(F.lds + RING_BYTES + 128);
        unsigned mine = 0u; if (threadIdx.x == 0) mine = __hip_atomic_fetch_add(qctr, 1u, __ATOMIC_RELAXED, __HIP_MEMORY_SCOPE_AGENT);
        for (;;) {
            if (threadIdx.x == 0) *uw = mine;
            __syncthreads();
            const int u = (int)__builtin_amdgcn_readfirstlane(*uw);
            if (u >= BATCH * 16 * 32) break;
            if (threadIdx.x == 0) mine = __hip_atomic_fetch_add(qctr, 1u, __ATOMIC_RELAXED, __HIP_MEMORY_SCOPE_AGENT);
            const int qb = 31 - (u >> 6), bhv = u & 63, b = bhv >> 4, h = bhv & 15;
            const float* cb = ck + (size_t)bhv * SEQ;
            const int t0 = __builtin_amdgcn_readfirstlane(t0tab[bhv * 32 + qb]);
            attn_body::attn_unit<8, true>(b, h * 64, h * 64, h * 64, h * 64, qb, (const abf*)Q, (const abf*)K, (const abf*)V, (abf*)O1, cb, (char*)F.lds, t0);
        }
    } else {
        const int nslot = BATCH * 16 * 8;
        for (int sl = F.vcu; sl < nslot; sl += F.G) { const int bhv = sl >> 3, s = sl & 7;
            for (int k = 0; k < 4; ++k) { const int qb = (k == 0) ? s : (k == 1) ? 15 - s : (k == 2) ? 16 + s : 31 - s;
                const int b = bhv >> 4, hc = bhv & 15;
                attn_body::attn_unit_dv<8>(b, hc * 64, hc * 64, (hc >> 1) * 128, (hc >> 1) * 128, qb, (const abf*)Q, (const abf*)K, (const abf*)V, (abf*)((hc & 1) ? O2 : O1), (char*)F.lds); }
        }
    }
}

#define XB_TMO      128
#define XB_XCNT(j)  (256  + 64 * (j))
#define XB_XSUB(j)  (1280 + 64 * (j))
#define XB_XGEN(j)  (2304 + 64 * (j))
#define XB_TOP      3328
#define XB_TOPGEN   3392
#define XCD_BAR_WORDS 3456
#define XB_SPIN_CAP (1u << 18)

__device__ __forceinline__ unsigned xb_ld(unsigned* p)              { return __hip_atomic_load(p, __ATOMIC_RELAXED, __HIP_MEMORY_SCOPE_AGENT); }
__device__ __forceinline__ unsigned xb_add(unsigned* p, unsigned v) { return __hip_atomic_fetch_add(p, v, __ATOMIC_RELAXED, __HIP_MEMORY_SCOPE_AGENT); }
__device__ __forceinline__ unsigned xb_xcc_id() { return (unsigned)__builtin_amdgcn_s_getreg((3 << 11) | 20) & 0xFu; }
#define XB_SPIN(cond, bar) do { unsigned _sp = 0; while (cond) { __builtin_amdgcn_s_sleep(1); \
    if ((++_sp & 255u) == 0u) { if (xb_ld(&(bar)[XB_TMO])) break; if (_sp > XB_SPIN_CAP) { atomicAdd(&(bar)[XB_TMO], 1u); break; } } } } while (0)

struct XcdBarrier {
    unsigned* bar; unsigned x;
    volatile LAS unsigned* st;
};

__device__ __forceinline__ XcdBarrier xcd_barrier_post(unsigned* bar, volatile LAS unsigned* st) {
    XcdBarrier b; b.bar = bar; b.x = xb_xcc_id(); b.st = st;
    if (threadIdx.x == 0) (void)xb_add(&bar[XB_XCNT(b.x)], 1u);
    return b;
}
__device__ __forceinline__ void xcd_barrier_complete(unsigned* bar, unsigned x, unsigned& nloc, unsigned& nx) {
    const unsigned G = gridDim.x * gridDim.y * gridDim.z;
    unsigned sum, cnt, mine, sp = 0u;
    for (;;) {
        sum = 0u; cnt = 0u; mine = 0u;
#pragma unroll
        for (unsigned j = 0; j < 16; ++j) { const unsigned c = xb_ld(&bar[XB_XCNT(j)]); sum += c; cnt += (c > 0u) ? 1u : 0u; mine = (j == x) ? c : mine; }
        if (sum == G) break;
        __builtin_amdgcn_s_sleep(1);
        if ((++sp & 255u) == 0u) { if (xb_ld(&bar[XB_TMO])) break; if (sp > XB_SPIN_CAP) { atomicAdd(&bar[XB_TMO], 1u); break; } }
    }
    nloc = mine > 0u ? mine : 1u; nx = cnt > 0u ? cnt : 1u;
}

__device__ __forceinline__ void xcd_barrier(const XcdBarrier& b) {
    asm volatile("s_waitcnt vmcnt(0)" ::: "memory");
    __syncthreads();
    if (threadIdx.x == 0) {
        unsigned* bar = b.bar;
        __builtin_amdgcn_s_waitcnt(0);
        unsigned nloc = b.st[0], nx = b.st[1];
        if (nloc == 0u) { xcd_barrier_complete(bar, b.x, nloc, nx); b.st[0] = nloc; b.st[1] = nx; }
        const unsigned old = xb_add(&bar[XB_XSUB(b.x)], 1u);
        const unsigned gen = old / nloc;
        if (old + 1u == (gen + 1u) * nloc) {
            __builtin_amdgcn_fence(__ATOMIC_RELEASE, "agent");
            asm volatile("s_waitcnt vmcnt(0)" ::: "memory");
            const unsigned og = xb_add(&bar[XB_TOP], 1u);
            const unsigned tg = og / nx;
            if (og + 1u == (tg + 1u) * nx) xb_add(&bar[XB_TOPGEN], 1u);
            else XB_SPIN(xb_ld(&bar[XB_TOPGEN]) == tg, bar);
            __builtin_amdgcn_fence(__ATOMIC_ACQUIRE, "agent");
            xb_add(&bar[XB_XGEN(b.x)], 1u);
            asm volatile("s_waitcnt vmcnt(0)" ::: "memory");
        } else {
            XB_SPIN(xb_ld(&bar[XB_XGEN(b.x)]) == gen, bar);
            __builtin_amdgcn_fence(__ATOMIC_ACQUIRE, "agent");
            asm volatile("s_waitcnt vmcnt(0)" ::: "memory");
        }
    }
    __syncthreads();
}

constexpr size_t WS_CTL = 0, CTL_ZERO_BYTES = 16384;
constexpr int LDSCTL_OFF = RING_BYTES;
__global__ void __launch_bounds__(NWAVES * 64, 2) yoco_fwd(Args args) {
    extern __shared__ __attribute__((aligned(16))) unsigned char lds[];
    cg::grid_group grid = cg::this_grid();
    using pg8::Gemm; using pg8::StaticOrder; using pg8::EpiQKV; using pg8::EpiRes; using pg8::EpiBf; using pg8::gemm_phase;
    const size_t E64 = 64 * MiB / 2;
    const int ph_lo = args.ph_lo, ph_hi = args.ph_hi;
    if (threadIdx.x < 64) ((LAS unsigned*)((LAS unsigned char*)lds + LDSCTL_OFF))[threadIdx.x] = 0u;
    __syncthreads();
    if (ph_hi - ph_lo > 1 && threadIdx.x == 0) (void)xb_add((unsigned*)(args.ws + WS_CTL) + XB_XCNT(xb_xcc_id()), 1u);
    if (ph_lo == 0) {
        const CAS Args* ap = (const CAS Args*)__builtin_amdgcn_kernarg_segment_ptr(); asm volatile("" : "+s"(ap));
        Frame F; F.a = ap; F.lds = (LAS unsigned char*)lds;
        { int t_ = threadIdx.x; asm volatile("" : "+v"(t_)); F.tid = t_; F.lane = t_ & 63; F.wave = __builtin_amdgcn_readfirstlane(t_ >> 6); }
        int bx = blockIdx.x, G_ = gridDim.x; asm volatile("" : "+s"(bx), "+s"(G_)); F.G = G_; F.vcu = (G_ % 8 == 0) ? (bx % 8) * (G_ / 8) + bx / 8 : bx;
        p0_prologue(F);
    }
    for (int ph = ph_lo; ph < ph_hi; ++ph) {
        const CAS Args* ap = (const CAS Args*)__builtin_amdgcn_kernarg_segment_ptr(); asm volatile("" : "+s"(ap));
        Frame F; F.a = ap; F.lds = (LAS unsigned char*)lds;
#define FRESH_TID() do { int t_ = threadIdx.x; asm volatile("" : "+v"(t_)); F.tid = t_; F.lane = t_ & 63; F.wave = __builtin_amdgcn_readfirstlane(t_ >> 6); } while (0)
        int bx = blockIdx.x, G_ = gridDim.x; asm volatile("" : "+s"(bx), "+s"(G_)); F.G = G_; F.vcu = (G_ % 8 == 0) ? (bx % 8) * (G_ / 8) + bx / 8 : bx;
        const int code = ap->prog[ph], kind = code & 255, L = (code >> 8) & 255, hf = (code >> 16) & 1, w2 = (code >> 17) & 1, full = (code >> 18) & 1;
        const int MH = full ? T : TH;
        unsigned char* ws = ap->ws; LAS unsigned char* ring = F.lds;
        float* rowss = (float*)(ws + WS_ROWSS); bf16* OA1 = (bf16*)ap->out; bf16* OA2 = OA1 + (size_t)T * D;
        bf16* hbX = (bf16*)(ws + WS_HBX); bf16* hbY = (bf16*)(ws + WS_HBY); bf16* R1 = (bf16*)(ws + WS_R1);
        int conv = -1;
#if PROBE_MASK
        const unsigned long long pt0 = __builtin_amdgcn_s_memrealtime();
#endif
        switch (kind) {
        case K_PRO: conv = 0; break;
        case K_QKVA: { Gemm g{hbX, (bf16*)(ws + W_QKV), T, 3 * D, D}; StaticOrder S; S.init(T, 3 * D, F.G, bx);
            EpiQKV<0> E{R1, (long long)(64 * MiB), (long long)(128 * MiB), rowss + (size_t)((3 * L) & 3) * T * 16, (const float*)(ws + WS_CS), nullptr, nullptr};
            gemm_phase<EpiQKV<0>, StaticOrder, PG8_ALIGN, PG8_SP2>(ring, g, S, E); } break;
        case K_ATTA: attn_phase<false>(F, R1, R1 + E64, R1 + 2 * E64, OA1, OA2, nullptr, nullptr, nullptr); break;
        case K_COMB: FRESH_TID(); combine_phase(F, L, OA1, OA2, R1 + 3 * E64); break;
        case K_QKVB: { const int N = (L == 2) ? 3 * D + 256 : D; Gemm g{hbX, (bf16*)(ws + W_QKV), T, N, D}; StaticOrder S; S.init(T, N, F.G, bx);
            EpiQKV<1> E{R1, (long long)((unsigned long long)OA1 - (unsigned long long)R1), (long long)((unsigned long long)OA2 - (unsigned long long)R1), rowss + (size_t)((3 * L) & 3) * T * 16, nullptr, (float*)(ws + WS_FLOG), ap->in[10]};
            gemm_phase<EpiQKV<1>, StaticOrder, PG8_ALIGN, PG8_SP2>(ring, g, S, E); } break;
        case K_SCAN: FRESH_TID(); scan_phase(F); break;
        case K_ATTB: attn_phase<true>(F, R1, OA1, OA2, R1, nullptr, (const float*)(ws + WS_CK), (unsigned*)(ws + WS_CTL) + 3584 + 64 * (L - 2), (const int*)(ws + WS_T0)); break;
        case K_RES: {
            Gemm g{w2 ? R1 : (L < 2 ? R1 + 3 * E64 : R1), (bf16*)(ws + (w2 ? W_2 : W_O)), w2 ? MH : T, D, w2 ? FF : D}; StaticOrder S; S.init(g.M, D, F.G, bx);
            EpiRes<0> E{hbX, w2 ? hbY : hbX, rowss + (size_t)((3 * L + 1 + w2) & 3) * T * 16, nullptr, nullptr, w2 ? hf * TH : 0};
            gemm_phase<EpiRes<0>, StaticOrder, PG8_ALIGN, PG8_SP2>(ring, g, S, E);
            if (!w2) { FRESH_TID(); convert_p(F, L, hbY); } } break;
        case K_W1: { { Gemm g{hbX + (size_t)hf * TH * D, (bf16*)(ws + W_1), MH, FF, D}; StaticOrder S; S.init(MH, FF, F.G, bx);
                EpiBf<1> E{R1, FF, rowss + (size_t)((3 * L + 1) & 3) * T * 16, hf * TH};
                gemm_phase<EpiBf<1>, StaticOrder, PG8_ALIGN, PG8_SP2>(ring, g, S, E); }
            if (hf == 0) { Gemm g2{hbY, (bf16*)(ws + W_PLE), T, D, PLE}; StaticOrder S2; S2.init(T, D, F.G, bx);
                EpiBf<0> E2{(bf16*)(ws + WS_PL), D, nullptr, 0};
                gemm_phase<EpiBf<0>, StaticOrder, PG8_ALIGN, PG8_SP2>(ring, g2, S2, E2); } } break;
        case K_GATE: { Gemm g{hbY, (bf16*)(ws + W_G + (size_t)(L & 1) * 2 * MiB), T, D, D}; StaticOrder S; S.init(T, D, F.G, bx);
            EpiRes<1> E{hbY, hbX, rowss + (size_t)((3 * L + 3) & 3) * T * 16, rowss + (size_t)((3 * L + 2) & 3) * T * 16, (const bf16*)(ws + WS_PL), 0};
            gemm_phase<EpiRes<1>, StaticOrder, PG8_ALIGN, PG8_SP2>(ring, g, S, E);
            if (L + 1 < DEPTH) conv = L + 1; } break;
        default: FRESH_TID(); final_phase(F, hbX, ap->out); break;
        }
        if (conv >= 0) { FRESH_TID(); convert_layer(F, conv); }
#if PROBE_MASK
        if ((PROBE_MASK >> kind) & 1) { const unsigned long long pt1 = __builtin_amdgcn_s_memrealtime(); while (__builtin_amdgcn_s_memrealtime() - pt1 < pt1 - pt0) __builtin_amdgcn_s_sleep(8); }
#endif
        if (ph + 1 < ph_hi) {
            if (ph_hi < 0) grid.sync();
            else { XcdBarrier xb; xb.bar = (unsigned*)(ap->ws + WS_CTL); xb.x = xb_xcc_id(); xb.st = (volatile LAS unsigned*)((LAS unsigned char*)lds + LDSCTL_OFF + 32); xcd_barrier(xb); }
        }
    }
}

static void build_prog(int* prog) {
    int n = 0; prog[n++] = K_PRO;
    for (int L = 0; L < DEPTH; ++L) {
        if (L < 2) { prog[n++] = K_QKVA | L << 8; prog[n++] = K_ATTA | L << 8; prog[n++] = K_COMB | L << 8; }
        else { prog[n++] = K_QKVB | L << 8; if (L == 2) prog[n++] = K_SCAN | L << 8; prog[n++] = K_ATTB | L << 8; }
        prog[n++] = K_RES | L << 8;
        prog[n++] = K_W1 | L << 8 | 1 << 18; prog[n++] = K_RES | L << 8 | 1 << 17 | 1 << 18;
        prog[n++] = K_GATE | L << 8;
    }
    prog[n++] = K_FIN;
    if (n != N_PHASES) fprintf(stderr, "build_prog: %d phases, N_PHASES %d\n", n, N_PHASES);
    while (n < N_PHASES + 1) prog[n++] = K_FIN;
}

extern "C" void kernel_launch(void* const* d_in, const int* in_sizes, int n_in, void* d_out, int out_size, void* d_ws, size_t ws_size, hipStream_t stream) {
    static int grid = 0;
    if (grid == 0) {
        if (n_in != 21 || out_size != T * D || ws_size < WS_END) { fprintf(stderr, "kernel_launch: unexpected problem (n_in %d out %d ws %zu)\n", n_in, out_size, ws_size); grid = -1; return; }
        int dev = 0, cus = 0, per_cu = 0;
        if (hipGetDevice(&dev) != hipSuccess || hipDeviceGetAttribute(&cus, hipDeviceAttributeMultiprocessorCount, dev) != hipSuccess) { grid = -1; return; }
        if (hipFuncSetAttribute((const void*)yoco_fwd, hipFuncAttributeMaxDynamicSharedMemorySize, LDS_BYTES) != hipSuccess) { fprintf(stderr, "kernel_launch: hipFuncSetAttribute failed\n"); grid = -1; return; }
        if (hipOccupancyMaxActiveBlocksPerMultiprocessor(&per_cu, (const void*)yoco_fwd, NWAVES * 64, LDS_BYTES) != hipSuccess || per_cu < 1) { fprintf(stderr, "kernel_launch: occupancy query says %d\n", per_cu); per_cu = 1; }
        (void)hipGetLastError();
        grid = cus;
    }
    if (grid < 0) return;
    Args a{};
    for (int i = 0; i < 21; ++i) a.in[i] = (const float*)d_in[i];
    a.out = (float*)d_out; a.ws = (unsigned char*)d_ws;
    for (int j = 0; j < 8; ++j) { const float p = powf(500000.0f, (float)(2 * j) / 16.0f); a.inv_freq[j] = 1.0f / p; }
    build_prog(a.prog);
#if MK_SPLIT
    for (int p = 0; p < N_PHASES; ++p) { a.ph_lo = p; a.ph_hi = p + 1; hipLaunchKernelGGL(yoco_fwd, dim3(grid), dim3(NWAVES * 64), LDS_BYTES, stream, a); }
#else
    a.ph_lo = 0; a.ph_hi = N_PHASES;
    (void)hipMemsetAsync((char*)d_ws + WS_CTL, 0, CTL_ZERO_BYTES, stream);
    void* kargs[] = {&a};
    const hipError_t e = hipLaunchCooperativeKernel((const void*)yoco_fwd, dim3(grid), dim3(NWAVES * 64), kargs, LDS_BYTES, stream);
    if (e != hipSuccess) fprintf(stderr, "kernel_launch: cooperative launch failed: %s (grid %d)\n", hipGetErrorString(e), grid);
#endif
}
```
